# Optimizing an MI355X kernel written in HIP

```python
import jax, jax.numpy as jnp
from jax import lax
import numpy as np

D_MODEL = 1024
BATCH = 8
SEQ = 4096
DEPTH = 1

CHUNK = 64
Q_BLOCK = 128
LN_EPS = 1e-5
RMS_EPS = 1e-6

MLA_HEADS = 8
MLA_NOPE = 64
MLA_ROPE = 32
MLA_V = 64
MLA_QK = MLA_NOPE + MLA_ROPE
MLA_Q_RANK = 256
MLA_KV_RANK = 128
MLA_WIDTH = MLA_HEADS * MLA_V
ROPE_THETA = 10000.0

RWKV_HEADS = 8
RWKV_HEAD = 64
RWKV_WIDTH = RWKV_HEADS * RWKV_HEAD
DECAY_LORA = 64
ICLR_LORA = 64
RWKV_SHIFT_WIDTH = 3 * RWKV_WIDTH + DECAY_LORA + ICLR_LORA
GN_EPS = 64e-5

ALPHA = (2.0 * DEPTH) ** 0.25
BETA = (8.0 * DEPTH) ** -0.25

IN_SPLITS = (MLA_Q_RANK, MLA_KV_RANK, MLA_ROPE, MLA_WIDTH,
             RWKV_SHIFT_WIDTH, RWKV_WIDTH,
             D_MODEL, D_MODEL)
IN_WIDTH = sum(IN_SPLITS)

kernel_name = 'hybrid_mla_rwkv7_gated_deepnorm_block'


def _split(t, sizes):
    return jnp.split(t, [int(i) for i in np.cumsum(sizes)[:-1]], axis=-1)


def layer_norm(x):
    x = x.astype(jnp.float32)
    xc = x - jnp.mean(x, -1, keepdims=True)
    return xc * lax.rsqrt(jnp.mean(xc * xc, -1, keepdims=True) + LN_EPS)


def rms_norm(x, g):
    x32 = x.astype(jnp.float32)
    y = x32 * lax.rsqrt(jnp.mean(x32 * x32, -1, keepdims=True) + RMS_EPS)
    return (y * g).astype(x.dtype)


def rope_tables(positions):
    inv = ROPE_THETA ** (-jnp.arange(0, MLA_ROPE, 2, dtype=jnp.float32) / MLA_ROPE)
    ang = positions.astype(jnp.float32)[..., None] * inv
    return jnp.cos(ang)[:, :, None, :], jnp.sin(ang)[:, :, None, :]


def apply_rope(t, cos, sin):
    t1, t2 = jnp.split(t.astype(jnp.float32), 2, axis=-1)
    return jnp.concatenate([t1 * cos - t2 * sin, t1 * sin + t2 * cos], -1).astype(t.dtype)


def token_shift(u, mu):
    u_prev = jnp.pad(u, ((0, 0), (1, 0), (0, 0)))[:, :-1]
    return u + (u_prev - u) * mu


def chunk_causal_attention(q, k, v):
    B, S, H, Dk = q.shape
    nb = S // Q_BLOCK
    qb = q.reshape(B, nb, Q_BLOCK, H, Dk).transpose(1, 0, 2, 3, 4)
    key_chunk = jnp.arange(S) // CHUNK
    scale = Dk ** -0.5

    def block(args):
        qi, bi = args
        s = jnp.einsum('bqhd,bkhd->bhqk', qi, k).astype(jnp.float32) * scale
        q_chunk = (bi * Q_BLOCK + jnp.arange(Q_BLOCK)) // CHUNK
        mask = key_chunk[None, :] <= q_chunk[:, None]
        p = jax.nn.softmax(jnp.where(mask, s, -jnp.inf), axis=-1).astype(v.dtype)
        return jnp.einsum('bhqk,bkhd->bqhd', p, v)

    out = lax.map(block, (qb, jnp.arange(nb)))
    return out.transpose(1, 0, 2, 3, 4).reshape(B, S, H, v.shape[-1])


def wkv7(r, w, k, v, a, b):
    B, S, H, N = r.shape

    def step(state, inp):
        r_t, w_t, k_t, v_t, a_t, b_t = inp
        sa = jnp.einsum('bhij,bhj->bhi', state, a_t)
        state = (state * w_t[:, :, None, :] + sa[..., None] * b_t[:, :, None, :]
                 + v_t[..., None] * k_t[:, :, None, :])
        return state, jnp.einsum('bhij,bhj->bhi', state, r_t)

    xs = tuple(jnp.moveaxis(t.astype(jnp.float32), 1, 0) for t in (r, w, k, v, a, b))
    _, y = lax.scan(step, jnp.zeros((B, H, N, N), jnp.float32), xs)
    return jnp.moveaxis(y, 0, 1)


def mla_branch(q_c, kv_c, k_rope, cos, sin, q_norm_g, w_uq, kv_norm_g, w_ukv):
    B, S, _ = q_c.shape
    q = (rms_norm(q_c, q_norm_g) @ w_uq).reshape(B, S, MLA_HEADS, MLA_QK)
    kv = (rms_norm(kv_c, kv_norm_g) @ w_ukv).reshape(B, S, MLA_HEADS, MLA_NOPE + MLA_V)
    q_nope, q_pe = jnp.split(q, [MLA_NOPE], axis=-1)
    k_nope, v = jnp.split(kv, [MLA_NOPE], axis=-1)
    q_pe = apply_rope(q_pe, cos, sin)
    k_pe = apply_rope(k_rope[:, :, None, :], cos, sin)
    q = jnp.concatenate([q_nope, q_pe], -1)
    k = jnp.concatenate([k_nope, jnp.broadcast_to(k_pe, (B, S, MLA_HEADS, MLA_ROPE))], -1)
    return chunk_causal_attention(q, k, v).reshape(B, S, MLA_WIDTH)


def rwkv7_branch(u, w0, w_decay_up, a0, w_iclr_up, k_k, k_a, r_k, gn_g, gn_b):
    B, S, _ = u.shape
    r, k, v, wd, ad = _split(u, (RWKV_WIDTH, RWKV_WIDTH, RWKV_WIDTH, DECAY_LORA, ICLR_LORA))
    w_log = -jax.nn.softplus(-(w0 + jnp.tanh(wd) @ w_decay_up)) - 0.5
    decay = jnp.exp(-jnp.exp(w_log.astype(jnp.float32)))
    a = jax.nn.sigmoid(a0 + ad @ w_iclr_up)
    hs = lambda t: t.reshape(B, S, RWKV_HEADS, RWKV_HEAD)
    kk = hs(k * k_k).astype(jnp.float32)
    kk = kk / jnp.maximum(jnp.sqrt(jnp.sum(kk * kk, -1, keepdims=True)), 1e-12)
    k = k * (1 + (a - 1) * k_a)
    r_h, k_h, v_h, a_h = hs(r), hs(k), hs(v), hs(a)
    y = wkv7(r_h, hs(decay), k_h, v_h, -kk, kk * a_h)
    y = y - jnp.mean(y, -1, keepdims=True)
    y = y * lax.rsqrt(jnp.mean(y * y, -1, keepdims=True) + GN_EPS)
    y = y.reshape(B, S, RWKV_WIDTH) * gn_g + gn_b
    bonus = jnp.sum((r_h * k_h * r_k).astype(jnp.float32), -1, keepdims=True) * v_h
    return (y + bonus.reshape(B, S, RWKV_WIDTH)).astype(u.dtype)


def hybrid_layer(x, c, cos, sin, w_ada, b_ada, w_in, q_norm_g, w_uq, kv_norm_g, w_ukv,
                 mu_rwkv, w0, w_decay_up, a0, w_iclr_up, k_k, k_a, r_k, gn_g, gn_b,
                 w_proj_a, w_proj_b, w_out, post_g, post_b):
    dt = x.dtype
    shift, scale, gate = jnp.split(jax.nn.silu(c) @ w_ada + b_ada, 3, axis=-1)
    h = (layer_norm(x) * (1 + scale[:, None]) + shift[:, None]).astype(dt)
    proj = h @ w_in
    q_c, kv_c, k_rope, gpath_a, rwkv_in, gpath_b, merge_a, merge_b = _split(proj, IN_SPLITS)
    y_a = mla_branch(q_c, kv_c, k_rope, cos, sin, q_norm_g, w_uq, kv_norm_g, w_ukv)
    y_b = rwkv7_branch(token_shift(rwkv_in, mu_rwkv), w0, w_decay_up, a0, w_iclr_up,
                       k_k, k_a, r_k, gn_g, gn_b)
    y_a = (y_a * jax.nn.silu(gpath_a)) @ w_proj_a
    y_b = (y_b * jax.nn.silu(gpath_b)) @ w_proj_b
    merged = jax.nn.sigmoid(merge_a) * y_a + jax.nn.sigmoid(merge_b) * y_b
    sub = merged @ w_out
    out = layer_norm(ALPHA * x + (1 + gate[:, None]) * sub) * post_g + post_b
    return out.astype(dt)


def setup_inputs(seed: int = 0) -> dict:
    key = jax.random.key(seed)
    k = jax.random.split(key, 32)

    def nrm(i, shape, fan_in, gain=1.0):
        return jax.random.normal(k[i], (DEPTH,) + shape, jnp.float32) * (gain * fan_in ** -0.5)

    def near(i, shape, center, spread=0.02):
        return center + spread * jax.random.normal(k[i], (DEPTH,) + shape, jnp.float32)

    x = jax.random.normal(k[0], (BATCH, SEQ, D_MODEL), jnp.float32)
    c = jax.random.normal(k[1], (BATCH, D_MODEL), jnp.float32)
    positions = (jax.random.randint(k[2], (BATCH, 1), 0, 8192, dtype=jnp.int32)
                 + jnp.arange(SEQ, dtype=jnp.int32)[None, :])
    decay_base = -6.0 + 5.0 * jnp.linspace(0.0, 1.0, RWKV_WIDTH, dtype=jnp.float32) ** 0.9
    return {
        'x': x,
        'c': c,
        'positions': positions,
        'w_ada': nrm(3, (D_MODEL, 3 * D_MODEL), D_MODEL, 0.2),
        'b_ada': near(4, (3 * D_MODEL,), 0.0),
        'w_in': nrm(5, (D_MODEL, IN_WIDTH), D_MODEL),
        'q_norm_g': near(6, (MLA_Q_RANK,), 1.0),
        'w_uq': nrm(7, (MLA_Q_RANK, MLA_HEADS * MLA_QK), MLA_Q_RANK),
        'kv_norm_g': near(8, (MLA_KV_RANK,), 1.0),
        'w_ukv': nrm(9, (MLA_KV_RANK, MLA_HEADS * (MLA_NOPE + MLA_V)), MLA_KV_RANK),
        'mu_rwkv': jax.random.uniform(k[10], (DEPTH, RWKV_SHIFT_WIDTH), jnp.float32),
        'w0': decay_base + near(11, (RWKV_WIDTH,), 0.0, 0.1),
        'w_decay_up': nrm(12, (DECAY_LORA, RWKV_WIDTH), DECAY_LORA),
        'a0': near(13, (RWKV_WIDTH,), 0.0, 0.1),
        'w_iclr_up': nrm(14, (ICLR_LORA, RWKV_WIDTH), ICLR_LORA),
        'k_k': near(15, (RWKV_WIDTH,), 0.85),
        'k_a': near(16, (RWKV_WIDTH,), 1.0),
        'r_k': near(17, (RWKV_HEADS, RWKV_HEAD), 0.0, 0.1),
        'gn_g': near(18, (RWKV_WIDTH,), 1.0),
        'gn_b': near(19, (RWKV_WIDTH,), 0.0),
        'w_proj_a': nrm(20, (MLA_WIDTH, D_MODEL), MLA_WIDTH, BETA),
        'w_proj_b': nrm(21, (RWKV_WIDTH, D_MODEL), RWKV_WIDTH, BETA),
        'w_out': nrm(22, (D_MODEL, D_MODEL), D_MODEL, BETA),
        'post_g': near(23, (D_MODEL,), 1.0),
        'post_b': near(24, (D_MODEL,), 0.0),
    }


def reference(x, c, positions, w_ada, b_ada, w_in, q_norm_g, w_uq, kv_norm_g, w_ukv,
              mu_rwkv, w0, w_decay_up, a0, w_iclr_up, k_k, k_a, r_k, gn_g, gn_b,
              w_proj_a, w_proj_b, w_out, post_g, post_b):
    cos, sin = rope_tables(positions)
    for l in range(DEPTH):
        x = hybrid_layer(x, c, cos, sin, w_ada[l], b_ada[l], w_in[l], q_norm_g[l], w_uq[l],
                         kv_norm_g[l], w_ukv[l], mu_rwkv[l], w0[l], w_decay_up[l], a0[l],
                         w_iclr_up[l], k_k[l], k_a[l], r_k[l], gn_g[l], gn_b[l],
                         w_proj_a[l], w_proj_b[l], w_out[l], post_g[l], post_b[l])
    return x
```

```cpp
#include <hip/hip_runtime.h>
#include <hip/hip_cooperative_groups.h>
#include <cstdio>
#include <cstdint>
namespace cg = cooperative_groups;

typedef unsigned short us;
typedef __attribute__((ext_vector_type(8))) short bf16x8;
typedef __attribute__((ext_vector_type(4))) float f32x4;
typedef __attribute__((ext_vector_type(16))) float f32x16;
#define DEVI __device__ __forceinline__

constexpr int T_TOK = 32768, SEQ = 4096, DM = 1024;
constexpr int LDA_ = 2080;
constexpr int LDB_ = 3072;
constexpr int NTHR = 512;
constexpr int LDSB = 16 * 9216 + 2048;
constexpr float QSCALE = 0.10206207261596575f * 1.4426950408889634f;
constexpr float ALPHA_ = 1.189207115002721f;

struct Params {
  const float *x, *c; const int* pos;
  const float *w_ada, *b_ada, *w_in, *q_norm_g, *w_uq, *kv_norm_g, *w_ukv, *mu, *w0, *w_dec, *a0, *w_icl,
      *k_k, *k_a, *r_k, *gn_g, *gn_b, *w_pa, *w_pb, *w_out, *post_g, *post_b;
  float* out;
  float *mod, *cs, *stats, *Gc;
  us *Wt_in, *Wt_uq, *Wt_ukv, *Wt_dec, *Wt_icl, *Wt_pa, *Wt_pb, *Wt_out;
  us *h, *projA, *projB, *Q, *K, *Vt, *za, *zb, *bv, *Mp, *Nt, *Y1, *Y0t, *Hh, *merged;
};

DEVI us f2bf(float f) { unsigned u = __float_as_uint(f); u += 0x7fffu + ((u >> 16) & 1u); return (us)(u >> 16); }
DEVI float bf2f(us h) { return __uint_as_float(((unsigned)h) << 16); }
DEVI unsigned pack2(float a, float b) { return (unsigned)f2bf(a) | ((unsigned)f2bf(b) << 16); }
DEVI uint2 pack4(f32x4 v) { uint2 r; r.x = pack2(v[0], v[1]); r.y = pack2(v[2], v[3]); return r; }
DEVI f32x4 mfma16(bf16x8 a, bf16x8 b, f32x4 c) { return __builtin_amdgcn_mfma_f32_16x16x32_bf16(a, b, c, 0, 0, 0); }
DEVI f32x16 mfma32(bf16x8 a, bf16x8 b, f32x16 c) { return __builtin_amdgcn_mfma_f32_32x32x16_bf16(a, b, c, 0, 0, 0); }
DEVI float sigmoidf_(float v) { return 1.f / (1.f + __expf(-v)); }
DEVI float siluf_(float v) { return v / (1.f + __expf(-v)); }

__device__ void phase0(const Params& p, unsigned char* smraw) {
  float* smf = (float*)smraw;
  const int tid = threadIdx.x;
  for (int it = blockIdx.x; it < 1952; it += gridDim.x) {
    if (it < 1904) {
      const float* src; us* dst; int K, N, kt, nt; const float* rs = nullptr; float sc = 1.f; int r = it;
      if (r < 1296) { src = p.w_in; dst = p.Wt_in; K = 1024; N = 5152; kt = r / 81; nt = r % 81; }
      else if ((r -= 1296) < 48) { src = p.w_uq; dst = p.Wt_uq; K = 256; N = 768; kt = r / 12; nt = r % 12; rs = p.q_norm_g; sc = QSCALE; }
      else if ((r -= 48) < 32) { src = p.w_ukv; dst = p.Wt_ukv; K = 128; N = 1024; kt = r / 16; nt = r % 16; rs = p.kv_norm_g; }
      else if ((r -= 32) < 8) { src = p.w_dec; dst = p.Wt_dec; K = 64; N = 512; kt = 0; nt = r; }
      else if ((r -= 8) < 8) { src = p.w_icl; dst = p.Wt_icl; K = 64; N = 512; kt = 0; nt = r; }
      else if ((r -= 8) < 128) { src = p.w_pa; dst = p.Wt_pa; K = 512; N = 1024; kt = r / 16; nt = r % 16; }
      else if ((r -= 128) < 128) { src = p.w_pb; dst = p.Wt_pb; K = 512; N = 1024; kt = r / 16; nt = r % 16; }
      else { r -= 128; src = p.w_out; dst = p.Wt_out; K = 1024; N = 1024; kt = r / 16; nt = r % 16; }
      const int nl = tid & 63, kb = tid >> 6;
#pragma unroll
      for (int i = 0; i < 8; ++i) {
        int k = kb + 8 * i, n = nt * 64 + nl;
        float v = 0.f;
        if (n < N) v = src[(size_t)(kt * 64 + k) * N + n];
        if (rs) v *= rs[kt * 64 + k];
        smf[k * 65 + nl] = v * sc;
      }
      __syncthreads();
      const int n = tid >> 3, kq = tid & 7;
      if (nt * 64 + n < N) {
        uint4 o;
        o.x = pack2(smf[(kq * 8 + 0) * 65 + n], smf[(kq * 8 + 1) * 65 + n]);
        o.y = pack2(smf[(kq * 8 + 2) * 65 + n], smf[(kq * 8 + 3) * 65 + n]);
        o.z = pack2(smf[(kq * 8 + 4) * 65 + n], smf[(kq * 8 + 5) * 65 + n]);
        o.w = pack2(smf[(kq * 8 + 6) * 65 + n], smf[(kq * 8 + 7) * 65 + n]);
        *(uint4*)(dst + (size_t)(nt * 64 + n) * K + kt * 64 + kq * 8) = o;
      }
      __syncthreads();
    } else {
      const int n0 = (it - 1904) * 64;
      for (int i = tid; i < 8192; i += NTHR) smf[i] = siluf_(p.c[i]);
      __syncthreads();
      const int nl = tid & 63, kg = tid >> 6;
      float acc[8];
#pragma unroll
      for (int b = 0; b < 8; ++b) acc[b] = 0.f;
      for (int k = kg * 128; k < kg * 128 + 128; ++k) {
        float w = p.w_ada[(size_t)k * 3072 + n0 + nl];
#pragma unroll
        for (int b = 0; b < 8; ++b) acc[b] += smf[b * 1024 + k] * w;
      }
      float* red = smf + 8192;
#pragma unroll
      for (int b = 0; b < 8; ++b) red[(kg * 8 + b) * 64 + nl] = acc[b];
      __syncthreads();
      {
        const int b = tid >> 6;
        float s = p.b_ada[n0 + nl];
#pragma unroll
        for (int g = 0; g < 8; ++g) s += red[(g * 8 + b) * 64 + nl];
        p.mod[b * 3072 + n0 + nl] = s;
      }
      __syncthreads();
    }
  }
  const int gt = blockIdx.x * NTHR + tid, gs = gridDim.x * NTHR;
  for (int i = gt; i < T_TOK * 16; i += gs) {
    int t = i >> 4, pi = i & 15;
    double ang = (double)p.pos[t] * pow(10000.0, -(double)pi / 16.0);
    p.cs[t * 32 + pi] = (float)cos(ang);
    p.cs[t * 32 + 16 + pi] = (float)sin(ang);
  }
  for (int i = gt; i < T_TOK * 2; i += gs) p.stats[i] = 0.f;
  unsigned* padz = (unsigned*)(p.Wt_in + (size_t)5152 * 1024);
  for (int i = gt; i < 224 * 512; i += gs) padz[i] = 0u;
}

__device__ void phase1(const Params& p) {
  const int lane = threadIdx.x & 63, wid = threadIdx.x >> 6;
  for (int row = blockIdx.x * 8 + wid; row < T_TOK; row += gridDim.x * 8) {
    const float4* xr = (const float4*)(p.x + (size_t)row * DM);
    float4 v[4];
#pragma unroll
    for (int i = 0; i < 4; ++i) v[i] = xr[i * 64 + lane];
    float s = 0.f;
#pragma unroll
    for (int i = 0; i < 4; ++i) s += v[i].x + v[i].y + v[i].z + v[i].w;
#pragma unroll
    for (int o = 32; o; o >>= 1) s += __shfl_xor(s, o);
    const float mean = s * (1.f / 1024.f);
    float q = 0.f;
#pragma unroll
    for (int i = 0; i < 4; ++i) {
      v[i].x -= mean; v[i].y -= mean; v[i].z -= mean; v[i].w -= mean;
      q += v[i].x * v[i].x + v[i].y * v[i].y + v[i].z * v[i].z + v[i].w * v[i].w;
    }
#pragma unroll
    for (int o = 32; o; o >>= 1) q += __shfl_xor(q, o);
    const float rstd = rsqrtf(q * (1.f / 1024.f) + 1e-5f);
    const float* md = p.mod + (row >> 12) * 3072;
#pragma unroll
    for (int i = 0; i < 4; ++i) {
      const int col = i * 256 + lane * 4;
      float4 sh = *(const float4*)(md + col), scl = *(const float4*)(md + 1024 + col);
      uint2 o;
      o.x = pack2(v[i].x * rstd * (1.f + scl.x) + sh.x, v[i].y * rstd * (1.f + scl.y) + sh.y);
      o.y = pack2(v[i].z * rstd * (1.f + scl.z) + sh.z, v[i].w * rstd * (1.f + scl.w) + sh.w);
      *(uint2*)(p.h + (size_t)row * DM + col) = o;
    }
  }
}

constexpr int GST = 384 * 72;
DEVI void gemm_main(const us* __restrict__ X, int ldx, const us* __restrict__ Y, int ldy, int K, us* sm,
                    f32x4 (&acc)[4][4]) {
  const int tid = threadIdx.x, lane = tid & 63, wid = tid >> 6;
  const int wx = wid >> 2, wy = wid & 3, fr = lane & 15, fq = lane >> 4;
  const int sr = tid >> 3, sc = (tid & 7) * 8;
  bf16x8 gx[2], gy[4];
#pragma unroll
  for (int i = 0; i < 2; ++i) gx[i] = *(const bf16x8*)(X + (size_t)(sr + i * 64) * ldx + sc);
#pragma unroll
  for (int i = 0; i < 4; ++i) gy[i] = *(const bf16x8*)(Y + (size_t)(sr + i * 64) * ldy + sc);
#pragma unroll
  for (int i = 0; i < 2; ++i) *(bf16x8*)(sm + (sr + i * 64) * 72 + sc) = gx[i];
#pragma unroll
  for (int i = 0; i < 4; ++i) *(bf16x8*)(sm + (128 + sr + i * 64) * 72 + sc) = gy[i];
  __syncthreads();
  const int nk = K >> 6;
  for (int kt = 0; kt < nk; ++kt) {
    const int cur = kt & 1;
    if (kt + 1 < nk) {
      const int k0 = (kt + 1) * 64 + sc;
#pragma unroll
      for (int i = 0; i < 2; ++i) gx[i] = *(const bf16x8*)(X + (size_t)(sr + i * 64) * ldx + k0);
#pragma unroll
      for (int i = 0; i < 4; ++i) gy[i] = *(const bf16x8*)(Y + (size_t)(sr + i * 64) * ldy + k0);
    }
    const us* xs = sm + cur * GST;
    const us* ys = xs + 128 * 72;
#pragma unroll
    for (int ks = 0; ks < 2; ++ks) {
      bf16x8 a[4], b[4];
#pragma unroll
      for (int i = 0; i < 4; ++i) a[i] = *(const bf16x8*)(xs + (wx * 64 + i * 16 + fr) * 72 + ks * 32 + fq * 8);
#pragma unroll
      for (int j = 0; j < 4; ++j) b[j] = *(const bf16x8*)(ys + (wy * 64 + j * 16 + fr) * 72 + ks * 32 + fq * 8);
#pragma unroll
      for (int i = 0; i < 4; ++i)
#pragma unroll
        for (int j = 0; j < 4; ++j) acc[i][j] = mfma16(a[i], b[j], acc[i][j]);
    }
    if (kt + 1 < nk) {
      us* xn = sm + (cur ^ 1) * GST;
#pragma unroll
      for (int i = 0; i < 2; ++i) *(bf16x8*)(xn + (sr + i * 64) * 72 + sc) = gx[i];
#pragma unroll
      for (int i = 0; i < 4; ++i) *(bf16x8*)(xn + (128 + sr + i * 64) * 72 + sc) = gy[i];
    }
    __syncthreads();
  }
}
DEVI void zero_acc(f32x4 (&acc)[4][4]) {
#pragma unroll
  for (int i = 0; i < 4; ++i)
#pragma unroll
    for (int j = 0; j < 4; ++j) acc[i][j] = f32x4{0.f, 0.f, 0.f, 0.f};
}

__device__ void phase2(const Params& p, unsigned char* smraw) {
  us* sm = (us*)smraw;
  const int lane = threadIdx.x & 63, wid = threadIdx.x >> 6;
  const int wx = wid >> 2, wy = wid & 3, fr = lane & 15, fq = lane >> 4;
  for (int tile = blockIdx.x; tile < 41 * 128; tile += gridDim.x) {
    const int yt = tile / 41, xt = tile % 41;
    const int x0 = xt * 128, y0 = yt * 256;
    f32x4 acc[4][4];
    zero_acc(acc);
    gemm_main(p.Wt_in + (size_t)x0 * 1024, 1024, p.h + (size_t)y0 * 1024, 1024, 1024, sm, acc);
#pragma unroll
    for (int i = 0; i < 4; ++i) {
      const int nb = x0 + wx * 64 + i * 16;
      if (nb >= 5152) continue;
      us* dst; int ld, col, act;
      if (nb < 416) { dst = p.projA; ld = LDA_; col = nb; act = 0; }
      else if (nb < 928) { dst = p.projB; ld = LDB_; col = nb - 416; act = 1; }
      else if (nb < 2592) { dst = p.projA; ld = LDA_; col = nb - 928 + 416; act = 0; }
      else if (nb < 3104) { dst = p.projB; ld = LDB_; col = nb - 2592 + 512; act = 1; }
      else { dst = p.projB; ld = LDB_; col = nb - 3104 + 1024; act = 2; }
#pragma unroll
      for (int j = 0; j < 4; ++j) {
        const int t = y0 + wy * 64 + j * 16 + fr;
        f32x4 v = acc[i][j];
        if (act == 1) { for (int r = 0; r < 4; ++r) v[r] = siluf_(v[r]); }
        else if (act == 2) { for (int r = 0; r < 4; ++r) v[r] = sigmoidf_(v[r]); }
        *(uint2*)(dst + (size_t)t * ld + col + fq * 4) = pack4(v);
      }
    }
  }
}

#define REG_(i) ((us*)(smraw + (i) * 9216))
DEVI f32x4 mm_tile(const us* A, const us* B, int mt, int nt, int fr, int fq, f32x4 acc) {
#pragma unroll
  for (int ks = 0; ks < 2; ++ks) {
    bf16x8 a = *(const bf16x8*)(A + (mt * 16 + fr) * 72 + ks * 32 + fq * 8);
    bf16x8 b = *(const bf16x8*)(B + (nt * 16 + fr) * 72 + ks * 32 + fq * 8);
    acc = mfma16(a, b, acc);
  }
  return acc;
}
DEVI void storeT(us* dst, int ld, int mt, int nt, int fr, int fq, f32x4 v) {
  *(uint2*)(dst + (nt * 16 + fr) * ld + mt * 16 + fq * 4) = pack4(v);
}
DEVI f32x4 maskv(f32x4 v, int mt, int nt, int fr, int fq, int mode) {
  const int n = nt * 16 + fr, m0 = mt * 16 + fq * 4;
#pragma unroll
  for (int r = 0; r < 4; ++r) {
    const int m = m0 + r;
    bool keep = (mode == 0) ? (m < n) : (mode == 1) ? (m <= n) : (n < m);
    if (!keep) v[r] = 0.f;
  }
  return v;
}
DEVI void load_shift8(const us* ptr, bool hasprev, const float* mu, float (&o)[8]) {
  bf16x8 cur = *(const bf16x8*)ptr;
  bf16x8 prv = cur;
  if (hasprev) prv = *(const bf16x8*)(ptr - LDA_);
#pragma unroll
  for (int e = 0; e < 8; ++e) {
    float cv = bf2f((us)cur[e]);
    float pv = hasprev ? bf2f((us)prv[e]) : 0.f;
    o[e] = cv + (pv - cv) * mu[e];
  }
}

__device__ void wkv_prep_item(const Params& p, int item, unsigned char* smraw) {
  const int tid = threadIdx.x, lane = tid & 63, w = tid >> 6, fr = lane & 15, fq = lane >> 4;
  const int h = item & 7, bc = item >> 3, b = bc >> 6, c = bc & 63;
  const int ch = (b * 8 + h) * 64 + c;
  const int tok0 = b * SEQ + c * 64;
  const int t = tid >> 3, j0 = (tid & 7) * 8, jc = h * 64 + j0;
  const f32x4 z4 = {0.f, 0.f, 0.f, 0.f};
  us *At = REG_(0), *Bt = REG_(1), *Kt = REG_(2), *Rt = REG_(3), *BhT = REG_(4), *KhT = REG_(5), *VT = REG_(6);
  us *P0 = REG_(7), *PT0 = REG_(8), *P1 = REG_(9), *PT1 = REG_(10), *Aak = REG_(11), *Arb = REG_(12), *Ark = REG_(13);
  us* UT = REG_(14);
  float* F = (float*)REG_(9);
  float* G = (float*)REG_(14);
  float* segsum = (float*)(smraw + 16 * 9216);

  float rr[8], kk_[8], vv[8], wd[8], ad[8];
  {
    const bool hp = (c * 64 + t) > 0;
    const us* rowp = p.projA + (size_t)(tok0 + t) * LDA_ + 416;
    load_shift8(rowp + jc, hp, p.mu + jc, rr);
    load_shift8(rowp + 512 + jc, hp, p.mu + 512 + jc, kk_);
    load_shift8(rowp + 1024 + jc, hp, p.mu + 1024 + jc, vv);
    load_shift8(rowp + 1536 + j0, hp, p.mu + 1536 + j0, wd);
    load_shift8(rowp + 1600 + j0, hp, p.mu + 1600 + j0, ad);
  }
  {
    uint4 o1, o2;
    o1.x = pack2(tanhf(wd[0]), tanhf(wd[1])); o1.y = pack2(tanhf(wd[2]), tanhf(wd[3]));
    o1.z = pack2(tanhf(wd[4]), tanhf(wd[5])); o1.w = pack2(tanhf(wd[6]), tanhf(wd[7]));
    o2.x = pack2(ad[0], ad[1]); o2.y = pack2(ad[2], ad[3]); o2.z = pack2(ad[4], ad[5]); o2.w = pack2(ad[6], ad[7]);
    *(uint4*)(P0 + t * 72 + j0) = o1;
    *(uint4*)(PT0 + t * 72 + j0) = o2;
  }
  __syncthreads();
  {
    const int which = w >> 2, tt = w & 3;
    const us* A = which ? PT0 : P0;
    const us* Wt = (which ? p.Wt_icl : p.Wt_dec) + (size_t)h * 64 * 64;
    float* Fw = F + which * 4160;
#pragma unroll
    for (int jt = 0; jt < 4; ++jt) {
      f32x4 acc = z4;
#pragma unroll
      for (int ks = 0; ks < 2; ++ks) {
        bf16x8 a = *(const bf16x8*)(A + (tt * 16 + fr) * 72 + ks * 32 + fq * 8);
        bf16x8 bq = *(const bf16x8*)(Wt + (jt * 16 + fr) * 64 + ks * 32 + fq * 8);
        acc = mfma16(a, bq, acc);
      }
#pragma unroll
      for (int r = 0; r < 4; ++r) Fw[(tt * 16 + fq * 4 + r) * 65 + jt * 16 + fr] = acc[r];
    }
  }
  __syncthreads();
  float lw[8], av[8], kn[8], kp[8];
  {
    float ss = 0.f;
#pragma unroll
    for (int e = 0; e < 8; ++e) {
      float dl = p.w0[jc + e] + F[t * 65 + j0 + e];
      float al = p.a0[jc + e] + F[4160 + t * 65 + j0 + e];
      float xneg = -dl;
      float sp = fmaxf(xneg, 0.f) + log1pf(__expf(-fabsf(xneg)));
      float wl = -sp - 0.5f;
      lw[e] = -__expf(wl);
      av[e] = sigmoidf_(al);
      float kq = kk_[e] * p.k_k[jc + e];
      kn[e] = kq;
      ss += kq * kq;
      kp[e] = kk_[e] * (1.f + (av[e] - 1.f) * p.k_a[jc + e]);
    }
    ss += __shfl_xor(ss, 1); ss += __shfl_xor(ss, 2); ss += __shfl_xor(ss, 4);
    const float inv = 1.f / fmaxf(sqrtf(ss), 1e-12f);
    float bon = 0.f;
#pragma unroll
    for (int e = 0; e < 8; ++e) {
      kn[e] *= inv;
      bon += rr[e] * kp[e] * p.r_k[jc + e];
    }
    bon += __shfl_xor(bon, 1); bon += __shfl_xor(bon, 2); bon += __shfl_xor(bon, 4);
    uint4 o;
    o.x = pack2(bon * vv[0], bon * vv[1]); o.y = pack2(bon * vv[2], bon * vv[3]);
    o.z = pack2(bon * vv[4], bon * vv[5]); o.w = pack2(bon * vv[6], bon * vv[7]);
    *(uint4*)(p.bv + (size_t)(tok0 + t) * 512 + jc) = o;
  }
  __syncthreads();
#pragma unroll
  for (int e = 0; e < 8; ++e) G[t * 65 + j0 + e] = lw[e];
  __syncthreads();
  {
    const int j = tid & 63, seg = tid >> 6;
    float run = 0.f;
#pragma unroll
    for (int i = 0; i < 8; ++i) { run += G[(seg * 8 + i) * 65 + j]; G[(seg * 8 + i) * 65 + j] = run; }
    segsum[seg * 64 + j] = run;
    __syncthreads();
    float off = 0.f;
    for (int s2 = 0; s2 < seg; ++s2) off += segsum[s2 * 64 + j];
#pragma unroll
    for (int i = 0; i < 8; ++i) G[(seg * 8 + i) * 65 + j] += off;
  }
  __syncthreads();
  {
    float ta[8], tb[8], tk[8], tr[8];
#pragma unroll
    for (int e = 0; e < 8; ++e) {
      const float g = G[t * 65 + j0 + e], gC = G[63 * 65 + j0 + e];
      const float eg = __expf(g), eng = __expf(-g), egx = __expf(g - lw[e]), egc = __expf(gC - g);
      ta[e] = -kn[e] * egx;
      tb[e] = kn[e] * av[e] * eng;
      tk[e] = kp[e] * eng;
      tr[e] = rr[e] * eg;
      BhT[(j0 + e) * 72 + t] = f2bf(kn[e] * av[e] * egc);
      KhT[(j0 + e) * 72 + t] = f2bf(kp[e] * egc);
      VT[(j0 + e) * 72 + t] = f2bf(vv[e]);
      if (t == 0) p.Gc[ch * 64 + j0 + e] = __expf(gC);
    }
    uint4 o;
    o.x = pack2(ta[0], ta[1]); o.y = pack2(ta[2], ta[3]); o.z = pack2(ta[4], ta[5]); o.w = pack2(ta[6], ta[7]);
    *(uint4*)(At + t * 72 + j0) = o;
    o.x = pack2(tb[0], tb[1]); o.y = pack2(tb[2], tb[3]); o.z = pack2(tb[4], tb[5]); o.w = pack2(tb[6], tb[7]);
    *(uint4*)(Bt + t * 72 + j0) = o;
    o.x = pack2(tk[0], tk[1]); o.y = pack2(tk[2], tk[3]); o.z = pack2(tk[4], tk[5]); o.w = pack2(tk[6], tk[7]);
    *(uint4*)(Kt + t * 72 + j0) = o;
    o.x = pack2(tr[0], tr[1]); o.y = pack2(tr[2], tr[3]); o.z = pack2(tr[4], tr[5]); o.w = pack2(tr[6], tr[7]);
    *(uint4*)(Rt + t * 72 + j0) = o;
  }
  __syncthreads();
#pragma unroll
  for (int q = 0; q < 2; ++q) {
    const int id = w * 2 + q, mt = id >> 2, nt = id & 3;
    storeT(P0, 72, mt, nt, fr, fq, maskv(mm_tile(Bt, At, mt, nt, fr, fq, z4), mt, nt, fr, fq, 0));
    storeT(PT0, 72, mt, nt, fr, fq, maskv(mm_tile(At, Bt, mt, nt, fr, fq, z4), mt, nt, fr, fq, 2));
    storeT(Aak, 72, mt, nt, fr, fq, maskv(mm_tile(Kt, At, mt, nt, fr, fq, z4), mt, nt, fr, fq, 0));
    storeT(Arb, 72, mt, nt, fr, fq, maskv(mm_tile(Bt, Rt, mt, nt, fr, fq, z4), mt, nt, fr, fq, 1));
    storeT(Ark, 72, mt, nt, fr, fq, maskv(mm_tile(Kt, Rt, mt, nt, fr, fq, z4), mt, nt, fr, fq, 1));
  }
  __syncthreads();
  const int umt = w & 3, half = w >> 2;
  f32x4 u[4];
#pragma unroll
  for (int n = 0; n < 4; ++n) {
    if (half) u[n] = mm_tile(Aak, VT, umt, n, fr, fq, z4);
    else {
#pragma unroll
      for (int r = 0; r < 4; ++r) u[n][r] = bf2f(At[(umt * 16 + fq * 4 + r) * 72 + n * 16 + fr]);
    }
  }
  us* UTh = UT + half * 64 * 72;
#pragma unroll
  for (int n = 0; n < 4; ++n) storeT(UTh, 72, umt, n, fr, fq, u[n]);
  __syncthreads();
  for (int it = 0; it < 6; ++it) {
    const us* Pc = (it & 1) ? P1 : P0;
    const us* PTc = (it & 1) ? PT1 : PT0;
    us* Pn = (it & 1) ? P0 : P1;
    us* PTn = (it & 1) ? PT0 : PT1;
#pragma unroll
    for (int n = 0; n < 4; ++n) u[n] = mm_tile(Pc, UTh, umt, n, fr, fq, u[n]);
    if (it < 5) {
#pragma unroll
      for (int q = 0; q < 2; ++q) {
        const int id = w * 2 + q, mt = id >> 2, nt = id & 3;
        storeT(PTn, 72, mt, nt, fr, fq, mm_tile(Pc, PTc, mt, nt, fr, fq, z4));
        storeT(Pn, 72, mt, nt, fr, fq, mm_tile(PTc, Pc, mt, nt, fr, fq, z4));
      }
    }
    __syncthreads();
#pragma unroll
    for (int n = 0; n < 4; ++n) storeT(UTh, 72, umt, n, fr, fq, u[n]);
    __syncthreads();
  }
  {
    const int o = w >> 1;
    const us* U1 = UT;
    const us* U0 = UT + 64 * 72;
    for (int q = 0; q < 8; ++q) {
      const int id = (w & 1) * 8 + q, mt = id >> 2, nt = id & 3;
      if (o == 0) {
        f32x4 cc = mm_tile(U1, BhT, mt, nt, fr, fq, z4);
        storeT(p.Mp + (size_t)ch * 4096, 64, mt, nt, fr, fq, cc);
      } else if (o == 1) {
        f32x4 cc = mm_tile(BhT, U0, mt, nt, fr, fq, z4);
        cc = mm_tile(KhT, VT, mt, nt, fr, fq, cc);
        storeT(p.Nt + (size_t)ch * 4096, 64, mt, nt, fr, fq, cc);
      } else if (o == 2) {
        f32x4 cc = mm_tile(U1, Arb, mt, nt, fr, fq, z4);
#pragma unroll
        for (int r = 0; r < 4; ++r) cc[r] += bf2f(Rt[(nt * 16 + fr) * 72 + mt * 16 + fq * 4 + r]);
        storeT(p.Y1 + (size_t)ch * 4096, 64, mt, nt, fr, fq, cc);
      } else {
        f32x4 cc = mm_tile(Arb, U0, mt, nt, fr, fq, z4);
        cc = mm_tile(Ark, VT, mt, nt, fr, fq, cc);
        storeT(p.Y0t + (size_t)ch * 4096, 64, mt, nt, fr, fq, cc);
      }
    }
  }
  __syncthreads();
}

#define P3_COMMON \
  us* sm = (us*)smraw; \
  float* rs = (float*)(smraw + 2 * GST * 2); \
  const int tid = threadIdx.x, lane = tid & 63, wid = tid >> 6; \
  const int wx = wid >> 2, wy = wid & 3, fr = lane & 15, fq = lane >> 4;
__device__ void phase3q(const Params& p, unsigned char* smraw) {
  P3_COMMON
  for (int it = blockIdx.x; it < 6 * 128; it += gridDim.x) {
    {
      const int yt = it / 6, xt = it % 6, x0 = xt * 128, y0 = yt * 256;
      {
        const int tok = tid >> 1, hf = tid & 1;
        const us* src = p.projA + (size_t)(y0 + tok) * LDA_ + hf * 128;
        float ss = 0.f;
#pragma unroll
        for (int i = 0; i < 16; ++i) {
          bf16x8 v = *(const bf16x8*)(src + i * 8);
#pragma unroll
          for (int e = 0; e < 8; ++e) { float f = bf2f((us)v[e]); ss += f * f; }
        }
        ss += __shfl_xor(ss, 1);
        if (!hf) rs[tok] = rsqrtf(ss * (1.f / 256.f) + 1e-6f);
      }
      f32x4 acc[4][4];
      zero_acc(acc);
      gemm_main(p.Wt_uq + (size_t)x0 * 256, 256, p.projA + (size_t)y0 * LDA_, LDA_, 256, sm, acc);
#pragma unroll
      for (int j = 0; j < 4; ++j) {
        const int tl = wy * 64 + j * 16 + fr, tk = y0 + tl;
        const float rstd = rs[tl];
        const int bb = tk >> 12, s = tk & 4095;
#pragma unroll
        for (int i = 0; i < 4; ++i) {
          const int nb = x0 + wx * 64 + i * 16;
          const int hd = nb / 96, dq = nb % 96;
          us* qrow = p.Q + ((size_t)(bb * 8 + hd) * SEQ + s) * 96;
          if (dq < 64) {
            f32x4 v = acc[i][j] * rstd;
            *(uint2*)(qrow + dq + fq * 4) = pack4(v);
          } else if (dq == 64) {
            if (i < 3) {
              f32x4 t1 = acc[i][j] * rstd, t2 = acc[(i + 1) & 3][j] * rstd, o1, o2;
              const float4 cv = *(const float4*)(p.cs + (size_t)tk * 32 + fq * 4);
              const float4 sv = *(const float4*)(p.cs + (size_t)tk * 32 + 16 + fq * 4);
              o1[0] = t1[0] * cv.x - t2[0] * sv.x; o2[0] = t1[0] * sv.x + t2[0] * cv.x;
              o1[1] = t1[1] * cv.y - t2[1] * sv.y; o2[1] = t1[1] * sv.y + t2[1] * cv.y;
              o1[2] = t1[2] * cv.z - t2[2] * sv.z; o2[2] = t1[2] * sv.z + t2[2] * cv.z;
              o1[3] = t1[3] * cv.w - t2[3] * sv.w; o2[3] = t1[3] * sv.w + t2[3] * cv.w;
              *(uint2*)(qrow + 64 + fq * 4) = pack4(o1);
              *(uint2*)(qrow + 80 + fq * 4) = pack4(o2);
            }
          }
        }
      }
      __syncthreads();
    }
  }
}
__device__ void phase3kv(const Params& p, unsigned char* smraw) {
  P3_COMMON
  for (int it = blockIdx.x; it < 8 * 128; it += gridDim.x) {
    {
      const int r = it, yt = r >> 3, xt = r & 7, x0 = xt * 128, y0 = yt * 256;
      {
        const int tok = tid >> 1, hf = tid & 1;
        const us* src = p.projA + (size_t)(y0 + tok) * LDA_ + 256 + hf * 64;
        float ss = 0.f;
#pragma unroll
        for (int i = 0; i < 8; ++i) {
          bf16x8 v = *(const bf16x8*)(src + i * 8);
#pragma unroll
          for (int e = 0; e < 8; ++e) { float f = bf2f((us)v[e]); ss += f * f; }
        }
        ss += __shfl_xor(ss, 1);
        if (!hf) rs[tok] = rsqrtf(ss * (1.f / 128.f) + 1e-6f);
      }
      f32x4 acc[4][4];
      zero_acc(acc);
      gemm_main(p.Wt_ukv + (size_t)x0 * 128, 128, p.projA + (size_t)y0 * LDA_ + 256, LDA_, 128, sm, acc);
      const int hd = xt;
#pragma unroll
      for (int j = 0; j < 4; ++j) {
        const int tl = wy * 64 + j * 16 + fr, tk = y0 + tl;
        const float rstd = rs[tl];
        const int bb = tk >> 12, s = tk & 4095;
#pragma unroll
        for (int i = 0; i < 4; ++i) {
          const int rcol = wx * 64 + i * 16 + fq * 4;
          f32x4 v = acc[i][j] * rstd;
          if (wx == 0) {
            *(uint2*)(p.K + ((size_t)(bb * 8 + hd) * SEQ + s) * 96 + rcol) = pack4(v);
          } else {
            us* vb = p.Vt + ((size_t)(bb * 8 + hd) * 64 + (rcol - 64)) * SEQ + s;
#pragma unroll
            for (int q = 0; q < 4; ++q) vb[(size_t)q * SEQ] = f2bf(v[q]);
          }
        }
      }
      __syncthreads();
    }
  }
}
__device__ void phase3w(const Params& p, unsigned char* smraw) {
  const int tid = threadIdx.x;
  for (int it = blockIdx.x; it < 4096; it += gridDim.x) wkv_prep_item(p, it, smraw);
  const int gt = blockIdx.x * NTHR + tid, gs = gridDim.x * NTHR;
  for (int i = gt; i < T_TOK * 16; i += gs) {
    const int tk = i >> 4, pi = i & 15;
    const float k1 = bf2f(p.projA[(size_t)tk * LDA_ + 384 + pi]), k2 = bf2f(p.projA[(size_t)tk * LDA_ + 400 + pi]);
    const float cv = p.cs[tk * 32 + pi], sv = p.cs[tk * 32 + 16 + pi];
    const us o1 = f2bf(k1 * cv - k2 * sv), o2 = f2bf(k1 * sv + k2 * cv);
    const int bb = tk >> 12, s = tk & 4095;
#pragma unroll
    for (int hd = 0; hd < 8; ++hd) {
      us* kr = p.K + ((size_t)(bb * 8 + hd) * SEQ + s) * 96;
      kr[64 + pi] = o1;
      kr[80 + pi] = o2;
    }
  }
}

__device__ void wkv_scan_item(const Params& p, int item) {
  const int lane = threadIdx.x & 63, fr = lane & 15, fq = lane >> 4;
  const int bh = item >> 2, vs = item & 3;
  f32x4 H[4];
#pragma unroll
  for (int m = 0; m < 4; ++m) H[m] = f32x4{0.f, 0.f, 0.f, 0.f};
  for (int c = 0; c < 64; ++c) {
    const size_t ch = (size_t)bh * 64 + c;
    us* hh = p.Hh + ch * 4096 + (vs * 16 + fr) * 64 + fq * 4;
#pragma unroll
    for (int m = 0; m < 4; ++m) *(uint2*)(hh + m * 16) = pack4(H[m]);
    if (c == 63) break;
    const us* mp = p.Mp + ch * 4096;
    const us* nt = p.Nt + ch * 4096 + (vs * 16 + fr) * 64 + fq * 4;
    const float* gc = p.Gc + ch * 64 + fq * 4;
    bf16x8 bop[2];
#pragma unroll
    for (int ks = 0; ks < 2; ++ks) {
      uint2 lo = pack4(H[2 * ks]), hi = pack4(H[2 * ks + 1]);
      uint4 q4; q4.x = lo.x; q4.y = lo.y; q4.z = hi.x; q4.w = hi.y;
      bop[ks] = *(bf16x8*)&q4;
    }
    f32x4 Hn[4];
#pragma unroll
    for (int m = 0; m < 4; ++m) {
      const float4 g = *(const float4*)(gc + m * 16);
      const uint2 nn = *(const uint2*)(nt + m * 16);
      Hn[m][0] = g.x * H[m][0] + bf2f((us)(nn.x & 0xffff));
      Hn[m][1] = g.y * H[m][1] + bf2f((us)(nn.x >> 16));
      Hn[m][2] = g.z * H[m][2] + bf2f((us)(nn.y & 0xffff));
      Hn[m][3] = g.w * H[m][3] + bf2f((us)(nn.y >> 16));
#pragma unroll
      for (int ks = 0; ks < 2; ++ks) {
        const uint2 lo = *(const uint2*)(mp + (m * 16 + fr) * 64 + ks * 32 + fq * 4);
        const uint2 hi = *(const uint2*)(mp + (m * 16 + fr) * 64 + ks * 32 + 16 + fq * 4);
        uint4 q4; q4.x = lo.x; q4.y = lo.y; q4.z = hi.x; q4.w = hi.y;
        Hn[m] = mfma16(*(bf16x8*)&q4, bop[ks], Hn[m]);
      }
    }
#pragma unroll
    for (int m = 0; m < 4; ++m) H[m] = Hn[m];
  }
}

constexpr int AKS = 104, AVS = 68, ASTG = 64 * AKS + 64 * AVS;
__device__ void attn_item(const Params& p, int bh, int qt, unsigned char* smraw) {
  us* sm = (us*)smraw;
  const int tid = threadIdx.x, lane = tid & 63, w = tid >> 6, c = lane & 31, hh = lane >> 5;
  const int q0 = qt * 256;
  const us* Kg = p.K + (size_t)bh * SEQ * 96;
  const us* Vg = p.Vt + (size_t)bh * 64 * SEQ;
  bf16x8 qf[6];
  {
    const us* qb = p.Q + ((size_t)bh * SEQ + q0 + w * 32 + c) * 96 + 8 * hh;
#pragma unroll
    for (int s = 0; s < 6; ++s) qf[s] = *(const bf16x8*)(qb + 16 * s);
  }
  const int nkt = q0 / 64 + 4, mylim = q0 / 64 + (w >> 1);
  f32x16 ot0, ot1;
#pragma unroll
  for (int r = 0; r < 16; ++r) { ot0[r] = 0.f; ot1[r] = 0.f; }
  float mrun = -1e30f, lrun = 0.f;
  const int kr0 = tid / 12, kc0 = (tid % 12) * 8;
  const int kr1 = (tid + 512) / 12, kc1 = ((tid + 512) % 12) * 8;
  const int vr = tid >> 3, vc = (tid & 7) * 8;
  bf16x8 gk0, gk1, gv;
  gk0 = *(const bf16x8*)(Kg + (size_t)kr0 * 96 + kc0);
  if (tid < 256) gk1 = *(const bf16x8*)(Kg + (size_t)kr1 * 96 + kc1);
  gv = *(const bf16x8*)(Vg + (size_t)vr * SEQ + vc);
  {
    us* ks = sm; us* vsm = sm + 64 * AKS;
    *(bf16x8*)(ks + kr0 * AKS + kc0) = gk0;
    if (tid < 256) *(bf16x8*)(ks + kr1 * AKS + kc1) = gk1;
    const uint4 q4 = *(uint4*)&gv;
    *(uint2*)(vsm + vr * AVS + vc) = make_uint2(q4.x, q4.y);
    *(uint2*)(vsm + vr * AVS + vc + 4) = make_uint2(q4.z, q4.w);
  }
  __syncthreads();
  for (int kt = 0; kt < nkt; ++kt) {
    const int cur = kt & 1;
    if (kt + 1 < nkt) {
      const size_t kb = (size_t)(kt + 1) * 64;
      gk0 = *(const bf16x8*)(Kg + (kb + kr0) * 96 + kc0);
      if (tid < 256) gk1 = *(const bf16x8*)(Kg + (kb + kr1) * 96 + kc1);
      gv = *(const bf16x8*)(Vg + (size_t)vr * SEQ + kb + vc);
    }
    if (kt <= mylim) {
      const us* ks = sm + cur * ASTG;
      const us* vsm = ks + 64 * AKS;
      f32x16 s0, s1;
#pragma unroll
      for (int r = 0; r < 16; ++r) { s0[r] = 0.f; s1[r] = 0.f; }
#pragma unroll
      for (int s = 0; s < 6; ++s) {
        bf16x8 a0 = *(const bf16x8*)(ks + c * AKS + 16 * s + 8 * hh);
        bf16x8 a1 = *(const bf16x8*)(ks + (32 + c) * AKS + 16 * s + 8 * hh);
        s0 = mfma32(a0, qf[s], s0);
        s1 = mfma32(a1, qf[s], s1);
      }
      float mx = s0[0];
#pragma unroll
      for (int r = 1; r < 16; ++r) mx = fmaxf(mx, s0[r]);
#pragma unroll
      for (int r = 0; r < 16; ++r) mx = fmaxf(mx, s1[r]);
      mx = fmaxf(mx, __shfl_xor(mx, 32));
      const float mnew = fmaxf(mrun, mx);
      const float alpha = exp2f(mrun - mnew);
      mrun = mnew;
      float rsum = 0.f;
#pragma unroll
      for (int r = 0; r < 16; ++r) { s0[r] = exp2f(s0[r] - mnew); rsum += s0[r]; }
#pragma unroll
      for (int r = 0; r < 16; ++r) { s1[r] = exp2f(s1[r] - mnew); rsum += s1[r]; }
      rsum += __shfl_xor(rsum, 32);
      lrun = lrun * alpha + rsum;
#pragma unroll
      for (int r = 0; r < 16; ++r) { ot0[r] *= alpha; ot1[r] *= alpha; }
#pragma unroll
      for (int sub = 0; sub < 2; ++sub) {
#pragma unroll
        for (int s = 0; s < 2; ++s) {
          uint4 pq;
          if (sub == 0) {
            pq.x = pack2(s0[8 * s + 0], s0[8 * s + 1]); pq.y = pack2(s0[8 * s + 2], s0[8 * s + 3]);
            pq.z = pack2(s0[8 * s + 4], s0[8 * s + 5]); pq.w = pack2(s0[8 * s + 6], s0[8 * s + 7]);
          } else {
            pq.x = pack2(s1[8 * s + 0], s1[8 * s + 1]); pq.y = pack2(s1[8 * s + 2], s1[8 * s + 3]);
            pq.z = pack2(s1[8 * s + 4], s1[8 * s + 5]); pq.w = pack2(s1[8 * s + 6], s1[8 * s + 7]);
          }
          const bf16x8 pb = *(bf16x8*)&pq;
          const int kb = 32 * sub + 16 * s + 4 * hh;
          {
            const uint2 lo = *(const uint2*)(vsm + c * AVS + kb);
            const uint2 hi = *(const uint2*)(vsm + c * AVS + kb + 8);
            uint4 q4; q4.x = lo.x; q4.y = lo.y; q4.z = hi.x; q4.w = hi.y;
            ot0 = mfma32(*(bf16x8*)&q4, pb, ot0);
          }
          {
            const uint2 lo = *(const uint2*)(vsm + (32 + c) * AVS + kb);
            const uint2 hi = *(const uint2*)(vsm + (32 + c) * AVS + kb + 8);
            uint4 q4; q4.x = lo.x; q4.y = lo.y; q4.z = hi.x; q4.w = hi.y;
            ot1 = mfma32(*(bf16x8*)&q4, pb, ot1);
          }
        }
      }
    }
    if (kt + 1 < nkt) {
      us* ks = sm + (cur ^ 1) * ASTG; us* vsm = ks + 64 * AKS;
      *(bf16x8*)(ks + kr0 * AKS + kc0) = gk0;
      if (tid < 256) *(bf16x8*)(ks + kr1 * AKS + kc1) = gk1;
      const uint4 q4 = *(uint4*)&gv;
      *(uint2*)(vsm + vr * AVS + vc) = make_uint2(q4.x, q4.y);
      *(uint2*)(vsm + vr * AVS + vc + 4) = make_uint2(q4.z, q4.w);
    }
    __syncthreads();
  }
  {
    const float inv = 1.f / lrun;
    const int b = bh >> 3, hd = bh & 7;
    const size_t tk = (size_t)b * SEQ + q0 + w * 32 + c;
    const us* ga = p.projB + tk * LDB_ + hd * 64;
    us* zo = p.za + tk * 512 + hd * 64;
#pragma unroll
    for (int dt = 0; dt < 2; ++dt) {
#pragma unroll
      for (int g = 0; g < 4; ++g) {
        const int d0 = 32 * dt + 8 * g + 4 * hh;
        const uint2 gg = *(const uint2*)(ga + d0);
        f32x4 v;
        if (dt == 0) { v[0] = ot0[4 * g]; v[1] = ot0[4 * g + 1]; v[2] = ot0[4 * g + 2]; v[3] = ot0[4 * g + 3]; }
        else { v[0] = ot1[4 * g]; v[1] = ot1[4 * g + 1]; v[2] = ot1[4 * g + 2]; v[3] = ot1[4 * g + 3]; }
        v[0] *= inv * bf2f((us)(gg.x & 0xffff)); v[1] *= inv * bf2f((us)(gg.x >> 16));
        v[2] *= inv * bf2f((us)(gg.y & 0xffff)); v[3] *= inv * bf2f((us)(gg.y >> 16));
        *(uint2*)(zo + d0) = pack4(v);
      }
    }
  }
}

__device__ void phase4(const Params& p, unsigned char* smraw) {
  const int wid = threadIdx.x >> 6;
  if (wid == 0)
    for (int it = blockIdx.x; it < 256; it += gridDim.x) wkv_scan_item(p, it);
  const int G = gridDim.x;
  for (int r = 0;; ++r) {
    const int pos = (r & 1) ? (G - 1 - (int)blockIdx.x) : (int)blockIdx.x;
    const int k = r * G + pos;
    if (r * G >= 1024) break;
    if (k < 1024) attn_item(p, k & 63, 15 - (k >> 6), smraw);
  }
}

__device__ void phase5(const Params& p) {
  const int lane = threadIdx.x & 63, wid = threadIdx.x >> 6, fr = lane & 15, fq = lane >> 4;
  for (int it = blockIdx.x * 8 + wid; it < 4096 * 4; it += gridDim.x * 8) {
    const int ch = it >> 2, mt = it & 3;
    const int bh = ch >> 6, cc = ch & 63, b = bh >> 3, hd = bh & 7;
    const us* y1 = p.Y1 + (size_t)ch * 4096;
    const us* hh = p.Hh + (size_t)ch * 4096;
    const us* y0 = p.Y0t + (size_t)ch * 4096;
    bf16x8 a[2];
#pragma unroll
    for (int ks = 0; ks < 2; ++ks) a[ks] = *(const bf16x8*)(y1 + (mt * 16 + fr) * 64 + ks * 32 + fq * 8);
    f32x4 y[4];
#pragma unroll
    for (int nt = 0; nt < 4; ++nt) {
      const uint2 yy = *(const uint2*)(y0 + (nt * 16 + fr) * 64 + mt * 16 + fq * 4);
      y[nt][0] = bf2f((us)(yy.x & 0xffff)); y[nt][1] = bf2f((us)(yy.x >> 16));
      y[nt][2] = bf2f((us)(yy.y & 0xffff)); y[nt][3] = bf2f((us)(yy.y >> 16));
#pragma unroll
      for (int ks = 0; ks < 2; ++ks) {
        bf16x8 bq = *(const bf16x8*)(hh + (nt * 16 + fr) * 64 + ks * 32 + fq * 8);
        y[nt] = mfma16(a[ks], bq, y[nt]);
      }
    }
    f32x4 s1 = y[0] + y[1] + y[2] + y[3];
#pragma unroll
    for (int o = 1; o < 16; o <<= 1)
#pragma unroll
      for (int r = 0; r < 4; ++r) s1[r] += __shfl_xor(s1[r], o);
    f32x4 mean = s1 * (1.f / 64.f);
    f32x4 s2 = {0.f, 0.f, 0.f, 0.f};
#pragma unroll
    for (int nt = 0; nt < 4; ++nt) { y[nt] -= mean; s2 += y[nt] * y[nt]; }
#pragma unroll
    for (int o = 1; o < 16; o <<= 1)
#pragma unroll
      for (int r = 0; r < 4; ++r) s2[r] += __shfl_xor(s2[r], o);
    f32x4 rstd;
#pragma unroll
    for (int r = 0; r < 4; ++r) rstd[r] = rsqrtf(s2[r] * (1.f / 64.f) + 64e-5f);
    const size_t tk0 = (size_t)b * SEQ + cc * 64 + mt * 16 + fq * 4;
#pragma unroll
    for (int nt = 0; nt < 4; ++nt) {
      const int ci = hd * 64 + nt * 16 + fr;
      const float gg = p.gn_g[ci], gb = p.gn_b[ci];
#pragma unroll
      for (int r = 0; r < 4; ++r) {
        const size_t tk = tk0 + r;
        float v = y[nt][r] * rstd[r] * gg + gb + bf2f(p.bv[tk * 512 + ci]);
        v *= bf2f(p.projB[tk * LDB_ + 512 + ci]);
        p.zb[tk * 512 + ci] = f2bf(v);
      }
    }
  }
}

__device__ void phase6(const Params& p, unsigned char* smraw) {
  us* sm = (us*)smraw;
  const int lane = threadIdx.x & 63, wid = threadIdx.x >> 6;
  const int wx = wid >> 2, wy = wid & 3, fr = lane & 15, fq = lane >> 4;
  for (int tile = blockIdx.x; tile < 8 * 128; tile += gridDim.x) {
    const int yt = tile >> 3, xt = tile & 7, x0 = xt * 128, y0 = yt * 256;
    f32x4 acc[4][4], acc2[4][4];
    zero_acc(acc);
    zero_acc(acc2);
    gemm_main(p.Wt_pa + (size_t)x0 * 512, 512, p.za + (size_t)y0 * 512, 512, 512, sm, acc);
    gemm_main(p.Wt_pb + (size_t)x0 * 512, 512, p.zb + (size_t)y0 * 512, 512, 512, sm, acc2);
#pragma unroll
    for (int i = 0; i < 4; ++i)
#pragma unroll
      for (int j = 0; j < 4; ++j) {
        const int n = x0 + wx * 64 + i * 16 + fq * 4;
        const size_t t = y0 + wy * 64 + j * 16 + fr;
        const uint2 ga = *(const uint2*)(p.projB + t * LDB_ + 1024 + n);
        const uint2 gb = *(const uint2*)(p.projB + t * LDB_ + 2048 + n);
        f32x4 v;
        v[0] = bf2f((us)(ga.x & 0xffff)) * acc[i][j][0] + bf2f((us)(gb.x & 0xffff)) * acc2[i][j][0];
        v[1] = bf2f((us)(ga.x >> 16)) * acc[i][j][1] + bf2f((us)(gb.x >> 16)) * acc2[i][j][1];
        v[2] = bf2f((us)(ga.y & 0xffff)) * acc[i][j][2] + bf2f((us)(gb.y & 0xffff)) * acc2[i][j][2];
        v[3] = bf2f((us)(ga.y >> 16)) * acc[i][j][3] + bf2f((us)(gb.y >> 16)) * acc2[i][j][3];
        *(uint2*)(p.merged + t * 1024 + n) = pack4(v);
      }
  }
}

__device__ void phase7(const Params& p, unsigned char* smraw) {
  us* sm = (us*)smraw;
  const int lane = threadIdx.x & 63, wid = threadIdx.x >> 6;
  const int wx = wid >> 2, wy = wid & 3, fr = lane & 15, fq = lane >> 4;
  for (int tile = blockIdx.x; tile < 8 * 128; tile += gridDim.x) {
    const int yt = tile >> 3, xt = tile & 7, x0 = xt * 128, y0 = yt * 256;
    f32x4 acc[4][4];
    zero_acc(acc);
    gemm_main(p.Wt_out + (size_t)x0 * 1024, 1024, p.merged + (size_t)y0 * 1024, 1024, 1024, sm, acc);
    const float* gate = p.mod + (y0 >> 12) * 3072 + 2048;
#pragma unroll
    for (int j = 0; j < 4; ++j) {
      const size_t t = y0 + wy * 64 + j * 16 + fr;
      float s1 = 0.f, s2 = 0.f;
#pragma unroll
      for (int i = 0; i < 4; ++i) {
        const int n = x0 + wx * 64 + i * 16 + fq * 4;
        const float4 xv = *(const float4*)(p.x + t * 1024 + n);
        const float4 gv = *(const float4*)(gate + n);
        float4 z;
        z.x = ALPHA_ * xv.x + (1.f + gv.x) * acc[i][j][0];
        z.y = ALPHA_ * xv.y + (1.f + gv.y) * acc[i][j][1];
        z.z = ALPHA_ * xv.z + (1.f + gv.z) * acc[i][j][2];
        z.w = ALPHA_ * xv.w + (1.f + gv.w) * acc[i][j][3];
        *(float4*)(p.out + t * 1024 + n) = z;
        s1 += z.x + z.y + z.z + z.w;
        s2 += z.x * z.x + z.y * z.y + z.z * z.z + z.w * z.w;
      }
      s1 += __shfl_xor(s1, 16); s1 += __shfl_xor(s1, 32);
      s2 += __shfl_xor(s2, 16); s2 += __shfl_xor(s2, 32);
      if (fq == 0) { atomicAdd(p.stats + t * 2, s1); atomicAdd(p.stats + t * 2 + 1, s2); }
    }
  }
}

__device__ void phase8(const Params& p) {
  const int lane = threadIdx.x & 63, wid = threadIdx.x >> 6;
  for (int row = blockIdx.x * 8 + wid; row < T_TOK; row += gridDim.x * 8) {
    const float mean = p.stats[row * 2] * (1.f / 1024.f);
    const float var = p.stats[row * 2 + 1] * (1.f / 1024.f) - mean * mean;
    const float rstd = rsqrtf(fmaxf(var, 0.f) + 1e-5f);
    float4* zr = (float4*)(p.out + (size_t)row * DM);
#pragma unroll
    for (int i = 0; i < 4; ++i) {
      const int c4 = i * 64 + lane;
      float4 v = zr[c4];
      const float4 g = ((const float4*)p.post_g)[c4], bb = ((const float4*)p.post_b)[c4];
      v.x = (v.x - mean) * rstd * g.x + bb.x; v.y = (v.y - mean) * rstd * g.y + bb.y;
      v.z = (v.z - mean) * rstd * g.z + bb.z; v.w = (v.w - mean) * rstd * g.w + bb.w;
      zr[c4] = v;
    }
  }
}

#ifdef ONE_LAUNCH
__global__ void __launch_bounds__(NTHR) fwd_kernel(Params p) {
  extern __shared__ __attribute__((aligned(16))) unsigned char smraw[];
  cg::grid_group grid = cg::this_grid();
  phase0(p, smraw); grid.sync();
  phase1(p); grid.sync();
  phase2(p, smraw); grid.sync();
  phase3q(p, smraw); phase3kv(p, smraw); phase3w(p, smraw); grid.sync();
  phase4(p, smraw); grid.sync();
  phase5(p); grid.sync();
  phase6(p, smraw); grid.sync();
  phase7(p, smraw); grid.sync();
  phase8(p);
}
#else
#define PK(name, call) __global__ void __launch_bounds__(NTHR) name(Params p) { \
  extern __shared__ __attribute__((aligned(16))) unsigned char smraw[]; call; }
PK(k_p0, phase0(p, smraw)) PK(k_p1, phase1(p)) PK(k_p2, phase2(p, smraw)) PK(k_p3q, phase3q(p, smraw))
PK(k_p3kv, phase3kv(p, smraw)) PK(k_p3w, phase3w(p, smraw)) PK(k_p4, phase4(p, smraw)) PK(k_p5, phase5(p))
PK(k_p6, phase6(p, smraw)) PK(k_p7, phase7(p, smraw)) PK(k_p8, phase8(p))
#endif

extern "C" void kernel_launch(void* const* d_in, const int* in_sizes, int n_in, void* d_out, int out_size,
                              void* d_ws, size_t ws_size, hipStream_t stream) {
  static int grid_blocks = 0;
#ifdef ONE_LAUNCH
  if (!grid_blocks) {
    int dev = 0, cus = 0, per_cu = 0;
    (void)hipGetDevice(&dev);
    (void)hipDeviceGetAttribute(&cus, hipDeviceAttributeMultiprocessorCount, dev);
    (void)hipFuncSetAttribute((const void*)fwd_kernel, hipFuncAttributeMaxDynamicSharedMemorySize, LDSB);
    (void)hipOccupancyMaxActiveBlocksPerMultiprocessor(&per_cu, fwd_kernel, NTHR, LDSB);
    if (per_cu < 1) per_cu = 1;
    grid_blocks = cus * per_cu;
  }
#else
  if (!grid_blocks) {
    const void* ks[] = {(const void*)k_p0, (const void*)k_p1, (const void*)k_p2, (const void*)k_p3q, (const void*)k_p3kv,
                        (const void*)k_p3w, (const void*)k_p4, (const void*)k_p5, (const void*)k_p6, (const void*)k_p7,
                        (const void*)k_p8};
    for (int i = 0; i < 11; ++i) (void)hipFuncSetAttribute(ks[i], hipFuncAttributeMaxDynamicSharedMemorySize, LDSB);
    grid_blocks = 256;
  }
#endif
  Params p{};
  p.x = (const float*)d_in[0]; p.c = (const float*)d_in[1]; p.pos = (const int*)d_in[2];
  p.w_ada = (const float*)d_in[3]; p.b_ada = (const float*)d_in[4]; p.w_in = (const float*)d_in[5];
  p.q_norm_g = (const float*)d_in[6]; p.w_uq = (const float*)d_in[7]; p.kv_norm_g = (const float*)d_in[8];
  p.w_ukv = (const float*)d_in[9]; p.mu = (const float*)d_in[10]; p.w0 = (const float*)d_in[11];
  p.w_dec = (const float*)d_in[12]; p.a0 = (const float*)d_in[13]; p.w_icl = (const float*)d_in[14];
  p.k_k = (const float*)d_in[15]; p.k_a = (const float*)d_in[16]; p.r_k = (const float*)d_in[17];
  p.gn_g = (const float*)d_in[18]; p.gn_b = (const float*)d_in[19]; p.w_pa = (const float*)d_in[20];
  p.w_pb = (const float*)d_in[21]; p.w_out = (const float*)d_in[22]; p.post_g = (const float*)d_in[23];
  p.post_b = (const float*)d_in[24];
  p.out = (float*)d_out;
  unsigned char* ws = (unsigned char*)d_ws;
  size_t off = 0;
  auto take = [&](size_t bytes) { unsigned char* r = ws + off; off += (bytes + 255) & ~(size_t)255; return r; };
  const size_t MiB = 1u << 20;
  p.mod = (float*)take(8 * 3072 * 4);
  p.cs = (float*)take((size_t)T_TOK * 32 * 4);
  p.stats = (float*)take((size_t)T_TOK * 2 * 4);
  p.Gc = (float*)take(4096 * 64 * 4);
  p.Wt_in = (us*)take((size_t)5376 * 1024 * 2);
  p.Wt_uq = (us*)take(768 * 256 * 2);
  p.Wt_ukv = (us*)take(1024 * 128 * 2);
  p.Wt_dec = (us*)take(512 * 64 * 2);
  p.Wt_icl = (us*)take(512 * 64 * 2);
  p.Wt_pa = (us*)take(1024 * 512 * 2);
  p.Wt_pb = (us*)take(1024 * 512 * 2);
  p.Wt_out = (us*)take(1024 * 1024 * 2);
  unsigned char* r1 = take(64 * MiB);
  unsigned char* r2 = take((size_t)T_TOK * LDA_ * 2);
  p.projB = (us*)take((size_t)T_TOK * LDB_ * 2);
  p.Y1 = (us*)take(32 * MiB);
  p.Y0t = (us*)take(32 * MiB);
  p.bv = (us*)take(32 * MiB);
  p.h = (us*)r1; p.Mp = (us*)r1; p.Nt = (us*)(r1 + 32 * MiB); p.merged = (us*)r1;
  p.projA = (us*)r2; p.Hh = (us*)r2; p.za = (us*)(r2 + 32 * MiB); p.zb = (us*)(r2 + 64 * MiB);
  unsigned char* ob = (unsigned char*)d_out;
  p.Q = (us*)ob; p.K = (us*)(ob + 48 * MiB); p.Vt = (us*)(ob + 96 * MiB);
  if (off > ws_size) { fprintf(stderr, "workspace too small: need %zu have %zu\n", off, ws_size); return; }
#ifndef ONE_LAUNCH
  const dim3 g(grid_blocks), bdim(NTHR);
  k_p0<<<g, bdim, LDSB, stream>>>(p);
  k_p1<<<g, bdim, LDSB, stream>>>(p);
  k_p2<<<g, bdim, LDSB, stream>>>(p);
  k_p3q<<<g, bdim, LDSB, stream>>>(p);
  k_p3kv<<<g, bdim, LDSB, stream>>>(p);
  k_p3w<<<g, bdim, LDSB, stream>>>(p);
  k_p4<<<g, bdim, LDSB, stream>>>(p);
  k_p5<<<g, bdim, LDSB, stream>>>(p);
  k_p6<<<g, bdim, LDSB, stream>>>(p);
  k_p7<<<g, bdim, LDSB, stream>>>(p);
  k_p8<<<g, bdim, LDSB, stream>>>(p);
#else
  void* args[] = {&p};
  hipError_t e = hipLaunchCooperativeKernel((void*)fwd_kernel, dim3(grid_blocks), dim3(NTHR), args, LDSB, stream);
  if (e != hipSuccess) fprintf(stderr, "cooperative launch failed: %s (grid %d)\n", hipGetErrorString(e), grid_blocks);
#endif
}
```

```cpp
#include <hip/hip_runtime.h>
#include <hip/hip_cooperative_groups.h>
#include <cstdio>
#include <cstdint>
namespace cg = cooperative_groups;
#define ONE_LAUNCH 1

typedef unsigned short us;
typedef __attribute__((ext_vector_type(8))) short bf16x8;
typedef __attribute__((ext_vector_type(4))) float f32x4;
typedef __attribute__((ext_vector_type(16))) float f32x16;
#define DEVI __device__ __forceinline__

constexpr int T_TOK = 32768, SEQ = 4096, DM = 1024;
constexpr int LDA_ = 2080;
constexpr int LDB_ = 3072;
constexpr int NTHR = 512;
constexpr int LDSB = 16 * 9216 + 2048;
constexpr float QSCALE = 0.10206207261596575f * 1.4426950408889634f;
constexpr float ALPHA_ = 1.189207115002721f;

struct Params {
  const float *x, *c; const int* pos;
  const float *w_ada, *b_ada, *w_in, *q_norm_g, *w_uq, *kv_norm_g, *w_ukv, *mu, *w0, *w_dec, *a0, *w_icl,
      *k_k, *k_a, *r_k, *gn_g, *gn_b, *w_pa, *w_pb, *w_out, *post_g, *post_b;
  float* out;
  float *mod, *cs, *stats, *Gc;
  us *Wt_in, *Wt_uq, *Wt_ukv, *Wt_dec, *Wt_icl, *Wt_pa, *Wt_pb, *Wt_out;
  us *h, *projA, *projB, *Q, *K, *Vt, *za, *zb, *bv, *Mp, *Nt, *Y1, *Y0t, *Hh, *merged;
};

DEVI us f2bf(float f) { unsigned u = __float_as_uint(f); u += 0x7fffu + ((u >> 16) & 1u); return (us)(u >> 16); }
DEVI float bf2f(us h) { return __uint_as_float(((unsigned)h) << 16); }
DEVI unsigned pack2(float a, float b) { return (unsigned)f2bf(a) | ((unsigned)f2bf(b) << 16); }
DEVI uint2 pack4(f32x4 v) { uint2 r; r.x = pack2(v[0], v[1]); r.y = pack2(v[2], v[3]); return r; }
DEVI f32x4 mfma16(bf16x8 a, bf16x8 b, f32x4 c) { return __builtin_amdgcn_mfma_f32_16x16x32_bf16(a, b, c, 0, 0, 0); }
DEVI f32x16 mfma32(bf16x8 a, bf16x8 b, f32x16 c) { return __builtin_amdgcn_mfma_f32_32x32x16_bf16(a, b, c, 0, 0, 0); }
DEVI float sigmoidf_(float v) { return 1.f / (1.f + __expf(-v)); }
DEVI float siluf_(float v) { return v / (1.f + __expf(-v)); }

__device__ void phase0(const Params& p, unsigned char* smraw) {
  float* smf = (float*)smraw;
  const int tid = threadIdx.x;
  for (int it = blockIdx.x; it < 1952; it += gridDim.x) {
    if (it < 1904) {
      const float* src; us* dst; int K, N, kt, nt; const float* rs = nullptr; float sc = 1.f; int r = it;
      if (r < 1296) { src = p.w_in; dst = p.Wt_in; K = 1024; N = 5152; kt = r / 81; nt = r % 81; }
      else if ((r -= 1296) < 48) { src = p.w_uq; dst = p.Wt_uq; K = 256; N = 768; kt = r / 12; nt = r % 12; rs = p.q_norm_g; sc = QSCALE; }
      else if ((r -= 48) < 32) { src = p.w_ukv; dst = p.Wt_ukv; K = 128; N = 1024; kt = r / 16; nt = r % 16; rs = p.kv_norm_g; }
      else if ((r -= 32) < 8) { src = p.w_dec; dst = p.Wt_dec; K = 64; N = 512; kt = 0; nt = r; }
      else if ((r -= 8) < 8) { src = p.w_icl; dst = p.Wt_icl; K = 64; N = 512; kt = 0; nt = r; }
      else if ((r -= 8) < 128) { src = p.w_pa; dst = p.Wt_pa; K = 512; N = 1024; kt = r / 16; nt = r % 16; }
      else if ((r -= 128) < 128) { src = p.w_pb; dst = p.Wt_pb; K = 512; N = 1024; kt = r / 16; nt = r % 16; }
      else { r -= 128; src = p.w_out; dst = p.Wt_out; K = 1024; N = 1024; kt = r / 16; nt = r % 16; }
      const int nl = tid & 63, kb = tid >> 6;
#pragma unroll
      for (int i = 0; i < 8; ++i) {
        int k = kb + 8 * i, n = nt * 64 + nl;
        float v = 0.f;
        if (n < N) v = src[(size_t)(kt * 64 + k) * N + n];
        if (rs) v *= rs[kt * 64 + k];
        smf[k * 65 + nl] = v * sc;
      }
      __syncthreads();
      const int n = tid >> 3, kq = tid & 7;
      if (nt * 64 + n < N) {
        uint4 o;
        o.x = pack2(smf[(kq * 8 + 0) * 65 + n], smf[(kq * 8 + 1) * 65 + n]);
        o.y = pack2(smf[(kq * 8 + 2) * 65 + n], smf[(kq * 8 + 3) * 65 + n]);
        o.z = pack2(smf[(kq * 8 + 4) * 65 + n], smf[(kq * 8 + 5) * 65 + n]);
        o.w = pack2(smf[(kq * 8 + 6) * 65 + n], smf[(kq * 8 + 7) * 65 + n]);
        *(uint4*)(dst + (size_t)(nt * 64 + n) * K + kt * 64 + kq * 8) = o;
      }
      __syncthreads();
    } else {
      const int n0 = (it - 1904) * 64;
      for (int i = tid; i < 8192; i += NTHR) smf[i] = siluf_(p.c[i]);
      __syncthreads();
      const int nl = tid & 63, kg = tid >> 6;
      float acc[8];
#pragma unroll
      for (int b = 0; b < 8; ++b) acc[b] = 0.f;
      for (int k = kg * 128; k < kg * 128 + 128; ++k) {
        float w = p.w_ada[(size_t)k * 3072 + n0 + nl];
#pragma unroll
        for (int b = 0; b < 8; ++b) acc[b] += smf[b * 1024 + k] * w;
      }
      float* red = smf + 8192;
#pragma unroll
      for (int b = 0; b < 8; ++b) red[(kg * 8 + b) * 64 + nl] = acc[b];
      __syncthreads();
      {
        const int b = tid >> 6;
        float s = p.b_ada[n0 + nl];
#pragma unroll
        for (int g = 0; g < 8; ++g) s += red[(g * 8 + b) * 64 + nl];
        p.mod[b * 3072 + n0 + nl] = s;
      }
      __syncthreads();
    }
  }
  const int gt = blockIdx.x * NTHR + tid, gs = gridDim.x * NTHR;
  for (int i = gt; i < T_TOK * 16; i += gs) {
    int t = i >> 4, pi = i & 15;
    double ang = (double)p.pos[t] * pow(10000.0, -(double)pi / 16.0);
    p.cs[t * 32 + pi] = (float)cos(ang);
    p.cs[t * 32 + 16 + pi] = (float)sin(ang);
  }
  for (int i = gt; i < T_TOK * 2; i += gs) p.stats[i] = 0.f;
  unsigned* padz = (unsigned*)(p.Wt_in + (size_t)5152 * 1024);
  for (int i = gt; i < 224 * 512; i += gs) padz[i] = 0u;
}

__device__ void phase1(const Params& p) {
  const int lane = threadIdx.x & 63, wid = threadIdx.x >> 6;
  for (int row = blockIdx.x * 8 + wid; row < T_TOK; row += gridDim.x * 8) {
    const float4* xr = (const float4*)(p.x + (size_t)row * DM);
    float4 v[4];
#pragma unroll
    for (int i = 0; i < 4; ++i) v[i] = xr[i * 64 + lane];
    float s = 0.f;
#pragma unroll
    for (int i = 0; i < 4; ++i) s += v[i].x + v[i].y + v[i].z + v[i].w;
#pragma unroll
    for (int o = 32; o; o >>= 1) s += __shfl_xor(s, o);
    const float mean = s * (1.f / 1024.f);
    float q = 0.f;
#pragma unroll
    for (int i = 0; i < 4; ++i) {
      v[i].x -= mean; v[i].y -= mean; v[i].z -= mean; v[i].w -= mean;
      q += v[i].x * v[i].x + v[i].y * v[i].y + v[i].z * v[i].z + v[i].w * v[i].w;
    }
#pragma unroll
    for (int o = 32; o; o >>= 1) q += __shfl_xor(q, o);
    const float rstd = rsqrtf(q * (1.f / 1024.f) + 1e-5f);
    const float* md = p.mod + (row >> 12) * 3072;
#pragma unroll
    for (int i = 0; i < 4; ++i) {
      const int col = i * 256 + lane * 4;
      float4 sh = *(const float4*)(md + col), scl = *(const float4*)(md + 1024 + col);
      uint2 o;
      o.x = pack2(v[i].x * rstd * (1.f + scl.x) + sh.x, v[i].y * rstd * (1.f + scl.y) + sh.y);
      o.y = pack2(v[i].z * rstd * (1.f + scl.z) + sh.z, v[i].w * rstd * (1.f + scl.w) + sh.w);
      *(uint2*)(p.h + (size_t)row * DM + col) = o;
    }
  }
}

constexpr int GST = 384 * 72;
DEVI void gemm_main(const us* __restrict__ X, int ldx, const us* __restrict__ Y, int ldy, int K, us* sm,
                    f32x4 (&acc)[4][4]) {
  const int tid = threadIdx.x, lane = tid & 63, wid = tid >> 6;
  const int wx = wid >> 2, wy = wid & 3, fr = lane & 15, fq = lane >> 4;
  const int sr = tid >> 3, sc = (tid & 7) * 8;
  bf16x8 gx[2], gy[4];
#pragma unroll
  for (int i = 0; i < 2; ++i) gx[i] = *(const bf16x8*)(X + (size_t)(sr + i * 64) * ldx + sc);
#pragma unroll
  for (int i = 0; i < 4; ++i) gy[i] = *(const bf16x8*)(Y + (size_t)(sr + i * 64) * ldy + sc);
#pragma unroll
  for (int i = 0; i < 2; ++i) *(bf16x8*)(sm + (sr + i * 64) * 72 + sc) = gx[i];
#pragma unroll
  for (int i = 0; i < 4; ++i) *(bf16x8*)(sm + (128 + sr + i * 64) * 72 + sc) = gy[i];
  __syncthreads();
  const int nk = K >> 6;
  for (int kt = 0; kt < nk; ++kt) {
    const int cur = kt & 1;
    if (kt + 1 < nk) {
      const int k0 = (kt + 1) * 64 + sc;
#pragma unroll
      for (int i = 0; i < 2; ++i) gx[i] = *(const bf16x8*)(X + (size_t)(sr + i * 64) * ldx + k0);
#pragma unroll
      for (int i = 0; i < 4; ++i) gy[i] = *(const bf16x8*)(Y + (size_t)(sr + i * 64) * ldy + k0);
    }
    const us* xs = sm + cur * GST;
    const us* ys = xs + 128 * 72;
#pragma unroll
    for (int ks = 0; ks < 2; ++ks) {
      bf16x8 a[4], b[4];
#pragma unroll
      for (int i = 0; i < 4; ++i) a[i] = *(const bf16x8*)(xs + (wx * 64 + i * 16 + fr) * 72 + ks * 32 + fq * 8);
#pragma unroll
      for (int j = 0; j < 4; ++j) b[j] = *(const bf16x8*)(ys + (wy * 64 + j * 16 + fr) * 72 + ks * 32 + fq * 8);
#pragma unroll
      for (int i = 0; i < 4; ++i)
#pragma unroll
        for (int j = 0; j < 4; ++j) acc[i][j] = mfma16(a[i], b[j], acc[i][j]);
    }
    if (kt + 1 < nk) {
      us* xn = sm + (cur ^ 1) * GST;
#pragma unroll
      for (int i = 0; i < 2; ++i) *(bf16x8*)(xn + (sr + i * 64) * 72 + sc) = gx[i];
#pragma unroll
      for (int i = 0; i < 4; ++i) *(bf16x8*)(xn + (128 + sr + i * 64) * 72 + sc) = gy[i];
    }
    __syncthreads();
  }
}
DEVI void zero_acc(f32x4 (&acc)[4][4]) {
#pragma unroll
  for (int i = 0; i < 4; ++i)
#pragma unroll
    for (int j = 0; j < 4; ++j) acc[i][j] = f32x4{0.f, 0.f, 0.f, 0.f};
}

__device__ void phase2(const Params& p, unsigned char* smraw) {
  us* sm = (us*)smraw;
  const int lane = threadIdx.x & 63, wid = threadIdx.x >> 6;
  const int wx = wid >> 2, wy = wid & 3, fr = lane & 15, fq = lane >> 4;
  for (int tile = blockIdx.x; tile < 41 * 128; tile += gridDim.x) {
    const int yt = tile / 41, xt = tile % 41;
    const int x0 = xt * 128, y0 = yt * 256;
    f32x4 acc[4][4];
    zero_acc(acc);
    gemm_main(p.Wt_in + (size_t)x0 * 1024, 1024, p.h + (size_t)y0 * 1024, 1024, 1024, sm, acc);
#pragma unroll
    for (int i = 0; i < 4; ++i) {
      const int nb = x0 + wx * 64 + i * 16;
      if (nb >= 5152) continue;
      us* dst; int ld, col, act;
      if (nb < 416) { dst = p.projA; ld = LDA_; col = nb; act = 0; }
      else if (nb < 928) { dst = p.projB; ld = LDB_; col = nb - 416; act = 1; }
      else if (nb < 2592) { dst = p.projA; ld = LDA_; col = nb - 928 + 416; act = 0; }
      else if (nb < 3104) { dst = p.projB; ld = LDB_; col = nb - 2592 + 512; act = 1; }
      else { dst = p.projB; ld = LDB_; col = nb - 3104 + 1024; act = 2; }
#pragma unroll
      for (int j = 0; j < 4; ++j) {
        const int t = y0 + wy * 64 + j * 16 + fr;
        f32x4 v = acc[i][j];
        if (act == 1) { for (int r = 0; r < 4; ++r) v[r] = siluf_(v[r]); }
        else if (act == 2) { for (int r = 0; r < 4; ++r) v[r] = sigmoidf_(v[r]); }
        *(uint2*)(dst + (size_t)t * ld + col + fq * 4) = pack4(v);
      }
    }
  }
}

#define REG_(i) ((us*)(smraw + (i) * 9216))
DEVI f32x4 mm_tile(const us* A, const us* B, int mt, int nt, int fr, int fq, f32x4 acc) {
#pragma unroll
  for (int ks = 0; ks < 2; ++ks) {
    bf16x8 a = *(const bf16x8*)(A + (mt * 16 + fr) * 72 + ks * 32 + fq * 8);
    bf16x8 b = *(const bf16x8*)(B + (nt * 16 + fr) * 72 + ks * 32 + fq * 8);
    acc = mfma16(a, b, acc);
  }
  return acc;
}
DEVI void storeT(us* dst, int ld, int mt, int nt, int fr, int fq, f32x4 v) {
  *(uint2*)(dst + (nt * 16 + fr) * ld + mt * 16 + fq * 4) = pack4(v);
}
DEVI f32x4 maskv(f32x4 v, int mt, int nt, int fr, int fq, int mode) {
  const int n = nt * 16 + fr, m0 = mt * 16 + fq * 4;
#pragma unroll
  for (int r = 0; r < 4; ++r) {
    const int m = m0 + r;
    bool keep = (mode == 0) ? (m < n) : (mode == 1) ? (m <= n) : (n < m);
    if (!keep) v[r] = 0.f;
  }
  return v;
}
DEVI void load_shift8(const us* ptr, bool hasprev, const float* mu, float (&o)[8]) {
  bf16x8 cur = *(const bf16x8*)ptr;
  bf16x8 prv = cur;
  if (hasprev) prv = *(const bf16x8*)(ptr - LDA_);
#pragma unroll
  for (int e = 0; e < 8; ++e) {
    float cv = bf2f((us)cur[e]);
    float pv = hasprev ? bf2f((us)prv[e]) : 0.f;
    o[e] = cv + (pv - cv) * mu[e];
  }
}

__device__ void wkv_prep_item(const Params& p, int item, unsigned char* smraw) {
  const int tid = threadIdx.x, lane = tid & 63, w = tid >> 6, fr = lane & 15, fq = lane >> 4;
  const int h = item & 7, bc = item >> 3, b = bc >> 6, c = bc & 63;
  const int ch = (b * 8 + h) * 64 + c;
  const int tok0 = b * SEQ + c * 64;
  const int t = tid >> 3, j0 = (tid & 7) * 8, jc = h * 64 + j0;
  const f32x4 z4 = {0.f, 0.f, 0.f, 0.f};
  us *At = REG_(0), *Bt = REG_(1), *Kt = REG_(2), *Rt = REG_(3), *BhT = REG_(4), *KhT = REG_(5), *VT = REG_(6);
  us *P0 = REG_(7), *PT0 = REG_(8), *P1 = REG_(9), *PT1 = REG_(10), *Aak = REG_(11), *Arb = REG_(12), *Ark = REG_(13);
  us* UT = REG_(14);
  float* F = (float*)REG_(9);
  float* G = (float*)REG_(14);
  float* segsum = (float*)(smraw + 16 * 9216);

  float rr[8], kk_[8], vv[8], wd[8], ad[8];
  {
    const bool hp = (c * 64 + t) > 0;
    const us* rowp = p.projA + (size_t)(tok0 + t) * LDA_ + 416;
    load_shift8(rowp + jc, hp, p.mu + jc, rr);
    load_shift8(rowp + 512 + jc, hp, p.mu + 512 + jc, kk_);
    load_shift8(rowp + 1024 + jc, hp, p.mu + 1024 + jc, vv);
    load_shift8(rowp + 1536 + j0, hp, p.mu + 1536 + j0, wd);
    load_shift8(rowp + 1600 + j0, hp, p.mu + 1600 + j0, ad);
  }
  {
    uint4 o1, o2;
    o1.x = pack2(tanhf(wd[0]), tanhf(wd[1])); o1.y = pack2(tanhf(wd[2]), tanhf(wd[3]));
    o1.z = pack2(tanhf(wd[4]), tanhf(wd[5])); o1.w = pack2(tanhf(wd[6]), tanhf(wd[7]));
    o2.x = pack2(ad[0], ad[1]); o2.y = pack2(ad[2], ad[3]); o2.z = pack2(ad[4], ad[5]); o2.w = pack2(ad[6], ad[7]);
    *(uint4*)(P0 + t * 72 + j0) = o1;
    *(uint4*)(PT0 + t * 72 + j0) = o2;
  }
  __syncthreads();
  {
    const int which = w >> 2, tt = w & 3;
    const us* A = which ? PT0 : P0;
    const us* Wt = (which ? p.Wt_icl : p.Wt_dec) + (size_t)h * 64 * 64;
    float* Fw = F + which * 4160;
#pragma unroll
    for (int jt = 0; jt < 4; ++jt) {
      f32x4 acc = z4;
#pragma unroll
      for (int ks = 0; ks < 2; ++ks) {
        bf16x8 a = *(const bf16x8*)(A + (tt * 16 + fr) * 72 + ks * 32 + fq * 8);
        bf16x8 bq = *(const bf16x8*)(Wt + (jt * 16 + fr) * 64 + ks * 32 + fq * 8);
        acc = mfma16(a, bq, acc);
      }
#pragma unroll
      for (int r = 0; r < 4; ++r) Fw[(tt * 16 + fq * 4 + r) * 65 + jt * 16 + fr] = acc[r];
    }
  }
  __syncthreads();
  float lw[8], av[8], kn[8], kp[8];
  {
    float ss = 0.f;
#pragma unroll
    for (int e = 0; e < 8; ++e) {
      float dl = p.w0[jc + e] + F[t * 65 + j0 + e];
      float al = p.a0[jc + e] + F[4160 + t * 65 + j0 + e];
      float xneg = -dl;
      float sp = fmaxf(xneg, 0.f) + log1pf(__expf(-fabsf(xneg)));
      float wl = -sp - 0.5f;
      lw[e] = -__expf(wl);
      av[e] = sigmoidf_(al);
      float kq = kk_[e] * p.k_k[jc + e];
      kn[e] = kq;
      ss += kq * kq;
      kp[e] = kk_[e] * (1.f + (av[e] - 1.f) * p.k_a[jc + e]);
    }
    ss += __shfl_xor(ss, 1); ss += __shfl_xor(ss, 2); ss += __shfl_xor(ss, 4);
    const float inv = 1.f / fmaxf(sqrtf(ss), 1e-12f);
    float bon = 0.f;
#pragma unroll
    for (int e = 0; e < 8; ++e) {
      kn[e] *= inv;
      bon += rr[e] * kp[e] * p.r_k[jc + e];
    }
    bon += __shfl_xor(bon, 1); bon += __shfl_xor(bon, 2); bon += __shfl_xor(bon, 4);
    uint4 o;
    o.x = pack2(bon * vv[0], bon * vv[1]); o.y = pack2(bon * vv[2], bon * vv[3]);
    o.z = pack2(bon * vv[4], bon * vv[5]); o.w = pack2(bon * vv[6], bon * vv[7]);
    *(uint4*)(p.bv + (size_t)(tok0 + t) * 512 + jc) = o;
  }
  __syncthreads();
#pragma unroll
  for (int e = 0; e < 8; ++e) G[t * 65 + j0 + e] = lw[e];
  __syncthreads();
  {
    const int j = tid & 63, seg = tid >> 6;
    float run = 0.f;
#pragma unroll
    for (int i = 0; i < 8; ++i) { run += G[(seg * 8 + i) * 65 + j]; G[(seg * 8 + i) * 65 + j] = run; }
    segsum[seg * 64 + j] = run;
    __syncthreads();
    float off = 0.f;
    for (int s2 = 0; s2 < seg; ++s2) off += segsum[s2 * 64 + j];
#pragma unroll
    for (int i = 0; i < 8; ++i) G[(seg * 8 + i) * 65 + j] += off;
  }
  __syncthreads();
  {
    float ta[8], tb[8], tk[8], tr[8];
#pragma unroll
    for (int e = 0; e < 8; ++e) {
      const float g = G[t * 65 + j0 + e], gC = G[63 * 65 + j0 + e];
      const float eg = __expf(g), eng = __expf(-g), egx = __expf(g - lw[e]), egc = __expf(gC - g);
      ta[e] = -kn[e] * egx;
      tb[e] = kn[e] * av[e] * eng;
      tk[e] = kp[e] * eng;
      tr[e] = rr[e] * eg;
      BhT[(j0 + e) * 72 + t] = f2bf(kn[e] * av[e] * egc);
      KhT[(j0 + e) * 72 + t] = f2bf(kp[e] * egc);
      VT[(j0 + e) * 72 + t] = f2bf(vv[e]);
      if (t == 0) p.Gc[ch * 64 + j0 + e] = __expf(gC);
    }
    uint4 o;
    o.x = pack2(ta[0], ta[1]); o.y = pack2(ta[2], ta[3]); o.z = pack2(ta[4], ta[5]); o.w = pack2(ta[6], ta[7]);
    *(uint4*)(At + t * 72 + j0) = o;
    o.x = pack2(tb[0], tb[1]); o.y = pack2(tb[2], tb[3]); o.z = pack2(tb[4], tb[5]); o.w = pack2(tb[6], tb[7]);
    *(uint4*)(Bt + t * 72 + j0) = o;
    o.x = pack2(tk[0], tk[1]); o.y = pack2(tk[2], tk[3]); o.z = pack2(tk[4], tk[5]); o.w = pack2(tk[6], tk[7]);
    *(uint4*)(Kt + t * 72 + j0) = o;
    o.x = pack2(tr[0], tr[1]); o.y = pack2(tr[2], tr[3]); o.z = pack2(tr[4], tr[5]); o.w = pack2(tr[6], tr[7]);
    *(uint4*)(Rt + t * 72 + j0) = o;
  }
  __syncthreads();
#pragma unroll
  for (int q = 0; q < 2; ++q) {
    const int id = w * 2 + q, mt = id >> 2, nt = id & 3;
    storeT(P0, 72, mt, nt, fr, fq, maskv(mm_tile(Bt, At, mt, nt, fr, fq, z4), mt, nt, fr, fq, 0));
    storeT(PT0, 72, mt, nt, fr, fq, maskv(mm_tile(At, Bt, mt, nt, fr, fq, z4), mt, nt, fr, fq, 2));
    storeT(Aak, 72, mt, nt, fr, fq, maskv(mm_tile(Kt, At, mt, nt, fr, fq, z4), mt, nt, fr, fq, 0));
    storeT(Arb, 72, mt, nt, fr, fq, maskv(mm_tile(Bt, Rt, mt, nt, fr, fq, z4), mt, nt, fr, fq, 1));
    storeT(Ark, 72, mt, nt, fr, fq, maskv(mm_tile(Kt, Rt, mt, nt, fr, fq, z4), mt, nt, fr, fq, 1));
  }
  __syncthreads();
  const int umt = w & 3, half = w >> 2;
  f32x4 u[4];
#pragma unroll
  for (int n = 0; n < 4; ++n) {
    if (half) u[n] = mm_tile(Aak, VT, umt, n, fr, fq, z4);
    else {
#pragma unroll
      for (int r = 0; r < 4; ++r) u[n][r] = bf2f(At[(umt * 16 + fq * 4 + r) * 72 + n * 16 + fr]);
    }
  }
  us* UTh = UT + half * 64 * 72;
#pragma unroll
  for (int n = 0; n < 4; ++n) storeT(UTh, 72, umt, n, fr, fq, u[n]);
  __syncthreads();
  for (int it = 0; it < 6; ++it) {
    const us* Pc = (it & 1) ? P1 : P0;
    const us* PTc = (it & 1) ? PT1 : PT0;
    us* Pn = (it & 1) ? P0 : P1;
    us* PTn = (it & 1) ? PT0 : PT1;
#pragma unroll
    for (int n = 0; n < 4; ++n) u[n] = mm_tile(Pc, UTh, umt, n, fr, fq, u[n]);
    if (it < 5) {
#pragma unroll
      for (int q = 0; q < 2; ++q) {
        const int id = w * 2 + q, mt = id >> 2, nt = id & 3;
        storeT(PTn, 72, mt, nt, fr, fq, mm_tile(Pc, PTc, mt, nt, fr, fq, z4));
        storeT(Pn, 72, mt, nt, fr, fq, mm_tile(PTc, Pc, mt, nt, fr, fq, z4));
      }
    }
    __syncthreads();
#pragma unroll
    for (int n = 0; n < 4; ++n) storeT(UTh, 72, umt, n, fr, fq, u[n]);
    __syncthreads();
  }
  {
    const int o = w >> 1;
    const us* U1 = UT;
    const us* U0 = UT + 64 * 72;
    for (int q = 0; q < 8; ++q) {
      const int id = (w & 1) * 8 + q, mt = id >> 2, nt = id & 3;
      if (o == 0) {
        f32x4 cc = mm_tile(U1, BhT, mt, nt, fr, fq, z4);
        storeT(p.Mp + (size_t)ch * 4096, 64, mt, nt, fr, fq, cc);
      } else if (o == 1) {
        f32x4 cc = mm_tile(BhT, U0, mt, nt, fr, fq, z4);
        cc = mm_tile(KhT, VT, mt, nt, fr, fq, cc);
        storeT(p.Nt + (size_t)ch * 4096, 64, mt, nt, fr, fq, cc);
      } else if (o == 2) {
        f32x4 cc = mm_tile(U1, Arb, mt, nt, fr, fq, z4);
#pragma unroll
        for (int r = 0; r < 4; ++r) cc[r] += bf2f(Rt[(nt * 16 + fr) * 72 + mt * 16 + fq * 4 + r]);
        storeT(p.Y1 + (size_t)ch * 4096, 64, mt, nt, fr, fq, cc);
      } else {
        f32x4 cc = mm_tile(Arb, U0, mt, nt, fr, fq, z4);
        cc = mm_tile(Ark, VT, mt, nt, fr, fq, cc);
        storeT(p.Y0t + (size_t)ch * 4096, 64, mt, nt, fr, fq, cc);
      }
    }
  }
  __syncthreads();
}

#define P3_COMMON \
  us* sm = (us*)smraw; \
  float* rs = (float*)(smraw + 2 * GST * 2); \
  const int tid = threadIdx.x, lane = tid & 63, wid = tid >> 6; \
  const int wx = wid >> 2, wy = wid & 3, fr = lane & 15, fq = lane >> 4;
__device__ void phase3q(const Params& p, unsigned char* smraw) {
  P3_COMMON
  for (int it = blockIdx.x; it < 6 * 128; it += gridDim.x) {
    {
      const int yt = it / 6, xt = it % 6, x0 = xt * 128, y0 = yt * 256;
      {
        const int tok = tid >> 1, hf = tid & 1;
        const us* src = p.projA + (size_t)(y0 + tok) * LDA_ + hf * 128;
        float ss = 0.f;
#pragma unroll
        for (int i = 0; i < 16; ++i) {
          bf16x8 v = *(const bf16x8*)(src + i * 8);
#pragma unroll
          for (int e = 0; e < 8; ++e) { float f = bf2f((us)v[e]); ss += f * f; }
        }
        ss += __shfl_xor(ss, 1);
        if (!hf) rs[tok] = rsqrtf(ss * (1.f / 256.f) + 1e-6f);
      }
      f32x4 acc[4][4];
      zero_acc(acc);
      gemm_main(p.Wt_uq + (size_t)x0 * 256, 256, p.projA + (size_t)y0 * LDA_, LDA_, 256, sm, acc);
#pragma unroll
      for (int j = 0; j < 4; ++j) {
        const int tl = wy * 64 + j * 16 + fr, tk = y0 + tl;
        const float rstd = rs[tl];
        const int bb = tk >> 12, s = tk & 4095;
#pragma unroll
        for (int i = 0; i < 4; ++i) {
          const int nb = x0 + wx * 64 + i * 16;
          const int hd = nb / 96, dq = nb % 96;
          us* qrow = p.Q + ((size_t)(bb * 8 + hd) * SEQ + s) * 96;
          if (dq < 64) {
            f32x4 v = acc[i][j] * rstd;
            *(uint2*)(qrow + dq + fq * 4) = pack4(v);
          } else if (dq == 64) {
            if (i < 3) {
              f32x4 t1 = acc[i][j] * rstd, t2 = acc[(i + 1) & 3][j] * rstd, o1, o2;
              const float4 cv = *(const float4*)(p.cs + (size_t)tk * 32 + fq * 4);
              const float4 sv = *(const float4*)(p.cs + (size_t)tk * 32 + 16 + fq * 4);
              o1[0] = t1[0] * cv.x - t2[0] * sv.x; o2[0] = t1[0] * sv.x + t2[0] * cv.x;
              o1[1] = t1[1] * cv.y - t2[1] * sv.y; o2[1] = t1[1] * sv.y + t2[1] * cv.y;
              o1[2] = t1[2] * cv.z - t2[2] * sv.z; o2[2] = t1[2] * sv.z + t2[2] * cv.z;
              o1[3] = t1[3] * cv.w - t2[3] * sv.w; o2[3] = t1[3] * sv.w + t2[3] * cv.w;
              *(uint2*)(qrow + 64 + fq * 4) = pack4(o1);
              *(uint2*)(qrow + 80 + fq * 4) = pack4(o2);
            }
          }
        }
      }
      __syncthreads();
    }
  }
}
__device__ void phase3kv(const Params& p, unsigned char* smraw) {
  P3_COMMON
  for (int it = blockIdx.x; it < 8 * 128; it += gridDim.x) {
    {
      const int r = it, yt = r >> 3, xt = r & 7, x0 = xt * 128, y0 = yt * 256;
      {
        const int tok = tid >> 1, hf = tid & 1;
        const us* src = p.projA + (size_t)(y0 + tok) * LDA_ + 256 + hf * 64;
        float ss = 0.f;
#pragma unroll
        for (int i = 0; i < 8; ++i) {
          bf16x8 v = *(const bf16x8*)(src + i * 8);
#pragma unroll
          for (int e = 0; e < 8; ++e) { float f = bf2f((us)v[e]); ss += f * f; }
        }
        ss += __shfl_xor(ss, 1);
        if (!hf) rs[tok] = rsqrtf(ss * (1.f / 128.f) + 1e-6f);
      }
      f32x4 acc[4][4];
      zero_acc(acc);
      gemm_main(p.Wt_ukv + (size_t)x0 * 128, 128, p.projA + (size_t)y0 * LDA_ + 256, LDA_, 128, sm, acc);
      const int hd = xt;
#pragma unroll
      for (int j = 0; j < 4; ++j) {
        const int tl = wy * 64 + j * 16 + fr, tk = y0 + tl;
        const float rstd = rs[tl];
        const int bb = tk >> 12, s = tk & 4095;
#pragma unroll
        for (int i = 0; i < 4; ++i) {
          const int rcol = wx * 64 + i * 16 + fq * 4;
          f32x4 v = acc[i][j] * rstd;
          if (wx == 0) {
            *(uint2*)(p.K + ((size_t)(bb * 8 + hd) * SEQ + s) * 96 + rcol) = pack4(v);
          } else {
            us* vb = p.Vt + ((size_t)(bb * 8 + hd) * 64 + (rcol - 64)) * SEQ + s;
#pragma unroll
            for (int q = 0; q < 4; ++q) vb[(size_t)q * SEQ] = f2bf(v[q]);
          }
        }
      }
      __syncthreads();
    }
  }
}
__device__ void phase3w(const Params& p, unsigned char* smraw) {
  const int tid = threadIdx.x;
  for (int it = blockIdx.x; it < 4096; it += gridDim.x) wkv_prep_item(p, it, smraw);
  const int gt = blockIdx.x * NTHR + tid, gs = gridDim.x * NTHR;
  for (int i = gt; i < T_TOK * 16; i += gs) {
    const int tk = i >> 4, pi = i & 15;
    const float k1 = bf2f(p.projA[(size_t)tk * LDA_ + 384 + pi]), k2 = bf2f(p.projA[(size_t)tk * LDA_ + 400 + pi]);
    const float cv = p.cs[tk * 32 + pi], sv = p.cs[tk * 32 + 16 + pi];
    const us o1 = f2bf(k1 * cv - k2 * sv), o2 = f2bf(k1 * sv + k2 * cv);
    const int bb = tk >> 12, s = tk & 4095;
#pragma unroll
    for (int hd = 0; hd < 8; ++hd) {
      us* kr = p.K + ((size_t)(bb * 8 + hd) * SEQ + s) * 96;
      kr[64 + pi] = o1;
      kr[80 + pi] = o2;
    }
  }
}

__device__ void wkv_scan_item(const Params& p, int item) {
  const int lane = threadIdx.x & 63, fr = lane & 15, fq = lane >> 4;
  const int bh = item >> 2, vs = item & 3;
  f32x4 H[4];
#pragma unroll
  for (int m = 0; m < 4; ++m) H[m] = f32x4{0.f, 0.f, 0.f, 0.f};
  for (int c = 0; c < 64; ++c) {
    const size_t ch = (size_t)bh * 64 + c;
    us* hh = p.Hh + ch * 4096 + (vs * 16 + fr) * 64 + fq * 4;
#pragma unroll
    for (int m = 0; m < 4; ++m) *(uint2*)(hh + m * 16) = pack4(H[m]);
    if (c == 63) break;
    const us* mp = p.Mp + ch * 4096;
    const us* nt = p.Nt + ch * 4096 + (vs * 16 + fr) * 64 + fq * 4;
    const float* gc = p.Gc + ch * 64 + fq * 4;
    bf16x8 bop[2];
#pragma unroll
    for (int ks = 0; ks < 2; ++ks) {
      uint2 lo = pack4(H[2 * ks]), hi = pack4(H[2 * ks + 1]);
      uint4 q4; q4.x = lo.x; q4.y = lo.y; q4.z = hi.x; q4.w = hi.y;
      bop[ks] = *(bf16x8*)&q4;
    }
    f32x4 Hn[4];
#pragma unroll
    for (int m = 0; m < 4; ++m) {
      const float4 g = *(const float4*)(gc + m * 16);
      const uint2 nn = *(const uint2*)(nt + m * 16);
      Hn[m][0] = g.x * H[m][0] + bf2f((us)(nn.x & 0xffff));
      Hn[m][1] = g.y * H[m][1] + bf2f((us)(nn.x >> 16));
      Hn[m][2] = g.z * H[m][2] + bf2f((us)(nn.y & 0xffff));
      Hn[m][3] = g.w * H[m][3] + bf2f((us)(nn.y >> 16));
#pragma unroll
      for (int ks = 0; ks < 2; ++ks) {
        const uint2 lo = *(const uint2*)(mp + (m * 16 + fr) * 64 + ks * 32 + fq * 4);
        const uint2 hi = *(const uint2*)(mp + (m * 16 + fr) * 64 + ks * 32 + 16 + fq * 4);
        uint4 q4; q4.x = lo.x; q4.y = lo.y; q4.z = hi.x; q4.w = hi.y;
        Hn[m] = mfma16(*(bf16x8*)&q4, bop[ks], Hn[m]);
      }
    }
#pragma unroll
    for (int m = 0; m < 4; ++m) H[m] = Hn[m];
  }
}

constexpr int AKS = 104, AVS = 68, ASTG = 64 * AKS + 64 * AVS;
__device__ void attn_item(const Params& p, int bh, int qt, unsigned char* smraw) {
  us* sm = (us*)smraw;
  const int tid = threadIdx.x, lane = tid & 63, w = tid >> 6, c = lane & 31, hh = lane >> 5;
  const int q0 = qt * 256;
  const us* Kg = p.K + (size_t)bh * SEQ * 96;
  const us* Vg = p.Vt + (size_t)bh * 64 * SEQ;
  bf16x8 qf[6];
  {
    const us* qb = p.Q + ((size_t)bh * SEQ + q0 + w * 32 + c) * 96 + 8 * hh;
#pragma unroll
    for (int s = 0; s < 6; ++s) qf[s] = *(const bf16x8*)(qb + 16 * s);
  }
  const int nkt = q0 / 64 + 4, mylim = q0 / 64 + (w >> 1);
  f32x16 ot0, ot1;
#pragma unroll
  for (int r = 0; r < 16; ++r) { ot0[r] = 0.f; ot1[r] = 0.f; }
  float mrun = -1e30f, lrun = 0.f;
  const int kr0 = tid / 12, kc0 = (tid % 12) * 8;
  const int kr1 = (tid + 512) / 12, kc1 = ((tid + 512) % 12) * 8;
  const int vr = tid >> 3, vc = (tid & 7) * 8;
  bf16x8 gk0, gk1, gv;
  gk0 = *(const bf16x8*)(Kg + (size_t)kr0 * 96 + kc0);
  if (tid < 256) gk1 = *(const bf16x8*)(Kg + (size_t)kr1 * 96 + kc1);
  gv = *(const bf16x8*)(Vg + (size_t)vr * SEQ + vc);
  {
    us* ks = sm; us* vsm = sm + 64 * AKS;
    *(bf16x8*)(ks + kr0 * AKS + kc0) = gk0;
    if (tid < 256) *(bf16x8*)(ks + kr1 * AKS + kc1) = gk1;
    const uint4 q4 = *(uint4*)&gv;
    *(uint2*)(vsm + vr * AVS + vc) = make_uint2(q4.x, q4.y);
    *(uint2*)(vsm + vr * AVS + vc + 4) = make_uint2(q4.z, q4.w);
  }
  __syncthreads();
  for (int kt = 0; kt < nkt; ++kt) {
    const int cur = kt & 1;
    if (kt + 1 < nkt) {
      const size_t kb = (size_t)(kt + 1) * 64;
      gk0 = *(const bf16x8*)(Kg + (kb + kr0) * 96 + kc0);
      if (tid < 256) gk1 = *(const bf16x8*)(Kg + (kb + kr1) * 96 + kc1);
      gv = *(const bf16x8*)(Vg + (size_t)vr * SEQ + kb + vc);
    }
    if (kt <= mylim) {
      const us* ks = sm + cur * ASTG;
      const us* vsm = ks + 64 * AKS;
      f32x16 s0, s1;
#pragma unroll
      for (int r = 0; r < 16; ++r) { s0[r] = 0.f; s1[r] = 0.f; }
#pragma unroll
      for (int s = 0; s < 6; ++s) {
        bf16x8 a0 = *(const bf16x8*)(ks + c * AKS + 16 * s + 8 * hh);
        bf16x8 a1 = *(const bf16x8*)(ks + (32 + c) * AKS + 16 * s + 8 * hh);
        s0 = mfma32(a0, qf[s], s0);
        s1 = mfma32(a1, qf[s], s1);
      }
      float mx = s0[0];
#pragma unroll
      for (int r = 1; r < 16; ++r) mx = fmaxf(mx, s0[r]);
#pragma unroll
      for (int r = 0; r < 16; ++r) mx = fmaxf(mx, s1[r]);
      mx = fmaxf(mx, __shfl_xor(mx, 32));
      const float mnew = fmaxf(mrun, mx);
      const float alpha = exp2f(mrun - mnew);
      mrun = mnew;
      float rsum = 0.f;
#pragma unroll
      for (int r = 0; r < 16; ++r) { s0[r] = exp2f(s0[r] - mnew); rsum += s0[r]; }
#pragma unroll
      for (int r = 0; r < 16; ++r) { s1[r] = exp2f(s1[r] - mnew); rsum += s1[r]; }
      rsum += __shfl_xor(rsum, 32);
      lrun = lrun * alpha + rsum;
#pragma unroll
      for (int r = 0; r < 16; ++r) { ot0[r] *= alpha; ot1[r] *= alpha; }
#pragma unroll
      for (int sub = 0; sub < 2; ++sub) {
#pragma unroll
        for (int s = 0; s < 2; ++s) {
          uint4 pq;
          if (sub == 0) {
            pq.x = pack2(s0[8 * s + 0], s0[8 * s + 1]); pq.y = pack2(s0[8 * s + 2], s0[8 * s + 3]);
            pq.z = pack2(s0[8 * s + 4], s0[8 * s + 5]); pq.w = pack2(s0[8 * s + 6], s0[8 * s + 7]);
          } else {
            pq.x = pack2(s1[8 * s + 0], s1[8 * s + 1]); pq.y = pack2(s1[8 * s + 2], s1[8 * s + 3]);
            pq.z = pack2(s1[8 * s + 4], s1[8 * s + 5]); pq.w = pack2(s1[8 * s + 6], s1[8 * s + 7]);
          }
          const bf16x8 pb = *(bf16x8*)&pq;
          const int kb = 32 * sub + 16 * s + 4 * hh;
          {
            const uint2 lo = *(const uint2*)(vsm + c * AVS + kb);
            const uint2 hi = *(const uint2*)(vsm + c * AVS + kb + 8);
            uint4 q4; q4.x = lo.x; q4.y = lo.y; q4.z = hi.x; q4.w = hi.y;
            ot0 = mfma32(*(bf16x8*)&q4, pb, ot0);
          }
          {
            const uint2 lo = *(const uint2*)(vsm + (32 + c) * AVS + kb);
            const uint2 hi = *(const uint2*)(vsm + (32 + c) * AVS + kb + 8);
            uint4 q4; q4.x = lo.x; q4.y = lo.y; q4.z = hi.x; q4.w = hi.y;
            ot1 = mfma32(*(bf16x8*)&q4, pb, ot1);
          }
        }
      }
    }
    if (kt + 1 < nkt) {
      us* ks = sm + (cur ^ 1) * ASTG; us* vsm = ks + 64 * AKS;
      *(bf16x8*)(ks + kr0 * AKS + kc0) = gk0;
      if (tid < 256) *(bf16x8*)(ks + kr1 * AKS + kc1) = gk1;
      const uint4 q4 = *(uint4*)&gv;
      *(uint2*)(vsm + vr * AVS + vc) = make_uint2(q4.x, q4.y);
      *(uint2*)(vsm + vr * AVS + vc + 4) = make_uint2(q4.z, q4.w);
    }
    __syncthreads();
  }
  {
    const float inv = 1.f / lrun;
    const int b = bh >> 3, hd = bh & 7;
    const size_t tk = (size_t)b * SEQ + q0 + w * 32 + c;
    const us* ga = p.projB + tk * LDB_ + hd * 64;
    us* zo = p.za + tk * 512 + hd * 64;
#pragma unroll
    for (int dt = 0; dt < 2; ++dt) {
#pragma unroll
      for (int g = 0; g < 4; ++g) {
        const int d0 = 32 * dt + 8 * g + 4 * hh;
        const uint2 gg = *(const uint2*)(ga + d0);
        f32x4 v;
        if (dt == 0) { v[0] = ot0[4 * g]; v[1] = ot0[4 * g + 1]; v[2] = ot0[4 * g + 2]; v[3] = ot0[4 * g + 3]; }
        else { v[0] = ot1[4 * g]; v[1] = ot1[4 * g + 1]; v[2] = ot1[4 * g + 2]; v[3] = ot1[4 * g + 3]; }
        v[0] *= inv * bf2f((us)(gg.x & 0xffff)); v[1] *= inv * bf2f((us)(gg.x >> 16));
        v[2] *= inv * bf2f((us)(gg.y & 0xffff)); v[3] *= inv * bf2f((us)(gg.y >> 16));
        *(uint2*)(zo + d0) = pack4(v);
      }
    }
  }
}

__device__ void phase4(const Params& p, unsigned char* smraw) {
  const int wid = threadIdx.x >> 6;
  if (wid == 0)
    for (int it = blockIdx.x; it < 256; it += gridDim.x) wkv_scan_item(p, it);
  const int G = gridDim.x;
  for (int r = 0;; ++r) {
    const int pos = (r & 1) ? (G - 1 - (int)blockIdx.x) : (int)blockIdx.x;
    const int k = r * G + pos;
    if (r * G >= 1024) break;
    if (k < 1024) attn_item(p, k & 63, 15 - (k >> 6), smraw);
  }
}

__device__ void phase5(const Params& p) {
  const int lane = threadIdx.x & 63, wid = threadIdx.x >> 6, fr = lane & 15, fq = lane >> 4;
  for (int it = blockIdx.x * 8 + wid; it < 4096 * 4; it += gridDim.x * 8) {
    const int ch = it >> 2, mt = it & 3;
    const int bh = ch >> 6, cc = ch & 63, b = bh >> 3, hd = bh & 7;
    const us* y1 = p.Y1 + (size_t)ch * 4096;
    const us* hh = p.Hh + (size_t)ch * 4096;
    const us* y0 = p.Y0t + (size_t)ch * 4096;
    bf16x8 a[2];
#pragma unroll
    for (int ks = 0; ks < 2; ++ks) a[ks] = *(const bf16x8*)(y1 + (mt * 16 + fr) * 64 + ks * 32 + fq * 8);
    f32x4 y[4];
#pragma unroll
    for (int nt = 0; nt < 4; ++nt) {
      const uint2 yy = *(const uint2*)(y0 + (nt * 16 + fr) * 64 + mt * 16 + fq * 4);
      y[nt][0] = bf2f((us)(yy.x & 0xffff)); y[nt][1] = bf2f((us)(yy.x >> 16));
      y[nt][2] = bf2f((us)(yy.y & 0xffff)); y[nt][3] = bf2f((us)(yy.y >> 16));
#pragma unroll
      for (int ks = 0; ks < 2; ++ks) {
        bf16x8 bq = *(const bf16x8*)(hh + (nt * 16 + fr) * 64 + ks * 32 + fq * 8);
        y[nt] = mfma16(a[ks], bq, y[nt]);
      }
    }
    f32x4 s1 = y[0] + y[1] + y[2] + y[3];
#pragma unroll
    for (int o = 1; o < 16; o <<= 1)
#pragma unroll
      for (int r = 0; r < 4; ++r) s1[r] += __shfl_xor(s1[r], o);
    f32x4 mean = s1 * (1.f / 64.f);
    f32x4 s2 = {0.f, 0.f, 0.f, 0.f};
#pragma unroll
    for (int nt = 0; nt < 4; ++nt) { y[nt] -= mean; s2 += y[nt] * y[nt]; }
#pragma unroll
    for (int o = 1; o < 16; o <<= 1)
#pragma unroll
      for (int r = 0; r < 4; ++r) s2[r] += __shfl_xor(s2[r], o);
    f32x4 rstd;
#pragma unroll
    for (int r = 0; r < 4; ++r) rstd[r] = rsqrtf(s2[r] * (1.f / 64.f) + 64e-5f);
    const size_t tk0 = (size_t)b * SEQ + cc * 64 + mt * 16 + fq * 4;
#pragma unroll
    for (int nt = 0; nt < 4; ++nt) {
      const int ci = hd * 64 + nt * 16 + fr;
      const float gg = p.gn_g[ci], gb = p.gn_b[ci];
#pragma unroll
      for (int r = 0; r < 4; ++r) {
        const size_t tk = tk0 + r;
        float v = y[nt][r] * rstd[r] * gg + gb + bf2f(p.bv[tk * 512 + ci]);
        v *= bf2f(p.projB[tk * LDB_ + 512 + ci]);
        p.zb[tk * 512 + ci] = f2bf(v);
      }
    }
  }
}

__device__ void phase6(const Params& p, unsigned char* smraw) {
  us* sm = (us*)smraw;
  const int lane = threadIdx.x & 63, wid = threadIdx.x >> 6;
  const int wx = wid >> 2, wy = wid & 3, fr = lane & 15, fq = lane >> 4;
  for (int tile = blockIdx.x; tile < 8 * 128; tile += gridDim.x) {
    const int yt = tile >> 3, xt = tile & 7, x0 = xt * 128, y0 = yt * 256;
    f32x4 acc[4][4], acc2[4][4];
    zero_acc(acc);
    zero_acc(acc2);
    gemm_main(p.Wt_pa + (size_t)x0 * 512, 512, p.za + (size_t)y0 * 512, 512, 512, sm, acc);
    gemm_main(p.Wt_pb + (size_t)x0 * 512, 512, p.zb + (size_t)y0 * 512, 512, 512, sm, acc2);
#pragma unroll
    for (int i = 0; i < 4; ++i)
#pragma unroll
      for (int j = 0; j < 4; ++j) {
        const int n = x0 + wx * 64 + i * 16 + fq * 4;
        const size_t t = y0 + wy * 64 + j * 16 + fr;
        const uint2 ga = *(const uint2*)(p.projB + t * LDB_ + 1024 + n);
        const uint2 gb = *(const uint2*)(p.projB + t * LDB_ + 2048 + n);
        f32x4 v;
        v[0] = bf2f((us)(ga.x & 0xffff)) * acc[i][j][0] + bf2f((us)(gb.x & 0xffff)) * acc2[i][j][0];
        v[1] = bf2f((us)(ga.x >> 16)) * acc[i][j][1] + bf2f((us)(gb.x >> 16)) * acc2[i][j][1];
        v[2] = bf2f((us)(ga.y & 0xffff)) * acc[i][j][2] + bf2f((us)(gb.y & 0xffff)) * acc2[i][j][2];
        v[3] = bf2f((us)(ga.y >> 16)) * acc[i][j][3] + bf2f((us)(gb.y >> 16)) * acc2[i][j][3];
        *(uint2*)(p.merged + t * 1024 + n) = pack4(v);
      }
  }
}

__device__ void phase7(const Params& p, unsigned char* smraw) {
  us* sm = (us*)smraw;
  const int lane = threadIdx.x & 63, wid = threadIdx.x >> 6;
  const int wx = wid >> 2, wy = wid & 3, fr = lane & 15, fq = lane >> 4;
  for (int tile = blockIdx.x; tile < 8 * 128; tile += gridDim.x) {
    const int yt = tile >> 3, xt = tile & 7, x0 = xt * 128, y0 = yt * 256;
    f32x4 acc[4][4];
    zero_acc(acc);
    gemm_main(p.Wt_out + (size_t)x0 * 1024, 1024, p.merged + (size_t)y0 * 1024, 1024, 1024, sm, acc);
    const float* gate = p.mod + (y0 >> 12) * 3072 + 2048;
#pragma unroll
    for (int j = 0; j < 4; ++j) {
      const size_t t = y0 + wy * 64 + j * 16 + fr;
      float s1 = 0.f, s2 = 0.f;
#pragma unroll
      for (int i = 0; i < 4; ++i) {
        const int n = x0 + wx * 64 + i * 16 + fq * 4;
        const float4 xv = *(const float4*)(p.x + t * 1024 + n);
        const float4 gv = *(const float4*)(gate + n);
        float4 z;
        z.x = ALPHA_ * xv.x + (1.f + gv.x) * acc[i][j][0];
        z.y = ALPHA_ * xv.y + (1.f + gv.y) * acc[i][j][1];
        z.z = ALPHA_ * xv.z + (1.f + gv.z) * acc[i][j][2];
        z.w = ALPHA_ * xv.w + (1.f + gv.w) * acc[i][j][3];
        *(float4*)(p.out + t * 1024 + n) = z;
        s1 += z.x + z.y + z.z + z.w;
        s2 += z.x * z.x + z.y * z.y + z.z * z.z + z.w * z.w;
      }
      s1 += __shfl_xor(s1, 16); s1 += __shfl_xor(s1, 32);
      s2 += __shfl_xor(s2, 16); s2 += __shfl_xor(s2, 32);
      if (fq == 0) { atomicAdd(p.stats + t * 2, s1); atomicAdd(p.stats + t * 2 + 1, s2); }
    }
  }
}

__device__ void phase8(const Params& p) {
  const int lane = threadIdx.x & 63, wid = threadIdx.x >> 6;
  for (int row = blockIdx.x * 8 + wid; row < T_TOK; row += gridDim.x * 8) {
    const float mean = p.stats[row * 2] * (1.f / 1024.f);
    const float var = p.stats[row * 2 + 1] * (1.f / 1024.f) - mean * mean;
    const float rstd = rsqrtf(fmaxf(var, 0.f) + 1e-5f);
    float4* zr = (float4*)(p.out + (size_t)row * DM);
#pragma unroll
    for (int i = 0; i < 4; ++i) {
      const int c4 = i * 64 + lane;
      float4 v = zr[c4];
      const float4 g = ((const float4*)p.post_g)[c4], bb = ((const float4*)p.post_b)[c4];
      v.x = (v.x - mean) * rstd * g.x + bb.x; v.y = (v.y - mean) * rstd * g.y + bb.y;
      v.z = (v.z - mean) * rstd * g.z + bb.z; v.w = (v.w - mean) * rstd * g.w + bb.w;
      zr[c4] = v;
    }
  }
}

#ifdef ONE_LAUNCH
__global__ void __launch_bounds__(NTHR) fwd_kernel(Params p) {
  extern __shared__ __attribute__((aligned(16))) unsigned char smraw[];
  cg::grid_group grid = cg::this_grid();
  phase0(p, smraw); grid.sync();
  phase1(p); grid.sync();
  phase2(p, smraw); grid.sync();
  phase3q(p, smraw); phase3kv(p, smraw); phase3w(p, smraw); grid.sync();
  phase4(p, smraw); grid.sync();
  phase5(p); grid.sync();
  phase6(p, smraw); grid.sync();
  phase7(p, smraw); grid.sync();
  phase8(p);
}
#else
#define PK(name, call) __global__ void __launch_bounds__(NTHR) name(Params p) { \
  extern __shared__ __attribute__((aligned(16))) unsigned char smraw[]; call; }
PK(k_p0, phase0(p, smraw)) PK(k_p1, phase1(p)) PK(k_p2, phase2(p, smraw)) PK(k_p3q, phase3q(p, smraw))
PK(k_p3kv, phase3kv(p, smraw)) PK(k_p3w, phase3w(p, smraw)) PK(k_p4, phase4(p, smraw)) PK(k_p5, phase5(p))
PK(k_p6, phase6(p, smraw)) PK(k_p7, phase7(p, smraw)) PK(k_p8, phase8(p))
#endif

extern "C" void kernel_launch(void* const* d_in, const int* in_sizes, int n_in, void* d_out, int out_size,
                              void* d_ws, size_t ws_size, hipStream_t stream) {
  static int grid_blocks = 0;
#ifdef ONE_LAUNCH
  if (!grid_blocks) {
    int dev = 0, cus = 0, per_cu = 0;
    (void)hipGetDevice(&dev);
    (void)hipDeviceGetAttribute(&cus, hipDeviceAttributeMultiprocessorCount, dev);
    (void)hipFuncSetAttribute((const void*)fwd_kernel, hipFuncAttributeMaxDynamicSharedMemorySize, LDSB);
    (void)hipOccupancyMaxActiveBlocksPerMultiprocessor(&per_cu, fwd_kernel, NTHR, LDSB);
    if (per_cu < 1) per_cu = 1;
    grid_blocks = cus * per_cu;
  }
#else
  if (!grid_blocks) {
    const void* ks[] = {(const void*)k_p0, (const void*)k_p1, (const void*)k_p2, (const void*)k_p3q, (const void*)k_p3kv,
                        (const void*)k_p3w, (const void*)k_p4, (const void*)k_p5, (const void*)k_p6, (const void*)k_p7,
                        (const void*)k_p8};
    for (int i = 0; i < 11; ++i) (void)hipFuncSetAttribute(ks[i], hipFuncAttributeMaxDynamicSharedMemorySize, LDSB);
    grid_blocks = 256;
  }
#endif
  Params p{};
  p.x = (const float*)d_in[0]; p.c = (const float*)d_in[1]; p.pos = (const int*)d_in[2];
  p.w_ada = (const float*)d_in[3]; p.b_ada = (const float*)d_in[4]; p.w_in = (const float*)d_in[5];
  p.q_norm_g = (const float*)d_in[6]; p.w_uq = (const float*)d_in[7]; p.kv_norm_g = (const float*)d_in[8];
  p.w_ukv = (const float*)d_in[9]; p.mu = (const float*)d_in[10]; p.w0 = (const float*)d_in[11];
  p.w_dec = (const float*)d_in[12]; p.a0 = (const float*)d_in[13]; p.w_icl = (const float*)d_in[14];
  p.k_k = (const float*)d_in[15]; p.k_a = (const float*)d_in[16]; p.r_k = (const float*)d_in[17];
  p.gn_g = (const float*)d_in[18]; p.gn_b = (const float*)d_in[19]; p.w_pa = (const float*)d_in[20];
  p.w_pb = (const float*)d_in[21]; p.w_out = (const float*)d_in[22]; p.post_g = (const float*)d_in[23];
  p.post_b = (const float*)d_in[24];
  p.out = (float*)d_out;
  unsigned char* ws = (unsigned char*)d_ws;
  size_t off = 0;
  auto take = [&](size_t bytes) { unsigned char* r = ws + off; off += (bytes + 255) & ~(size_t)255; return r; };
  const size_t MiB = 1u << 20;
  p.mod = (float*)take(8 * 3072 * 4);
  p.cs = (float*)take((size_t)T_TOK * 32 * 4);
  p.stats = (float*)take((size_t)T_TOK * 2 * 4);
  p.Gc = (float*)take(4096 * 64 * 4);
  p.Wt_in = (us*)take((size_t)5376 * 1024 * 2);
  p.Wt_uq = (us*)take(768 * 256 * 2);
  p.Wt_ukv = (us*)take(1024 * 128 * 2);
  p.Wt_dec = (us*)take(512 * 64 * 2);
  p.Wt_icl = (us*)take(512 * 64 * 2);
  p.Wt_pa = (us*)take(1024 * 512 * 2);
  p.Wt_pb = (us*)take(1024 * 512 * 2);
  p.Wt_out = (us*)take(1024 * 1024 * 2);
  unsigned char* r1 = take(64 * MiB);
  unsigned char* r2 = take((size_t)T_TOK * LDA_ * 2);
  p.projB = (us*)take((size_t)T_TOK * LDB_ * 2);
  p.Y1 = (us*)take(32 * MiB);
  p.Y0t = (us*)take(32 * MiB);
  p.bv = (us*)take(32 * MiB);
  p.h = (us*)r1; p.Mp = (us*)r1; p.Nt = (us*)(r1 + 32 * MiB); p.merged = (us*)r1;
  p.projA = (us*)r2; p.Hh = (us*)r2; p.za = (us*)(r2 + 32 * MiB); p.zb = (us*)(r2 + 64 * MiB);
  unsigned char* ob = (unsigned char*)d_out;
  p.Q = (us*)ob; p.K = (us*)(ob + 48 * MiB); p.Vt = (us*)(ob + 96 * MiB);
  if (off > ws_size) { fprintf(stderr, "workspace too small: need %zu have %zu\n", off, ws_size); return; }
#ifndef ONE_LAUNCH
  const dim3 g(grid_blocks), bdim(NTHR);
  k_p0<<<g, bdim, LDSB, stream>>>(p);
  k_p1<<<g, bdim, LDSB, stream>>>(p);
  k_p2<<<g, bdim, LDSB, stream>>>(p);
  k_p3q<<<g, bdim, LDSB, stream>>>(p);
  k_p3kv<<<g, bdim, LDSB, stream>>>(p);
  k_p3w<<<g, bdim, LDSB, stream>>>(p);
  k_p4<<<g, bdim, LDSB, stream>>>(p);
  k_p5<<<g, bdim, LDSB, stream>>>(p);
  k_p6<<<g, bdim, LDSB, stream>>>(p);
  k_p7<<<g, bdim, LDSB, stream>>>(p);
  k_p8<<<g, bdim, LDSB, stream>>>(p);
#else
  void* args[] = {&p};
  hipError_t e = hipLaunchCooperativeKernel((void*)fwd_kernel, dim3(grid_blocks), dim3(NTHR), args, LDSB, stream);
  if (e != hipSuccess) fprintf(stderr, "cooperative launch failed: %s (grid %d)\n", hipGetErrorString(e), grid_blocks);
#endif
}
```

```cpp
#include <hip/hip_runtime.h>
#include <hip/hip_cooperative_groups.h>
#include <cstdio>
#include <cstdint>
namespace cg = cooperative_groups;
#define ONE_LAUNCH 1

typedef unsigned short us;
typedef __attribute__((ext_vector_type(8))) short bf16x8;
typedef __attribute__((ext_vector_type(4))) float f32x4;
typedef __attribute__((ext_vector_type(16))) float f32x16;
typedef unsigned u32x2n_ __attribute__((ext_vector_type(2)));
#define DEVI __device__ __forceinline__

constexpr int T_TOK = 32768, SEQ = 4096, DM = 1024;
constexpr int LDA_ = 2080;
constexpr int LDB_ = 3072;
constexpr int NTHR = 512;
constexpr int LDSB0 = 16 * 9216 + 2048;
constexpr int LDSB = LDSB0 + 64;
constexpr float QSCALE = 0.10206207261596575f * 1.4426950408889634f;
constexpr float ALPHA_ = 1.189207115002721f;

struct Params {
  const float *x, *c; const int* pos;
  const float *w_ada, *b_ada, *w_in, *q_norm_g, *w_uq, *kv_norm_g, *w_ukv, *mu, *w0, *w_dec, *a0, *w_icl,
      *k_k, *k_a, *r_k, *gn_g, *gn_b, *w_pa, *w_pb, *w_out, *post_g, *post_b;
  float* out;
  float *mod, *cs, *stats, *Gc; unsigned* bar;
  us *Wt_in, *Wt_uq, *Wt_ukv, *Wt_dec, *Wt_icl, *Wt_pa, *Wt_pb, *Wt_out;
  us *h, *projA, *projB, *Q, *K, *Vt, *za, *zb, *bv, *Mp, *Nt, *Y1, *Y0t, *Hh, *merged, *sub;
};

DEVI int tidx() { int t = (int)threadIdx.x; asm volatile("" : "+v"(t)); return t; }
DEVI us f2bf(float f) { unsigned u = __float_as_uint(f); u += 0x7fffu + ((u >> 16) & 1u); return (us)(u >> 16); }
DEVI float bf2f(us h) { return __uint_as_float(((unsigned)h) << 16); }
typedef float f32x2_ __attribute__((ext_vector_type(2)));
typedef __bf16 bf16x2_ __attribute__((ext_vector_type(2)));
DEVI unsigned pack2(float a, float b) {
  f32x2_ v = {a, b};
  bf16x2_ r = __builtin_convertvector(v, bf16x2_);
  return *(unsigned*)&r;
}
DEVI uint2 pack4(f32x4 v) { uint2 r; r.x = pack2(v[0], v[1]); r.y = pack2(v[2], v[3]); return r; }
DEVI f32x4 mfma16(bf16x8 a, bf16x8 b, f32x4 c) { return __builtin_amdgcn_mfma_f32_16x16x32_bf16(a, b, c, 0, 0, 0); }
DEVI f32x16 mfma32(bf16x8 a, bf16x8 b, f32x16 c) { return __builtin_amdgcn_mfma_f32_32x32x16_bf16(a, b, c, 0, 0, 0); }
DEVI void lds_barrier() { asm volatile("s_waitcnt lgkmcnt(0)" ::: "memory"); __builtin_amdgcn_s_barrier(); asm volatile("" ::: "memory"); }
DEVI float sigmoidf_(float v) { return __builtin_amdgcn_rcpf(1.f + __builtin_amdgcn_exp2f(-1.4426950408889634f * v)); }
DEVI float siluf_(float v) { return v * __builtin_amdgcn_rcpf(1.f + __builtin_amdgcn_exp2f(-1.4426950408889634f * v)); }

DEVI void conv_job(const float* __restrict__ src, us* __restrict__ dst, int K, int N, int ld, int koff, const float* rs, float sc,
                   int gw, int nw, int lane) {
  const int ngrp = (N + 63) >> 6, noct = K >> 3;
  for (int wi = gw; wi < ngrp * noct; wi += nw) {
    const int nt = wi % ngrp, oc = wi / ngrp;
    const int n = nt * 64 + lane, k0 = oc * 8;
    if (n < N) {
      const float* sp = src + (size_t)k0 * N + n;
      const float v0 = sp[0], v1 = sp[(size_t)N], v2 = sp[(size_t)2 * N], v3 = sp[(size_t)3 * N];
      const float v4 = sp[(size_t)4 * N], v5 = sp[(size_t)5 * N], v6 = sp[(size_t)6 * N], v7 = sp[(size_t)7 * N];
      float4 ra = make_float4(sc, sc, sc, sc), rb = ra;
      if (rs) {
        const float4 a = *(const float4*)(rs + k0), b = *(const float4*)(rs + k0 + 4);
        ra = make_float4(a.x * sc, a.y * sc, a.z * sc, a.w * sc); rb = make_float4(b.x * sc, b.y * sc, b.z * sc, b.w * sc);
      }
      uint4 o;
      o.x = pack2(v0 * ra.x, v1 * ra.y); o.y = pack2(v2 * ra.z, v3 * ra.w);
      o.z = pack2(v4 * rb.x, v5 * rb.y); o.w = pack2(v6 * rb.z, v7 * rb.w);
      *(uint4*)(dst + (size_t)n * ld + koff + k0) = o;
    }
  }
}
__device__ void phase0(const Params& p, unsigned char* smraw) {
  float* smf = (float*)smraw;
  const int tid = tidx();
  for (int it = blockIdx.x; it < 48; it += gridDim.x) {
    {
      const int n0 = it * 64;
      for (int i = tid; i < 8192; i += NTHR) smf[i] = siluf_(p.c[i]);
      __syncthreads();
      const int nl = tid & 63, kg = tid >> 6;
      float acc[8];
#pragma unroll
      for (int b = 0; b < 8; ++b) acc[b] = 0.f;
      for (int k0 = kg * 128; k0 < kg * 128 + 128; k0 += 16) {
        float wv[16];
#pragma unroll
        for (int u = 0; u < 16; ++u) wv[u] = p.w_ada[(size_t)(k0 + u) * 3072 + n0 + nl];
#pragma unroll
        for (int u = 0; u < 16; ++u)
#pragma unroll
          for (int b = 0; b < 8; ++b) acc[b] += smf[b * 1024 + k0 + u] * wv[u];
      }
      float* red = smf + 8192;
#pragma unroll
      for (int b = 0; b < 8; ++b) red[(kg * 8 + b) * 64 + nl] = acc[b];
      __syncthreads();
      {
        const int b = tid >> 6;
        float s = p.b_ada[n0 + nl];
#pragma unroll
        for (int g = 0; g < 8; ++g) s += red[(g * 8 + b) * 64 + nl];
        p.mod[b * 3072 + n0 + nl] = s;
      }
      __syncthreads();
    }
  }
  {
    const int gw = blockIdx.x * 8 + (tid >> 6), nw = gridDim.x * 8;
    conv_job(p.w_in, p.Wt_in, 1024, 5152, 1024, 0, nullptr, 1.f, gw, nw, tid & 63);
    conv_job(p.w_uq, p.Wt_uq, 256, 768, 256, 0, p.q_norm_g, QSCALE, gw, nw, tid & 63);
    conv_job(p.w_ukv, p.Wt_ukv, 128, 1024, 128, 0, p.kv_norm_g, 1.f, gw, nw, tid & 63);
    conv_job(p.w_dec, p.Wt_dec, 64, 512, 64, 0, nullptr, 1.f, gw, nw, tid & 63);
    conv_job(p.w_icl, p.Wt_icl, 64, 512, 64, 0, nullptr, 1.f, gw, nw, tid & 63);
    conv_job(p.w_pa, p.Wt_pa, 512, 1024, 1024, 0, nullptr, 1.f, gw, nw, tid & 63);
    conv_job(p.w_pb, p.Wt_pa, 512, 1024, 1024, 512, nullptr, 1.f, gw, nw, tid & 63);
    conv_job(p.w_out, p.Wt_out, 1024, 1024, 1024, 0, nullptr, 1.f, gw, nw, tid & 63);
  }
  const int gt = blockIdx.x * NTHR + tid, gs = gridDim.x * NTHR;
  {
    const double inv = pow(10000.0, -(double)(gt & 15) / 16.0);
    for (int i = gt; i < T_TOK * 16; i += gs) {
      const int t = i >> 4, pi = i & 15;
      double ang = (double)p.pos[t] * inv;
      ang -= 6.283185307179586476925 * rint(ang * 0.15915494309189533577);
      float sv, cv;
      sincosf((float)ang, &sv, &cv);
      p.cs[t * 32 + pi] = cv;
      p.cs[t * 32 + 16 + pi] = sv;
    }
  }
  for (int i = gt; i < T_TOK * 2; i += gs) p.stats[i] = 0.f;
  unsigned* padz = (unsigned*)(p.Wt_in + (size_t)5152 * 1024);
  for (int i = gt; i < 224 * 512; i += gs) padz[i] = 0u;
}

__device__ void phase1(const Params& p) {
  const int lane = tidx() & 63, wid = tidx() >> 6;
  for (int row0 = (blockIdx.x * 8 + wid) * 2; row0 < T_TOK; row0 += gridDim.x * 16) {
    float4 v[2][4];
#pragma unroll
    for (int r = 0; r < 2; ++r) {
      const float4* xr = (const float4*)(p.x + (size_t)(row0 + r) * DM);
#pragma unroll
      for (int i = 0; i < 4; ++i) { const f32x4 t = __builtin_nontemporal_load((const f32x4*)xr + i * 64 + lane); v[r][i] = make_float4(t[0], t[1], t[2], t[3]); }
    }
    const float* md = p.mod + (row0 >> 12) * 3072;
#pragma unroll
    for (int r = 0; r < 2; ++r) {
      float s = 0.f;
#pragma unroll
      for (int i = 0; i < 4; ++i) s += v[r][i].x + v[r][i].y + v[r][i].z + v[r][i].w;
#pragma unroll
      for (int o = 32; o; o >>= 1) s += __shfl_xor(s, o);
      const float mean = s * (1.f / 1024.f);
      float q = 0.f;
#pragma unroll
      for (int i = 0; i < 4; ++i) {
        v[r][i].x -= mean; v[r][i].y -= mean; v[r][i].z -= mean; v[r][i].w -= mean;
        q += v[r][i].x * v[r][i].x + v[r][i].y * v[r][i].y + v[r][i].z * v[r][i].z + v[r][i].w * v[r][i].w;
      }
#pragma unroll
      for (int o = 32; o; o >>= 1) q += __shfl_xor(q, o);
      const float rstd = rsqrtf(q * (1.f / 1024.f) + 1e-5f);
#pragma unroll
      for (int i = 0; i < 4; ++i) {
        const int col = i * 256 + lane * 4;
        float4 sh = *(const float4*)(md + col), scl = *(const float4*)(md + 1024 + col);
        uint2 o;
        o.x = pack2(v[r][i].x * rstd * (1.f + scl.x) + sh.x, v[r][i].y * rstd * (1.f + scl.y) + sh.y);
        o.y = pack2(v[r][i].z * rstd * (1.f + scl.z) + sh.z, v[r][i].w * rstd * (1.f + scl.w) + sh.w);
        *(uint2*)(p.h + (size_t)(row0 + r) * DM + col) = o;
      }
    }
  }
}

constexpr int GST = 384 * 72;
template <bool SUMSQ = false, bool SWAPV = false>
DEVI void gemm_main(const us* __restrict__ X, int ldx, const us* __restrict__ Y, int ldy, int K, us* sm,
                    f32x4 (&acc)[4][4], float* rs_out = nullptr, float rs_scale = 0.f, float rs_eps = 0.f) {
  const int tid = tidx(), lane = tid & 63, wid = tid >> 6;
  const int wx = wid >> 2, wy = wid & 3, fr = lane & 15, fq = lane >> 4;
  const int sr = tid >> 3, sc = (tid & 7) * 8;
  bf16x8 gx[2], gy[4];
  float ssq[4] = {0.f, 0.f, 0.f, 0.f};
#define GM_ACCSQ() if (SUMSQ) { _Pragma("unroll") for (int i = 0; i < 4; ++i) { _Pragma("unroll") for (int e = 0; e < 8; ++e) { const float f = bf2f((us)gy[i][e]); ssq[i] += f * f; } } }
#pragma unroll
  for (int i = 0; i < 2; ++i) gx[i] = *(const bf16x8*)(X + (size_t)(sr + i * 64) * ldx + sc);
#pragma unroll
  for (int i = 0; i < 4; ++i) gy[i] = *(const bf16x8*)(Y + (size_t)(sr + i * 64) * ldy + sc);
#pragma unroll
  for (int i = 0; i < 2; ++i) *(bf16x8*)(sm + (sr + i * 64) * 72 + sc) = gx[i];
#pragma unroll
  for (int i = 0; i < 4; ++i) *(bf16x8*)(sm + (128 + sr + i * 64) * 72 + sc) = gy[i];
  GM_ACCSQ()
  lds_barrier();
  const int nk = K >> 6;
  for (int kt = 0; kt < nk; ++kt) {
    const int cur = kt & 1;
    if (kt + 1 < nk) {
      const int k0 = (kt + 1) * 64 + sc;
#pragma unroll
      for (int i = 0; i < 2; ++i) gx[i] = *(const bf16x8*)(X + (size_t)(sr + i * 64) * ldx + k0);
#pragma unroll
      for (int i = 0; i < 4; ++i) gy[i] = *(const bf16x8*)(Y + (size_t)(sr + i * 64) * ldy + k0);
    }
    const us* xs = sm + cur * GST;
    const us* ys = xs + 128 * 72;
#pragma unroll
    for (int ks = 0; ks < 2; ++ks) {
      bf16x8 a[4], b[4];
#pragma unroll
      for (int i = 0; i < 4; ++i) a[i] = *(const bf16x8*)(xs + (wx * 64 + i * 16 + fr) * 72 + ks * 32 + fq * 8);
#pragma unroll
      for (int j = 0; j < 4; ++j) b[j] = *(const bf16x8*)(ys + (wy * 64 + j * 16 + fr) * 72 + ks * 32 + fq * 8);
#pragma unroll
      for (int i = 0; i < 4; ++i)
#pragma unroll
        for (int j = 0; j < 4; ++j) {
          if (SWAPV && wx == 1) acc[i][j] = mfma16(b[j], a[i], acc[i][j]);
          else acc[i][j] = mfma16(a[i], b[j], acc[i][j]);
        }
    }
    if (kt + 1 < nk) {
      us* xn = sm + (cur ^ 1) * GST;
#pragma unroll
      for (int i = 0; i < 2; ++i) *(bf16x8*)(xn + (sr + i * 64) * 72 + sc) = gx[i];
#pragma unroll
      for (int i = 0; i < 4; ++i) *(bf16x8*)(xn + (128 + sr + i * 64) * 72 + sc) = gy[i];
      GM_ACCSQ()
    }
    lds_barrier();
  }
  if (SUMSQ) {
#pragma unroll
    for (int i = 0; i < 4; ++i) {
      float v = ssq[i];
      v += __shfl_xor(v, 1); v += __shfl_xor(v, 2); v += __shfl_xor(v, 4);
      if ((tid & 7) == 0) rs_out[sr + i * 64] = rsqrtf(v * rs_scale + rs_eps);
    }
    lds_barrier();
  }
#undef GM_ACCSQ
}
DEVI void zero_acc(f32x4 (&acc)[4][4]) {
#pragma unroll
  for (int i = 0; i < 4; ++i)
#pragma unroll
    for (int j = 0; j < 4; ++j) acc[i][j] = f32x4{0.f, 0.f, 0.f, 0.f};
}

namespace pg8 {
#define PG8_LAS __attribute__((address_space(3)))
typedef unsigned short bf16_t;
typedef short bf16x8 __attribute__((ext_vector_type(8)));
typedef float f32x4 __attribute__((ext_vector_type(4)));
typedef unsigned u32x4 __attribute__((ext_vector_type(4)));
constexpr int BM = 256, BK = 64, HALF = 128, HTB = HALF * BK * 2  , STAGE_BYTES = 8 * HTB, NXCD = 8, WGM = 8;

__host__ __device__ __forceinline__ int lds_byte(int r, int c) { const int st = (r >> 4) * 2 + (c >> 5), rr = r & 15, cc = c & 31, ob = rr * 64 + cc * 2; return st * 1024 + (ob ^ (((ob >> 9) & 1) << 5)); }
__host__ __device__ __forceinline__ void stage_rc(int b, int& R, int& C) { const int st = b / 1024, sb = b % 1024, swz = sb ^ (((sb >> 9) & 1) << 5); R = (st >> 1) * 16 + swz / 64; C = (st & 1) * 32 + (swz % 64) / 2; }
__host__ __device__ __forceinline__ int perm32(int rho) { const int n = rho >> 4, i = rho & 15; return 8 * (i >> 2) + 4 * n + (i & 3); }

struct Unit { int pm, pn; };
struct Gemm { const bf16_t* A; const bf16_t* Bt; int M, N, K; };

struct StaticOrder {
    int nM, nN, nwg, G, c;
    __host__ __device__ void init(int M, int N, int G_, int c_) { nM = M / BM; nN = N / BM; nwg = nM * nN; G = G_; c = c_; }
    __host__ __device__ bool next(int i, Unit& u) const {
        const long L = (long)i * G + c; if (L >= nwg) return false;
        int wgid = (int)L; { const int q = nwg / NXCD, r = nwg % NXCD, xcd = wgid % NXCD, off = wgid / NXCD; wgid = (xcd < r ? xcd * (q + 1) : r * (q + 1) + (xcd - r) * q) + off; }
        const int nig = WGM * nN, gid = wgid / nig, fm = gid * WGM, gsz = (nM - fm) < WGM ? (nM - fm) : WGM;
        u.pm = fm + ((wgid % nig) % gsz); u.pn = (wgid % nig) / gsz; return true;
    }
    __device__ __forceinline__ void a_ready(const Unit&) const {}
    __device__ __forceinline__ void done(const Unit&) const {}
};

template <class Epi, class Sched, bool STAMP = false>
__device__ __forceinline__ void gemm_phase(PG8_LAS unsigned char* lds, const Gemm g, const Sched& S, const Epi& E, unsigned long long* stamps) {
    const int tid = tidx(), wid = __builtin_amdgcn_readfirstlane(tid >> 6), lane = tid & 63, wr = wid >> 2, wc = wid & 3, fr = lane & 15, fq = lane >> 4;
    const int K = g.K, nt = K / BK;
    int ts_lo = 0, ts_hi = 0, nts = 0; const unsigned long long rt_entry = STAMP ? (unsigned long long)wall_clock64() : 0ull;
#define PG8_STAMP() do { if (STAMP && wid == 0 && nts < 64) { const unsigned long long _c = (unsigned long long)clock64(); \
        ts_lo = (lane == nts) ? (int)(unsigned)_c : ts_lo; ts_hi = (lane == nts) ? (int)(unsigned)(_c >> 32) : ts_hi; ++nts; } } while (0)
    unsigned voffA[2], voffB[2];
#pragma unroll
    for (int i = 0; i < 2; ++i) { int R, C; stage_rc(tid * 16 + i * 8192, R, C); const int Rb = Epi::PERM ? ((R & ~31) + perm32(R & 31)) : R;
        voffA[i] = (unsigned)(R * K + C) * 2u; voffB[i] = (unsigned)(Rb * K + C) * 2u; }
    const size_t kstep = (size_t)(BK * 2);
    const size_t hstep = (size_t)HALF * K * 2;
    const size_t tstep = 2 * hstep;
    const unsigned ldsw = (unsigned)wid * 1024u;
    const int aoff = lds_byte(wr * 64 + fr, fq * 8), boff = lds_byte(wc * 32 + fr, fq * 8);
#define PG8_SA(b, h) (((b) * 2 + (h)) * HTB)
#define PG8_SB(b, h) ((4 + (b) * 2 + (h)) * HTB)
#define PG8_STAGE(bufoff, gbase, voff) do { _Pragma("unroll") for (int _i = 0; _i < 2; ++_i) \
        __builtin_amdgcn_global_load_lds((const unsigned*)((const char*)(gbase) + (voff)[_i]), (PG8_LAS unsigned*)(lds + (bufoff) + ldsw + _i * 8192), 16, 0, 0); } while (0)
#define PG8_LDA(dst, b, h) do { _Pragma("unroll") for (int m = 0; m < 4; ++m) _Pragma("unroll") for (int k = 0; k < 2; ++k) dst[m][k] = *(const PG8_LAS bf16x8*)(lds + PG8_SA(b, h) + aoff + m * 2048 + k * 1024); } while (0)
#define PG8_LDB(dst, b, h) do { _Pragma("unroll") for (int n = 0; n < 2; ++n) _Pragma("unroll") for (int k = 0; k < 2; ++k) dst[n][k] = *(const PG8_LAS bf16x8*)(lds + PG8_SB(b, h) + boff + n * 2048 + k * 1024); } while (0)
#define PG8_MMA(ai, bj, At, Bt) do { __builtin_amdgcn_s_setprio(1); _Pragma("unroll") for (int m = 0; m < 4; ++m) _Pragma("unroll") for (int n = 0; n < 2; ++n) _Pragma("unroll") for (int k = 0; k < 2; ++k) \
        acc[ai][bj][m][n] = __builtin_amdgcn_mfma_f32_16x16x32_bf16(Bt[n][k], At[m][k], acc[ai][bj][m][n], 0, 0, 0); __builtin_amdgcn_s_setprio(0); } while (0)
#define PG8_WAIT_V(n) asm volatile("s_waitcnt vmcnt(" #n ")" ::: "memory")
#define PG8_WAIT_L(n) asm volatile("s_waitcnt lgkmcnt(" #n ")" ::: "memory")
#define PG8_BAR __builtin_amdgcn_s_barrier()
#define PG8_SCHED __builtin_amdgcn_sched_barrier(0)
    Unit cur, nxt; int ui = 0;
    if (!S.next(0, cur)) return;
    f32x4 acc[2][2][4][2];
#pragma unroll
    for (int a = 0; a < 2; ++a)
#pragma unroll
        for (int b = 0; b < 2; ++b)
#pragma unroll
            for (int m = 0; m < 4; ++m)
#pragma unroll
                for (int n = 0; n < 2; ++n) acc[a][b][m][n] = (f32x4){0.f, 0.f, 0.f, 0.f};
    bf16x8 At[4][2], B0[2][2], B1[2][2];
    const char* cA = (const char*)g.A + (size_t)cur.pm * tstep; const char* cB = (const char*)g.Bt + (size_t)cur.pn * tstep;
    S.a_ready(cur);
    PG8_STAGE(PG8_SB(0, 0), cB, voffB); PG8_STAGE(PG8_SA(0, 0), cA, voffA); PG8_STAGE(PG8_SB(0, 1), cB + hstep, voffB); PG8_STAGE(PG8_SA(0, 1), cA + hstep, voffA);
    if (wr == 1) PG8_BAR;
    PG8_WAIT_V(4); PG8_BAR;
    PG8_STAGE(PG8_SB(1, 0), cB + kstep, voffB); PG8_STAGE(PG8_SA(1, 0), cA + kstep, voffA); PG8_STAGE(PG8_SB(1, 1), cB + hstep + kstep, voffB);
    PG8_WAIT_V(6); PG8_BAR;
    for (;;) {
        const bool has_next = S.next(ui + 1, nxt);
        const char* nA = has_next ? (const char*)g.A + (size_t)nxt.pm * tstep : cA; const char* nB = has_next ? (const char*)g.Bt + (size_t)nxt.pn * tstep : cB;
        if constexpr (Epi::MID_T > 0) {
        for (int t = 0; t < Epi::MID_T; t += 2) {
            const bool last = (t == nt - 2);
            const char* a1 = cA + (size_t)(t + 1) * kstep;
            const char* a2 = last ? nA : cA + (size_t)(t + 2) * kstep; const char* b2 = last ? nB : cB + (size_t)(t + 2) * kstep;
            const char* a3 = a2 + kstep; const char* b3 = b2 + kstep;
            if (last && has_next) S.a_ready(nxt);
            PG8_LDB(B0, 0, 0); PG8_SCHED; PG8_LDA(At, 0, 0); PG8_STAGE(PG8_SA(1, 1), a1 + hstep, voffA);
            PG8_WAIT_L(8); PG8_BAR; PG8_WAIT_L(0); PG8_MMA(0, 0, At, B0); PG8_BAR; PG8_SCHED;
            PG8_LDB(B1, 0, 1); PG8_STAGE(PG8_SB(0, 0), b2, voffB);
            PG8_BAR; PG8_WAIT_L(0); PG8_MMA(0, 1, At, B1); PG8_BAR;
            PG8_LDA(At, 0, 1); PG8_STAGE(PG8_SA(0, 0), a2, voffA);
            PG8_BAR; PG8_WAIT_L(0); PG8_MMA(1, 0, At, B0); PG8_BAR; PG8_SCHED;
            PG8_STAGE(PG8_SB(0, 1), b2 + hstep, voffB);
            PG8_WAIT_V(6); PG8_BAR; PG8_MMA(1, 1, At, B1); PG8_BAR;
            PG8_LDB(B0, 1, 0); PG8_SCHED; PG8_LDA(At, 1, 0); PG8_STAGE(PG8_SA(0, 1), a2 + hstep, voffA);
            PG8_WAIT_L(8); PG8_BAR; PG8_WAIT_L(0); PG8_MMA(0, 0, At, B0); PG8_BAR; PG8_SCHED;
            PG8_LDB(B1, 1, 1); PG8_STAGE(PG8_SB(1, 0), b3, voffB);
            PG8_BAR; PG8_WAIT_L(0); PG8_MMA(0, 1, At, B1); PG8_BAR;
            PG8_LDA(At, 1, 1); PG8_STAGE(PG8_SA(1, 0), a3, voffA);
            PG8_BAR; PG8_WAIT_L(0); PG8_MMA(1, 0, At, B0); PG8_BAR; PG8_SCHED;
            PG8_STAGE(PG8_SB(1, 1), b3 + hstep, voffB);
            PG8_WAIT_V(6); PG8_BAR; PG8_MMA(1, 1, At, B1); PG8_BAR;
        }
        E.mid(acc, cur, wr, wc, fr, fq);
        for (int t = Epi::MID_T; t < nt; t += 2) {
            const bool last = (t == nt - 2);
            const char* a1 = cA + (size_t)(t + 1) * kstep;
            const char* a2 = last ? nA : cA + (size_t)(t + 2) * kstep; const char* b2 = last ? nB : cB + (size_t)(t + 2) * kstep;
            const char* a3 = a2 + kstep; const char* b3 = b2 + kstep;
            if (last && has_next) S.a_ready(nxt);
            PG8_LDB(B0, 0, 0); PG8_SCHED; PG8_LDA(At, 0, 0); PG8_STAGE(PG8_SA(1, 1), a1 + hstep, voffA);
            PG8_WAIT_L(8); PG8_BAR; PG8_WAIT_L(0); PG8_MMA(0, 0, At, B0); PG8_BAR; PG8_SCHED;
            PG8_LDB(B1, 0, 1); PG8_STAGE(PG8_SB(0, 0), b2, voffB);
            PG8_BAR; PG8_WAIT_L(0); PG8_MMA(0, 1, At, B1); PG8_BAR;
            PG8_LDA(At, 0, 1); PG8_STAGE(PG8_SA(0, 0), a2, voffA);
            PG8_BAR; PG8_WAIT_L(0); PG8_MMA(1, 0, At, B0); PG8_BAR; PG8_SCHED;
            PG8_STAGE(PG8_SB(0, 1), b2 + hstep, voffB);
            PG8_WAIT_V(6); PG8_BAR; PG8_MMA(1, 1, At, B1); PG8_BAR;
            PG8_LDB(B0, 1, 0); PG8_SCHED; PG8_LDA(At, 1, 0); PG8_STAGE(PG8_SA(0, 1), a2 + hstep, voffA);
            PG8_WAIT_L(8); PG8_BAR; PG8_WAIT_L(0); PG8_MMA(0, 0, At, B0); PG8_BAR; PG8_SCHED;
            PG8_LDB(B1, 1, 1); PG8_STAGE(PG8_SB(1, 0), b3, voffB);
            PG8_BAR; PG8_WAIT_L(0); PG8_MMA(0, 1, At, B1); PG8_BAR;
            PG8_LDA(At, 1, 1); PG8_STAGE(PG8_SA(1, 0), a3, voffA);
            PG8_BAR; PG8_WAIT_L(0); PG8_MMA(1, 0, At, B0); PG8_BAR; PG8_SCHED;
            PG8_STAGE(PG8_SB(1, 1), b3 + hstep, voffB);
            PG8_WAIT_V(6); PG8_BAR; PG8_MMA(1, 1, At, B1); PG8_BAR;
        }
        } else {
        for (int t = 0; t < nt; t += 2) {
            const bool last = (t == nt - 2);
            const char* a1 = cA + (size_t)(t + 1) * kstep;
            const char* a2 = last ? nA : cA + (size_t)(t + 2) * kstep; const char* b2 = last ? nB : cB + (size_t)(t + 2) * kstep;
            const char* a3 = a2 + kstep; const char* b3 = b2 + kstep;
            if (last && has_next) S.a_ready(nxt);
            PG8_LDB(B0, 0, 0); PG8_SCHED; PG8_LDA(At, 0, 0); PG8_STAGE(PG8_SA(1, 1), a1 + hstep, voffA);
            PG8_WAIT_L(8); PG8_BAR; PG8_WAIT_L(0); PG8_MMA(0, 0, At, B0); PG8_BAR; PG8_SCHED;
            PG8_LDB(B1, 0, 1); PG8_STAGE(PG8_SB(0, 0), b2, voffB);
            PG8_BAR; PG8_WAIT_L(0); PG8_MMA(0, 1, At, B1); PG8_BAR;
            PG8_LDA(At, 0, 1); PG8_STAGE(PG8_SA(0, 0), a2, voffA);
            PG8_BAR; PG8_WAIT_L(0); PG8_MMA(1, 0, At, B0); PG8_BAR; PG8_SCHED;
            PG8_STAGE(PG8_SB(0, 1), b2 + hstep, voffB);
            PG8_WAIT_V(6); PG8_BAR; PG8_MMA(1, 1, At, B1); PG8_BAR;
            PG8_LDB(B0, 1, 0); PG8_SCHED; PG8_LDA(At, 1, 0); PG8_STAGE(PG8_SA(0, 1), a2 + hstep, voffA);
            PG8_WAIT_L(8); PG8_BAR; PG8_WAIT_L(0); PG8_MMA(0, 0, At, B0); PG8_BAR; PG8_SCHED;
            PG8_LDB(B1, 1, 1); PG8_STAGE(PG8_SB(1, 0), b3, voffB);
            PG8_BAR; PG8_WAIT_L(0); PG8_MMA(0, 1, At, B1); PG8_BAR;
            PG8_LDA(At, 1, 1); PG8_STAGE(PG8_SA(1, 0), a3, voffA);
            PG8_BAR; PG8_WAIT_L(0); PG8_MMA(1, 0, At, B0); PG8_BAR; PG8_SCHED;
            PG8_STAGE(PG8_SB(1, 1), b3 + hstep, voffB);
            PG8_WAIT_V(6); PG8_BAR; PG8_MMA(1, 1, At, B1); PG8_BAR;
        }
        }
            if constexpr (!Epi::AFTER_DRAIN) { E(acc, cur, wr, wc, fr, fq); S.done(cur); }
            if (!has_next) break;
#pragma unroll
        for (int a = 0; a < 2; ++a)
#pragma unroll
            for (int b = 0; b < 2; ++b)
#pragma unroll
                for (int m = 0; m < 4; ++m)
#pragma unroll
                    for (int n = 0; n < 2; ++n) acc[a][b][m][n] = (f32x4){0.f, 0.f, 0.f, 0.f};
        cur = nxt; cA = nA; cB = nB; ++ui;
    }
    PG8_WAIT_V(0);
    if (wr == 0) PG8_BAR;
    PG8_BAR;
    if constexpr (Epi::AFTER_DRAIN) { E.fused(acc, cur, wr, wc, fr, fq, lds, wid, lane); S.done(cur); }
    if (STAMP && wid == 0) { stamps[lane] = lane < nts ? (((unsigned long long)(unsigned)ts_hi << 32) | (unsigned)ts_lo) : 0ull;
        if (lane == 62) stamps[62] = rt_entry; if (lane == 63) stamps[63] = (unsigned long long)wall_clock64(); }
#undef PG8_STAMP
#undef PG8_SA
#undef PG8_SB
#undef PG8_STAGE
#undef PG8_LDA
#undef PG8_LDB
#undef PG8_MMA
#undef PG8_WAIT_V
#undef PG8_WAIT_L
#undef PG8_BAR
#undef PG8_SCHED
}
}

typedef unsigned u32x4_ __attribute__((ext_vector_type(4)));
DEVI bf16x8 mk8(unsigned a, unsigned b, unsigned c, unsigned d) { u32x4_ v = {a, b, c, d}; return __builtin_bit_cast(bf16x8, v); }
DEVI float bflo(unsigned v) { return __uint_as_float(v << 16); }
DEVI float bfhi(unsigned v) { return __uint_as_float(v & 0xffff0000u); }
struct EpiProj {
  static constexpr bool PERM = true, AFTER_DRAIN = false; static constexpr int MID_T = 0;
  us *projA, *projB;
  DEVI void operator()(const f32x4 (&acc)[2][2][4][2], const pg8::Unit& u, int wr, int wc, int fr, int fq) const {
    const int row0 = u.pm * 256 + wr * 64 + fr;
#pragma unroll
    for (int bj = 0; bj < 2; ++bj) {
      const int nb = u.pn * 256 + bj * 128 + wc * 32;
      if (nb >= 5152) continue;
      us* dst; int ld, col, act;
      if (nb < 416) { dst = projA; ld = LDA_; col = nb; act = 0; }
      else if (nb < 928) { dst = projB; ld = LDB_; col = nb - 416; act = 1; }
      else if (nb < 2592) { dst = projA; ld = LDA_; col = nb - 928 + 416; act = 0; }
      else if (nb < 3104) { dst = projB; ld = LDB_; col = nb - 2592 + 512; act = 1; }
      else { dst = projB; ld = LDB_; col = nb - 3104 + 1024; act = 2; }
#pragma unroll
      for (int ai = 0; ai < 2; ++ai)
#pragma unroll
        for (int m = 0; m < 4; ++m) {
          f32x4 v0 = acc[ai][bj][m][0], v1 = acc[ai][bj][m][1];
          if (act == 1) {
#pragma unroll
            for (int r = 0; r < 4; ++r) { v0[r] = siluf_(v0[r]); v1[r] = siluf_(v1[r]); }
          } else if (act == 2) {
#pragma unroll
            for (int r = 0; r < 4; ++r) { v0[r] = sigmoidf_(v0[r]); v1[r] = sigmoidf_(v1[r]); }
          }
          uint4 o; o.x = pack2(v0[0], v0[1]); o.y = pack2(v0[2], v0[3]); o.z = pack2(v1[0], v1[1]); o.w = pack2(v1[2], v1[3]);
          __builtin_nontemporal_store(u32x4_{o.x, o.y, o.z, o.w}, (u32x4_*)(dst + (size_t)(row0 + ai * 128 + m * 16) * ld + col + 8 * fq));
        }
    }
  }
};
__device__ void phase2(const Params& p, unsigned char* smraw) {
  pg8::Gemm g{p.h, p.Wt_in, T_TOK, 5376, 1024};
  pg8::StaticOrder S; S.init(g.M, g.N, (int)gridDim.x, (int)blockIdx.x);
  EpiProj E{p.projA, p.projB};
  pg8::gemm_phase<EpiProj, pg8::StaticOrder, false>((PG8_LAS unsigned char*)smraw, g, S, E, nullptr);
}

#define REG_(i) ((us*)(smraw + (i) * 9216))
DEVI f32x4 mm_tile(const us* A, const us* B, int mt, int nt, int fr, int fq, f32x4 acc) {
#pragma unroll
  for (int ks = 0; ks < 2; ++ks) {
    bf16x8 a = *(const bf16x8*)(A + (mt * 16 + fr) * 72 + ks * 32 + fq * 8);
    bf16x8 b = *(const bf16x8*)(B + (nt * 16 + fr) * 72 + ks * 32 + fq * 8);
    acc = mfma16(a, b, acc);
  }
  return acc;
}
typedef short v4s_ __attribute__((ext_vector_type(4)));
DEVI bf16x8 frag_tr(const us* X, int r0, int ks, int lane) {
  const int grp = lane >> 4, i = lane & 15;
  const us* a0 = X + (ks * 32 + 8 * grp + (i >> 2)) * 72 + r0 + 4 * (i & 3);
  const v4s_ lo = __builtin_amdgcn_ds_read_tr16_b64_v4i16((__attribute__((address_space(3))) v4s_*)a0);
  const v4s_ hi = __builtin_amdgcn_ds_read_tr16_b64_v4i16((__attribute__((address_space(3))) v4s_*)(a0 + 4 * 72));
  return bf16x8{lo[0], lo[1], lo[2], lo[3], hi[0], hi[1], hi[2], hi[3]};
}
template <bool TA, bool TB>
DEVI f32x4 mm_tile_x(const us* A, const us* B, int mt, int nt, int lane, f32x4 acc) {
  const int fr = lane & 15, fq = lane >> 4;
#pragma unroll
  for (int ks = 0; ks < 2; ++ks) {
    const bf16x8 a = TA ? frag_tr(A, mt * 16, ks, lane) : *(const bf16x8*)(A + (mt * 16 + fr) * 72 + ks * 32 + fq * 8);
    const bf16x8 b = TB ? frag_tr(B, nt * 16, ks, lane) : *(const bf16x8*)(B + (nt * 16 + fr) * 72 + ks * 32 + fq * 8);
    acc = mfma16(a, b, acc);
  }
  return acc;
}
DEVI void storeT_nt(us* dst, int ld, int mt, int nt, int fr, int fq, f32x4 v) {
  const uint2 q = pack4(v);
  __builtin_nontemporal_store(u32x2n_{q.x, q.y}, (u32x2n_*)(dst + (nt * 16 + fr) * ld + mt * 16 + fq * 4));
}
DEVI void storeT(us* dst, int ld, int mt, int nt, int fr, int fq, f32x4 v) {
  *(uint2*)(dst + (nt * 16 + fr) * ld + mt * 16 + fq * 4) = pack4(v);
}
DEVI f32x4 maskv(f32x4 v, int mt, int nt, int fr, int fq, int mode) {
  const int n = nt * 16 + fr, m0 = mt * 16 + fq * 4;
#pragma unroll
  for (int r = 0; r < 4; ++r) {
    const int m = m0 + r;
    bool keep = (mode == 0) ? (m < n) : (mode == 1) ? (m <= n) : (n < m);
    if (!keep) v[r] = 0.f;
  }
  return v;
}
struct WkvRaw { bf16x8 cur[5], prv[5]; };
DEVI void wkv_load_raw(const Params& p, int item, WkvRaw& R) {
  const int tid = tidx();
  const int h = item & 7, bc = item >> 3, b = bc >> 6, c = bc & 63;
  const int t = tid >> 3, j0 = (tid & 7) * 8, jc = h * 64 + j0;
  const bool hp = (c * 64 + t) > 0;
  const us* rowp = p.projA + (size_t)(b * SEQ + c * 64 + t) * LDA_ + 416;
  const int offs[5] = {jc, 512 + jc, 1024 + jc, 1536 + j0, 1600 + j0};
#pragma unroll
  for (int q = 0; q < 5; ++q) {
    R.cur[q] = *(const bf16x8*)(rowp + offs[q]);
    R.prv[q] = hp ? *(const bf16x8*)(rowp + offs[q] - LDA_) : R.cur[q];
  }
}
DEVI void shift8(bf16x8 cur, bf16x8 prv, bool hasprev, const float* mu, float (&o)[8]) {
  const float4 m0 = *(const float4*)mu, m1 = *(const float4*)(mu + 4);
  const float mm[8] = {m0.x, m0.y, m0.z, m0.w, m1.x, m1.y, m1.z, m1.w};
#pragma unroll
  for (int e = 0; e < 8; ++e) {
    float cv = bf2f((us)cur[e]);
    float pv = hasprev ? bf2f((us)prv[e]) : 0.f;
    o[e] = cv + (pv - cv) * mm[e];
  }
}
DEVI void ld8f(const float* ptr, float (&o)[8]) {
  const float4 a = *(const float4*)ptr, b = *(const float4*)(ptr + 4);
  o[0] = a.x; o[1] = a.y; o[2] = a.z; o[3] = a.w; o[4] = b.x; o[5] = b.y; o[6] = b.z; o[7] = b.w;
}
DEVI float fast_tanh(float x) { const float e = __builtin_amdgcn_exp2f(2.8853900817779268f * x); return 1.f - 2.f * __builtin_amdgcn_rcpf(e + 1.f); }

__device__ void wkv_prep_item(const Params& p, int item, int next_item, WkvRaw& RW, unsigned char* smraw) {
  const int tid = tidx(), lane = tid & 63, w = tid >> 6, fr = lane & 15, fq = lane >> 4;
  const int h = item & 7, bc = item >> 3, b = bc >> 6, c = bc & 63;
  const int ch = (b * 8 + h) * 64 + c;
  const int tok0 = b * SEQ + c * 64;
  const int t = tid >> 3, j0 = (tid & 7) * 8, jc = h * 64 + j0;
  const f32x4 z4 = {0.f, 0.f, 0.f, 0.f};
  us *At = REG_(0), *Bt = REG_(1), *Kt = REG_(2), *Rt = REG_(3), *BhT = REG_(4), *KhT = REG_(5), *VT = REG_(6);
  us *P0 = REG_(7), *PT0 = REG_(8), *P1 = REG_(9), *PT1 = REG_(10), *Aak = REG_(11), *Arb = REG_(12), *Ark = REG_(13);
  us* UT = REG_(14);
  float* F = (float*)REG_(9);
  float* G = (float*)REG_(14);
  float* segsum = (float*)(smraw + 16 * 9216);

  float rr[8], kk_[8], vv[8], wd[8], ad[8];
  {
    const bool hp = (c * 64 + t) > 0;
    shift8(RW.cur[0], RW.prv[0], hp, p.mu + jc, rr);
    shift8(RW.cur[1], RW.prv[1], hp, p.mu + 512 + jc, kk_);
    shift8(RW.cur[2], RW.prv[2], hp, p.mu + 1024 + jc, vv);
    shift8(RW.cur[3], RW.prv[3], hp, p.mu + 1536 + j0, wd);
    shift8(RW.cur[4], RW.prv[4], hp, p.mu + 1600 + j0, ad);
  }
  {
    uint4 o1, o2;
    o1.x = pack2(fast_tanh(wd[0]), fast_tanh(wd[1])); o1.y = pack2(fast_tanh(wd[2]), fast_tanh(wd[3]));
    o1.z = pack2(fast_tanh(wd[4]), fast_tanh(wd[5])); o1.w = pack2(fast_tanh(wd[6]), fast_tanh(wd[7]));
    o2.x = pack2(ad[0], ad[1]); o2.y = pack2(ad[2], ad[3]); o2.z = pack2(ad[4], ad[5]); o2.w = pack2(ad[6], ad[7]);
    *(uint4*)(P0 + t * 72 + j0) = o1;
    *(uint4*)(PT0 + t * 72 + j0) = o2;
  }
  lds_barrier();
  {
    const int which = w >> 2, tt = w & 3;
    const us* A = which ? PT0 : P0;
    const us* Wt = (which ? p.Wt_icl : p.Wt_dec) + (size_t)h * 64 * 64;
    float* Fw = F + which * 4160;
#pragma unroll
    for (int jt = 0; jt < 4; ++jt) {
      f32x4 acc = z4;
#pragma unroll
      for (int ks = 0; ks < 2; ++ks) {
        bf16x8 a = *(const bf16x8*)(A + (tt * 16 + fr) * 72 + ks * 32 + fq * 8);
        bf16x8 bq = *(const bf16x8*)(Wt + (jt * 16 + fr) * 64 + ks * 32 + fq * 8);
        acc = mfma16(a, bq, acc);
      }
#pragma unroll
      for (int r = 0; r < 4; ++r) Fw[(tt * 16 + fq * 4 + r) * 65 + jt * 16 + fr] = acc[r];
    }
  }
  lds_barrier();
  float lw[8], av[8], kn[8], kp[8];
  {
    float ss = 0.f;
    float pw0[8], pa0[8], pkk[8], pka[8];
    ld8f(p.w0 + jc, pw0); ld8f(p.a0 + jc, pa0); ld8f(p.k_k + jc, pkk); ld8f(p.k_a + jc, pka);
#pragma unroll
    for (int e = 0; e < 8; ++e) {
      float dl = pw0[e] + F[t * 65 + j0 + e];
      float al = pa0[e] + F[4160 + t * 65 + j0 + e];
      float xneg = -dl;
      float sp = fmaxf(xneg, 0.f) + __logf(1.f + __expf(-fabsf(xneg)));
      float wl = -sp - 0.5f;
      lw[e] = -__expf(wl);
      av[e] = sigmoidf_(al);
      float kq = kk_[e] * pkk[e];
      kn[e] = kq;
      ss += kq * kq;
      kp[e] = kk_[e] * (1.f + (av[e] - 1.f) * pka[e]);
    }
    ss += __shfl_xor(ss, 1); ss += __shfl_xor(ss, 2); ss += __shfl_xor(ss, 4);
    const float inv = 1.f / fmaxf(sqrtf(ss), 1e-12f);
    float bon = 0.f;
    float prk[8];
    ld8f(p.r_k + jc, prk);
#pragma unroll
    for (int e = 0; e < 8; ++e) {
      kn[e] *= inv;
      bon += rr[e] * kp[e] * prk[e];
    }
    bon += __shfl_xor(bon, 1); bon += __shfl_xor(bon, 2); bon += __shfl_xor(bon, 4);
    uint4 o;
    o.x = pack2(bon * vv[0], bon * vv[1]); o.y = pack2(bon * vv[2], bon * vv[3]);
    o.z = pack2(bon * vv[4], bon * vv[5]); o.w = pack2(bon * vv[6], bon * vv[7]);
    __builtin_nontemporal_store(u32x4_{o.x, o.y, o.z, o.w}, (u32x4_*)(p.bv + (size_t)(tok0 + t) * 512 + jc));
  }
  lds_barrier();
#pragma unroll
  for (int e = 0; e < 8; ++e) G[t * 65 + j0 + e] = lw[e];
  lds_barrier();
  {
    const int j = tid & 63, seg = tid >> 6;
    float run = 0.f;
#pragma unroll
    for (int i = 0; i < 8; ++i) { run += G[(seg * 8 + i) * 65 + j]; G[(seg * 8 + i) * 65 + j] = run; }
    segsum[seg * 64 + j] = run;
    lds_barrier();
    float off = 0.f;
    for (int s2 = 0; s2 < seg; ++s2) off += segsum[s2 * 64 + j];
#pragma unroll
    for (int i = 0; i < 8; ++i) G[(seg * 8 + i) * 65 + j] += off;
  }
  lds_barrier();
  {
    float ta[8], tb[8], tk[8], tr[8], tbh[8], tkh[8];
#pragma unroll
    for (int e = 0; e < 8; ++e) {
      const float g = G[t * 65 + j0 + e], gC = G[63 * 65 + j0 + e];
      const float eg = __expf(g), eng = __expf(-g), egx = __expf(g - lw[e]), egc = __expf(gC - g);
      ta[e] = -kn[e] * egx;
      tb[e] = kn[e] * av[e] * eng;
      tk[e] = kp[e] * eng;
      tr[e] = rr[e] * eg;
      tbh[e] = kn[e] * av[e] * egc;
      tkh[e] = kp[e] * egc;
      if (t == 0) p.Gc[ch * 64 + j0 + e] = __expf(gC);
    }
    uint4 o;
    o.x = pack2(ta[0], ta[1]); o.y = pack2(ta[2], ta[3]); o.z = pack2(ta[4], ta[5]); o.w = pack2(ta[6], ta[7]);
    *(uint4*)(At + t * 72 + j0) = o;
    o.x = pack2(tb[0], tb[1]); o.y = pack2(tb[2], tb[3]); o.z = pack2(tb[4], tb[5]); o.w = pack2(tb[6], tb[7]);
    *(uint4*)(Bt + t * 72 + j0) = o;
    o.x = pack2(tk[0], tk[1]); o.y = pack2(tk[2], tk[3]); o.z = pack2(tk[4], tk[5]); o.w = pack2(tk[6], tk[7]);
    *(uint4*)(Kt + t * 72 + j0) = o;
    o.x = pack2(tr[0], tr[1]); o.y = pack2(tr[2], tr[3]); o.z = pack2(tr[4], tr[5]); o.w = pack2(tr[6], tr[7]);
    *(uint4*)(Rt + t * 72 + j0) = o;
    o.x = pack2(tbh[0], tbh[1]); o.y = pack2(tbh[2], tbh[3]); o.z = pack2(tbh[4], tbh[5]); o.w = pack2(tbh[6], tbh[7]);
    *(uint4*)(BhT + t * 72 + j0) = o;
    o.x = pack2(tkh[0], tkh[1]); o.y = pack2(tkh[2], tkh[3]); o.z = pack2(tkh[4], tkh[5]); o.w = pack2(tkh[6], tkh[7]);
    *(uint4*)(KhT + t * 72 + j0) = o;
    o.x = pack2(vv[0], vv[1]); o.y = pack2(vv[2], vv[3]); o.z = pack2(vv[4], vv[5]); o.w = pack2(vv[6], vv[7]);
    *(uint4*)(VT + t * 72 + j0) = o;
  }
  lds_barrier();
#pragma unroll
  for (int q = 0; q < 2; ++q) {
    const int id = w * 2 + q, mt = id >> 2, nt = id & 3;
    storeT(P0, 72, mt, nt, fr, fq, maskv(mm_tile(Bt, At, mt, nt, fr, fq, z4), mt, nt, fr, fq, 0));
  }
  lds_barrier();
  us* Tb = PT0;
  us* UTw = UT + w * 16 * 72;
  if (w == 0) {
    const int blk = lane >> 4, cc = lane & 15;
    float Tc[16];
#pragma unroll
    for (int r = 0; r < 16; ++r) Tc[r] = 0.f;
#pragma unroll
    for (int r = 0; r < 16; ++r) {
      float v = (r == cc) ? 1.f : 0.f;
      if (r > 0) {
        const us* arow = P0 + (blk * 16 + r) * 72 + blk * 16;
        const uint4 lo = *(const uint4*)arow;
        const uint4 hi = *(const uint4*)(arow + 8);
        const unsigned wv[8] = {lo.x, lo.y, lo.z, lo.w, hi.x, hi.y, hi.z, hi.w};
#pragma unroll
        for (int s2 = 0; s2 < r; ++s2) v += ((s2 & 1) ? bfhi(wv[s2 >> 1]) : bflo(wv[s2 >> 1])) * Tc[s2];
      }
      Tc[r] = v;
    }
#pragma unroll
    for (int r = 0; r < 16; ++r) Tb[blk * 256 + r * 16 + cc] = f2bf(Tc[r]);
  } else {
    for (int L = w - 1; L < 48; L += 7) {
      const int which = L >> 4, id = L & 15, mt = id >> 2, nt = id & 3;
      if (which == 0) storeT(Aak, 72, mt, nt, fr, fq, maskv(mm_tile(Kt, At, mt, nt, fr, fq, z4), mt, nt, fr, fq, 0));
      else if (which == 1) storeT(Arb, 72, mt, nt, fr, fq, maskv(mm_tile(Bt, Rt, mt, nt, fr, fq, z4), mt, nt, fr, fq, 1));
      else storeT(Ark, 72, mt, nt, fr, fq, maskv(mm_tile(Kt, Rt, mt, nt, fr, fq, z4), mt, nt, fr, fq, 1));
    }
  }
  {
    const uint4 zz = make_uint4(0u, 0u, 0u, 0u);
    *(uint4*)(UTw + (lane >> 2) * 72 + (lane & 3) * 16) = zz;
    *(uint4*)(UTw + (lane >> 2) * 72 + (lane & 3) * 16 + 8) = zz;
  }
  lds_barrier();
  if (next_item < 4096) wkv_load_raw(p, next_item, RW);
  {
    f32x4 zI[4];
    if (w >= 4) {
#pragma unroll
      for (int I = 0; I < 4; ++I) zI[I] = mm_tile_x<false, true>(Aak, VT, I, w - 4, lane, z4);
    } else {
#pragma unroll
      for (int I = 0; I < 4; ++I)
#pragma unroll
        for (int r = 0; r < 4; ++r) zI[I][r] = bf2f(At[(I * 16 + fq * 4 + r) * 72 + w * 16 + fr]);
    }
#pragma unroll
    for (int I = 0; I < 4; ++I) {
      f32x4 rhs = zI[I];
      if (I >= 1) {
#pragma unroll
        for (int ks = 0; ks < (I == 3 ? 2 : 1); ++ks) {
          const bf16x8 a = *(const bf16x8*)(P0 + (I * 16 + fr) * 72 + ks * 32 + fq * 8);
          const bf16x8 b = *(const bf16x8*)(UTw + fr * 72 + ks * 32 + fq * 8);
          rhs = mfma16(a, b, rhs);
        }
      }
      const uint2 tq = *(const uint2*)(Tb + I * 256 + fr * 16 + fq * 4);
      const uint2 rq = pack4(rhs);
      const f32x4 uI = mfma16(mk8(tq.x, tq.y, 0u, 0u), mk8(rq.x, rq.y, 0u, 0u), z4);
      *(uint2*)(UTw + fr * 72 + I * 16 + fq * 4) = pack4(uI);
    }
  }
  lds_barrier();
  {
    const int o = w >> 1;
    const us* U1 = UT;
    const us* U0 = UT + 64 * 72;
    for (int q = 0; q < 8; ++q) {
      const int id = (w & 1) * 8 + q, mt = id >> 2, nt = id & 3;
      if (o == 0) {
        f32x4 cc = mm_tile_x<false, true>(U1, BhT, mt, nt, lane, z4);
        storeT_nt(p.Mp + (size_t)ch * 4096, 64, mt, nt, fr, fq, cc);
      } else if (o == 1) {
        f32x4 cc = mm_tile_x<true, false>(BhT, U0, mt, nt, lane, z4);
        cc = mm_tile_x<true, true>(KhT, VT, mt, nt, lane, cc);
        storeT_nt(p.Nt + (size_t)ch * 4096, 64, mt, nt, fr, fq, cc);
      } else if (o == 2) {
        f32x4 cc = mm_tile(U1, Arb, mt, nt, fr, fq, z4);
#pragma unroll
        for (int r = 0; r < 4; ++r) cc[r] += bf2f(Rt[(nt * 16 + fr) * 72 + mt * 16 + fq * 4 + r]);
        storeT_nt(p.Y1 + (size_t)ch * 4096, 64, mt, nt, fr, fq, cc);
      } else {
        f32x4 cc = mm_tile(U0, Arb, mt, nt, fr, fq, z4);
        cc = mm_tile_x<true, false>(VT, Ark, mt, nt, lane, cc);
        storeT_nt(p.Y0t + (size_t)ch * 4096, 64, mt, nt, fr, fq, cc);
      }
    }
  }
  lds_barrier();
}

#define P3_COMMON \
  us* sm = (us*)smraw; \
  float* rs = (float*)(smraw + 2 * GST * 2); \
  const int tid = tidx(), lane = tid & 63, wid = tid >> 6; \
  const int wx = wid >> 2, wy = wid & 3, fr = lane & 15, fq = lane >> 4;
__device__ void phase3q(const Params& p, unsigned char* smraw) {
  P3_COMMON
  for (int it = blockIdx.x; it < 6 * 128; it += gridDim.x) {
    {
      const int yt = it / 6, xt = it % 6, x0 = xt * 128, y0 = yt * 256;
      f32x4 acc[4][4];
      zero_acc(acc);
      gemm_main<true>(p.Wt_uq + (size_t)x0 * 256, 256, p.projA + (size_t)y0 * LDA_, LDA_, 256, sm, acc, rs, 1.f / 256.f, 1e-6f);
#pragma unroll
      for (int j = 0; j < 4; ++j) {
        const int tl = wy * 64 + j * 16 + fr, tk = y0 + tl;
        const float rstd = rs[tl];
        const int bb = tk >> 12, s = tk & 4095;
#pragma unroll
        for (int i = 0; i < 4; ++i) {
          const int nb = x0 + wx * 64 + i * 16;
          const int hd = nb / 96, dq = nb % 96;
          us* qrow = p.Q + ((size_t)(bb * 8 + hd) * SEQ + s) * 96;
          if (dq < 64) {
            f32x4 v = acc[i][j] * rstd;
            *(uint2*)(qrow + dq + fq * 4) = pack4(v);
          } else if (dq == 64) {
            if (i < 3) {
              f32x4 t1 = acc[i][j] * rstd, t2 = acc[(i + 1) & 3][j] * rstd, o1, o2;
              const float4 cv = *(const float4*)(p.cs + (size_t)tk * 32 + fq * 4);
              const float4 sv = *(const float4*)(p.cs + (size_t)tk * 32 + 16 + fq * 4);
              o1[0] = t1[0] * cv.x - t2[0] * sv.x; o2[0] = t1[0] * sv.x + t2[0] * cv.x;
              o1[1] = t1[1] * cv.y - t2[1] * sv.y; o2[1] = t1[1] * sv.y + t2[1] * cv.y;
              o1[2] = t1[2] * cv.z - t2[2] * sv.z; o2[2] = t1[2] * sv.z + t2[2] * cv.z;
              o1[3] = t1[3] * cv.w - t2[3] * sv.w; o2[3] = t1[3] * sv.w + t2[3] * cv.w;
              *(uint2*)(qrow + 64 + fq * 4) = pack4(o1);
              *(uint2*)(qrow + 80 + fq * 4) = pack4(o2);
            }
          }
        }
      }
      lds_barrier();
    }
  }
}
__device__ void phase3kv(const Params& p, unsigned char* smraw) {
  P3_COMMON
  for (int it = blockIdx.x; it < 8 * 128; it += gridDim.x) {
    {
      const int r = it, yt = r >> 3, xt = r & 7, x0 = xt * 128, y0 = yt * 256;
      f32x4 acc[4][4];
      zero_acc(acc);
      gemm_main<true, true>(p.Wt_ukv + (size_t)x0 * 128, 128, p.projA + (size_t)y0 * LDA_ + 256, LDA_, 128, sm, acc, rs, 1.f / 128.f, 1e-6f);
      const int hd = xt;
      if (wx == 0) {
#pragma unroll
        for (int j = 0; j < 4; ++j) {
          const int tl = wy * 64 + j * 16 + fr, tk = y0 + tl;
          const float rstd = rs[tl];
          const int bb = tk >> 12, s = tk & 4095;
#pragma unroll
          for (int i = 0; i < 4; ++i) {
            f32x4 v = acc[i][j] * rstd;
            *(uint2*)(p.K + ((size_t)(bb * 8 + hd) * SEQ + s) * 96 + i * 16 + fq * 4) = pack4(v);
          }
        }
      } else {
#pragma unroll
        for (int j = 0; j < 4; ++j) {
          const int tl0 = wy * 64 + j * 16 + fq * 4, tk0 = y0 + tl0;
          const f32x4 r4 = *(const f32x4*)(rs + tl0);
          const int bb = tk0 >> 12, s0 = tk0 & 4095;
#pragma unroll
          for (int i = 0; i < 4; ++i) {
            f32x4 v = acc[i][j] * r4;
            *(uint2*)(p.Vt + ((size_t)(bb * 8 + hd) * 64 + i * 16 + fr) * SEQ + s0) = pack4(v);
          }
        }
      }
      lds_barrier();
    }
  }
}
__device__ void phase3w(const Params& p, unsigned char* smraw) {
  const int tid = tidx();
  {
    WkvRaw RW;
    if ((int)blockIdx.x < 4096) wkv_load_raw(p, blockIdx.x, RW);
    for (int it = blockIdx.x; it < 4096; it += gridDim.x) wkv_prep_item(p, it, it + (int)gridDim.x, RW, smraw);
  }
  const int gt = blockIdx.x * NTHR + tid, gs = gridDim.x * NTHR;
  for (int i = gt; i < T_TOK * 32; i += gs) {
    const int tk = i >> 5, hd = (i >> 2) & 7, pc = i & 3;
    const int p0 = (pc & 1) * 8;
    const us* kr_in = p.projA + (size_t)tk * LDA_ + 384;
    const uint4 a4 = *(const uint4*)(kr_in + p0), b4 = *(const uint4*)(kr_in + 16 + p0);
    float t1[8], t2[8], cv[8], sv[8];
    t1[0] = bflo(a4.x); t1[1] = bfhi(a4.x); t1[2] = bflo(a4.y); t1[3] = bfhi(a4.y); t1[4] = bflo(a4.z); t1[5] = bfhi(a4.z); t1[6] = bflo(a4.w); t1[7] = bfhi(a4.w);
    t2[0] = bflo(b4.x); t2[1] = bfhi(b4.x); t2[2] = bflo(b4.y); t2[3] = bfhi(b4.y); t2[4] = bflo(b4.z); t2[5] = bfhi(b4.z); t2[6] = bflo(b4.w); t2[7] = bfhi(b4.w);
    ld8f(p.cs + (size_t)tk * 32 + p0, cv);
    ld8f(p.cs + (size_t)tk * 32 + 16 + p0, sv);
    float o[8];
#pragma unroll
    for (int e = 0; e < 8; ++e) o[e] = (pc < 2) ? (t1[e] * cv[e] - t2[e] * sv[e]) : (t1[e] * sv[e] + t2[e] * cv[e]);
    uint4 q; q.x = pack2(o[0], o[1]); q.y = pack2(o[2], o[3]); q.z = pack2(o[4], o[5]); q.w = pack2(o[6], o[7]);
    const int bb = tk >> 12, sq = tk & 4095;
    *(uint4*)(p.K + ((size_t)(bb * 8 + hd) * SEQ + sq) * 96 + 64 + (pc >> 1) * 16 + p0) = q;
  }
}

typedef unsigned u32x2_ __attribute__((ext_vector_type(2)));
struct ScanLd { u32x4_ a[4][2]; f32x4 g[4]; u32x2_ nn[4]; };
DEVI void scan_load(const Params& p, size_t ch, int vs, int fr, int fq, ScanLd& L) {
  const us* mp = p.Mp + ch * 4096;
  const us* nt = p.Nt + ch * 4096 + (vs * 16 + fr) * 64 + fq * 4;
  const float* gc = p.Gc + ch * 64 + fq * 4;
#pragma unroll
  for (int m = 0; m < 4; ++m) {
    L.g[m] = *(const f32x4*)(gc + m * 16);
    L.nn[m] = *(const u32x2_*)(nt + m * 16);
#pragma unroll
    for (int ks = 0; ks < 2; ++ks) {
      const u32x2_ lo = *(const u32x2_*)(mp + (m * 16 + fr) * 64 + ks * 32 + fq * 4);
      const u32x2_ hi = *(const u32x2_*)(mp + (m * 16 + fr) * 64 + ks * 32 + 16 + fq * 4);
      L.a[m][ks] = u32x4_{lo[0], lo[1], hi[0], hi[1]};
    }
  }
}
DEVI void scan_step(f32x4 (&H)[4], const ScanLd& L) {
  bf16x8 bop[2];
#pragma unroll
  for (int ks = 0; ks < 2; ++ks) {
    uint2 lo = pack4(H[2 * ks]), hi = pack4(H[2 * ks + 1]);
    bop[ks] = mk8(lo.x, lo.y, hi.x, hi.y);
  }
#pragma unroll
  for (int m = 0; m < 4; ++m) {
    f32x4 hn;
    hn[0] = L.g[m][0] * H[m][0] + bflo(L.nn[m][0]);
    hn[1] = L.g[m][1] * H[m][1] + bfhi(L.nn[m][0]);
    hn[2] = L.g[m][2] * H[m][2] + bflo(L.nn[m][1]);
    hn[3] = L.g[m][3] * H[m][3] + bfhi(L.nn[m][1]);
#pragma unroll
    for (int ks = 0; ks < 2; ++ks) hn = mfma16(__builtin_bit_cast(bf16x8, L.a[m][ks]), bop[ks], hn);
    H[m] = hn;
  }
}
DEVI void scan_store(const Params& p, size_t ch, int vs, int fr, int fq, const f32x4 (&H)[4]) {
  us* hh = p.Hh + ch * 4096 + (vs * 16 + fr) * 64 + fq * 4;
#pragma unroll
  for (int m = 0; m < 4; ++m) { const uint2 q = pack4(H[m]); __builtin_nontemporal_store(u32x2n_{q.x, q.y}, (u32x2n_*)(hh + m * 16)); }
}
__device__ void wkv_scan_item(const Params& p, int item) {
  const int lane = tidx() & 63, fr = lane & 15, fq = lane >> 4;
  const int bh = item >> 2, vs = item & 3;
  const size_t ch0 = (size_t)bh * 64;
  f32x4 H[4];
#pragma unroll
  for (int m = 0; m < 4; ++m) H[m] = f32x4{0.f, 0.f, 0.f, 0.f};
  ScanLd L0, L1, L2;
  scan_load(p, ch0, vs, fr, fq, L0);
  scan_load(p, ch0 + 1, vs, fr, fq, L1);
  scan_load(p, ch0 + 2, vs, fr, fq, L2);
  for (int c = 0; c < 63; c += 3) {
    scan_store(p, ch0 + c, vs, fr, fq, H); scan_step(H, L0); scan_load(p, ch0 + min(c + 3, 62), vs, fr, fq, L0);
    scan_store(p, ch0 + c + 1, vs, fr, fq, H); scan_step(H, L1); scan_load(p, ch0 + min(c + 4, 62), vs, fr, fq, L1);
    scan_store(p, ch0 + c + 2, vs, fr, fq, H); scan_step(H, L2); scan_load(p, ch0 + min(c + 5, 62), vs, fr, fq, L2);
  }
  scan_store(p, ch0 + 63, vs, fr, fq, H);
}

constexpr int SC_G = 6, SC_NT = 64 * 144, SC_GC = SC_NT + 16 * 144, SC_SLOT = SC_GC + 256, SC_NGRP = 11;
__device__ void wkv_scan_block(const Params& p, int item, unsigned char* smraw) {
  const int tid = tidx(), lane = tid & 63, w = tid >> 6, fr = lane & 15, fq = lane >> 4;
  const int bh = item >> 2, vs = item & 3;
  const size_t ch0 = (size_t)bh * 64;
  bf16x8 gm[SC_G], gn[2];
  f32x4 gg;
  const int mrow = tid >> 3, mcol = (tid & 7) * 8;
  int nslot[2], nrow[2], ncol[2];
#pragma unroll
  for (int q = 0; q < 2; ++q) { const int id = tid + 512 * q; nslot[q] = id >> 7; nrow[q] = (id & 127) >> 3; ncol[q] = (id & 7) * 8; }
  const int gslot = tid >> 4, gcol = (tid & 15) * 4;
#define SC_LOAD(g0) { \
    _Pragma("unroll") for (int q = 0; q < SC_G; ++q) gm[q] = *(const bf16x8*)(p.Mp + (ch0 + min((g0) + q, 62)) * 4096 + mrow * 64 + mcol); \
    _Pragma("unroll") for (int q = 0; q < 2; ++q) if (tid + 512 * q < SC_G * 128) \
      gn[q] = *(const bf16x8*)(p.Nt + (ch0 + min((g0) + nslot[q], 62)) * 4096 + (vs * 16 + nrow[q]) * 64 + ncol[q]); \
    if (tid < SC_G * 16) gg = *(const f32x4*)(p.Gc + (ch0 + min((g0) + gslot, 62)) * 64 + gcol); }
#define SC_WRITE(buf) { unsigned char* bb = smraw + (buf) * (SC_G * SC_SLOT); \
    _Pragma("unroll") for (int q = 0; q < SC_G; ++q) *(bf16x8*)(bb + q * SC_SLOT + mrow * 144 + mcol * 2) = gm[q]; \
    _Pragma("unroll") for (int q = 0; q < 2; ++q) if (tid + 512 * q < SC_G * 128) \
      *(bf16x8*)(bb + nslot[q] * SC_SLOT + SC_NT + nrow[q] * 144 + ncol[q] * 2) = gn[q]; \
    if (tid < SC_G * 16) *(f32x4*)(bb + gslot * SC_SLOT + SC_GC + gcol * 4) = gg; }
  f32x4 H[4];
#pragma unroll
  for (int m = 0; m < 4; ++m) H[m] = f32x4{0.f, 0.f, 0.f, 0.f};
  SC_LOAD(0)
  SC_WRITE(0)
  lds_barrier();
  for (int g = 0; g < SC_NGRP; ++g) {
    if (g + 1 < SC_NGRP) SC_LOAD((g + 1) * SC_G)
    if (w == 0) {
      const unsigned char* bb = smraw + (g & 1) * (SC_G * SC_SLOT);
#pragma unroll
      for (int q = 0; q < SC_G; ++q) {
        const int c = g * SC_G + q;
        if (c < 63) {
          scan_store(p, ch0 + c, vs, fr, fq, H);
          const unsigned char* sl = bb + q * SC_SLOT;
          bf16x8 bop[2];
#pragma unroll
          for (int ks = 0; ks < 2; ++ks) {
            const uint2 lo = pack4(H[2 * ks]), hi = pack4(H[2 * ks + 1]);
            bop[ks] = mk8(lo.x, lo.y, hi.x, hi.y);
          }
#pragma unroll
          for (int m = 0; m < 4; ++m) {
            const f32x4 gv = *(const f32x4*)(sl + SC_GC + (m * 16 + fq * 4) * 4);
            const uint2 nn = *(const uint2*)(sl + SC_NT + fr * 144 + (m * 16 + fq * 4) * 2);
            f32x4 hn;
            hn[0] = gv[0] * H[m][0] + bflo(nn.x); hn[1] = gv[1] * H[m][1] + bfhi(nn.x);
            hn[2] = gv[2] * H[m][2] + bflo(nn.y); hn[3] = gv[3] * H[m][3] + bfhi(nn.y);
#pragma unroll
            for (int ks = 0; ks < 2; ++ks) {
              const uint2 lo = *(const uint2*)(sl + (m * 16 + fr) * 144 + (ks * 32 + fq * 4) * 2);
              const uint2 hi = *(const uint2*)(sl + (m * 16 + fr) * 144 + (ks * 32 + 16 + fq * 4) * 2);
              hn = mfma16(mk8(lo.x, lo.y, hi.x, hi.y), bop[ks], hn);
            }
            H[m] = hn;
          }
        }
      }
    }
    if (g + 1 < SC_NGRP) SC_WRITE((g + 1) & 1)
    lds_barrier();
  }
  if (w == 0) scan_store(p, ch0 + 63, vs, fr, fq, H);
#undef SC_LOAD
#undef SC_WRITE
}

constexpr int AKS = 104, AVS = 68, ASTG = 64 * AKS + 64 * AVS;
__device__ void attn_item(const Params& p, int bh, int qt, unsigned char* smraw) {
  us* sm = (us*)smraw;
  const int tid = tidx(), lane = tid & 63, w = tid >> 6, c = lane & 31, hh = lane >> 5;
  const int pr = w >> 1, sub = w & 1;
  const int q0 = qt * 256;
  const us* Kg = p.K + (size_t)bh * SEQ * 96;
  const us* Vg = p.Vt + (size_t)bh * 64 * SEQ;
  bf16x8 qf[2][6];
#pragma unroll
  for (int qs = 0; qs < 2; ++qs) {
    const us* qb = p.Q + ((size_t)bh * SEQ + q0 + pr * 64 + qs * 32 + c) * 96 + 8 * hh;
#pragma unroll
    for (int s = 0; s < 6; ++s) qf[qs][s] = *(const bf16x8*)(qb + 16 * s);
  }
  const int nkt = q0 / 64 + 4, mylim = q0 / 64 + pr;
  f32x16 ot[2][2];
#pragma unroll
  for (int a = 0; a < 2; ++a)
#pragma unroll
    for (int b = 0; b < 2; ++b)
#pragma unroll
      for (int r = 0; r < 16; ++r) ot[a][b][r] = 0.f;
  float mrun[2] = {-1e30f, -1e30f}, lrun[2] = {0.f, 0.f};
  const int kr0 = tid / 12, kc0 = (tid % 12) * 8;
  const int kr1 = (tid + 512) / 12, kc1 = ((tid + 512) % 12) * 8;
  const int vr = tid >> 3, vc = (tid & 7) * 8;
  bf16x8 gk0, gk1, gv;
  gk0 = *(const bf16x8*)(Kg + (size_t)kr0 * 96 + kc0);
  if (tid < 256) gk1 = *(const bf16x8*)(Kg + (size_t)kr1 * 96 + kc1);
  gv = *(const bf16x8*)(Vg + (size_t)vr * SEQ + vc);
  {
    us* ks = sm; us* vsm = sm + 64 * AKS;
    *(bf16x8*)(ks + kr0 * AKS + kc0) = gk0;
    if (tid < 256) *(bf16x8*)(ks + kr1 * AKS + kc1) = gk1;
    const u32x4_ q4 = __builtin_bit_cast(u32x4_, gv);
    *(uint2*)(vsm + vr * AVS + vc) = make_uint2(q4.x, q4.y);
    *(uint2*)(vsm + vr * AVS + vc + 4) = make_uint2(q4.z, q4.w);
  }
  lds_barrier();
  for (int kt = 0; kt < nkt; ++kt) {
    const int cur = kt & 1;
    if (kt + 1 < nkt) {
      const size_t kb = (size_t)(kt + 1) * 64;
      gk0 = *(const bf16x8*)(Kg + (kb + kr0) * 96 + kc0);
      if (tid < 256) gk1 = *(const bf16x8*)(Kg + (kb + kr1) * 96 + kc1);
      gv = *(const bf16x8*)(Vg + (size_t)vr * SEQ + kb + vc);
    }
    if (kt <= mylim) {
      const us* ks = sm + cur * ASTG + (32 * sub + c) * AKS + 8 * hh;
      const us* vsm = sm + cur * ASTG + 64 * AKS + 32 * sub + 4 * hh;
      f32x16 sc[2];
#pragma unroll
      for (int a = 0; a < 2; ++a)
#pragma unroll
        for (int r = 0; r < 16; ++r) sc[a][r] = 0.f;
#pragma unroll
      for (int s = 0; s < 6; ++s) {
        const bf16x8 a0 = *(const bf16x8*)(ks + 16 * s);
        sc[0] = mfma32(a0, qf[0][s], sc[0]);
        sc[1] = mfma32(a0, qf[1][s], sc[1]);
      }
#pragma unroll
      for (int qs = 0; qs < 2; ++qs) {
        float mx = fmaxf(fmaxf(sc[qs][0], sc[qs][1]), sc[qs][2]);
#pragma unroll
        for (int r = 3; r < 15; r += 2) mx = fmaxf(fmaxf(mx, sc[qs][r]), sc[qs][r + 1]);
        mx = fmaxf(mx, sc[qs][15]);
        mx = fmaxf(mx, __shfl_xor(mx, 32));
        if (__builtin_amdgcn_ballot_w64(mx > mrun[qs] + 8.f) != 0ull) {
          const float mnew = fmaxf(mrun[qs], mx);
          const float alpha = __builtin_amdgcn_exp2f(mrun[qs] - mnew);
          mrun[qs] = mnew;
          lrun[qs] *= alpha;
#pragma unroll
          for (int r = 0; r < 16; ++r) { ot[qs][0][r] *= alpha; ot[qs][1][r] *= alpha; }
        }
        const float mref = mrun[qs];
        sc[qs] = sc[qs] - mref;
#pragma unroll
        for (int r = 0; r < 16; ++r) sc[qs][r] = __builtin_amdgcn_exp2f(sc[qs][r]);
        typedef float f32x8_ __attribute__((ext_vector_type(8)));
        typedef float f32x2s_ __attribute__((ext_vector_type(2)));
        const f32x8_ h8 = __builtin_shufflevector(sc[qs], sc[qs], 0, 1, 2, 3, 4, 5, 6, 7) + __builtin_shufflevector(sc[qs], sc[qs], 8, 9, 10, 11, 12, 13, 14, 15);
        const f32x4 h4 = __builtin_shufflevector(h8, h8, 0, 1, 2, 3) + __builtin_shufflevector(h8, h8, 4, 5, 6, 7);
        const f32x2s_ h2 = __builtin_shufflevector(h4, h4, 0, 1) + __builtin_shufflevector(h4, h4, 2, 3);
        float rsum = h2[0] + h2[1];
        rsum += __shfl_xor(rsum, 32);
        lrun[qs] += rsum;
      }
#pragma unroll
      for (int s = 0; s < 2; ++s) {
        bf16x8 pb[2];
#pragma unroll
        for (int qs = 0; qs < 2; ++qs)
          pb[qs] = mk8(pack2(sc[qs][8 * s + 0], sc[qs][8 * s + 1]), pack2(sc[qs][8 * s + 2], sc[qs][8 * s + 3]),
                       pack2(sc[qs][8 * s + 4], sc[qs][8 * s + 5]), pack2(sc[qs][8 * s + 6], sc[qs][8 * s + 7]));
#pragma unroll
        for (int dt = 0; dt < 2; ++dt) {
          const uint2 lo = *(const uint2*)(vsm + (32 * dt + c) * AVS + 16 * s);
          const uint2 hi = *(const uint2*)(vsm + (32 * dt + c) * AVS + 16 * s + 8);
          const bf16x8 va = mk8(lo.x, lo.y, hi.x, hi.y);
          ot[0][dt] = mfma32(va, pb[0], ot[0][dt]);
          ot[1][dt] = mfma32(va, pb[1], ot[1][dt]);
        }
      }
    }
    if (kt + 1 < nkt) {
      us* ksn = sm + (cur ^ 1) * ASTG; us* vsn = ksn + 64 * AKS;
      *(bf16x8*)(ksn + kr0 * AKS + kc0) = gk0;
      if (tid < 256) *(bf16x8*)(ksn + kr1 * AKS + kc1) = gk1;
      const u32x4_ q4 = __builtin_bit_cast(u32x4_, gv);
      *(uint2*)(vsn + vr * AVS + vc) = make_uint2(q4.x, q4.y);
      *(uint2*)(vsn + vr * AVS + vc + 4) = make_uint2(q4.z, q4.w);
    }
    lds_barrier();
  }
  float* xo = (float*)smraw + pr * 4096;
  float* xml = (float*)smraw + 16384 + pr * 256;
  if (sub == 1) {
#pragma unroll
    for (int qs = 0; qs < 2; ++qs) {
#pragma unroll
      for (int dt = 0; dt < 2; ++dt)
#pragma unroll
        for (int r = 0; r < 16; ++r) xo[((qs * 2 + dt) * 16 + r) * 64 + lane] = ot[qs][dt][r];
      xml[(qs * 2 + 0) * 64 + lane] = mrun[qs];
      xml[(qs * 2 + 1) * 64 + lane] = lrun[qs];
    }
  }
  lds_barrier();
  if (sub == 0) {
    const int b = bh >> 3, hd = bh & 7;
#pragma unroll
    for (int qs = 0; qs < 2; ++qs) {
      const float m2 = xml[(qs * 2 + 0) * 64 + lane], l2 = xml[(qs * 2 + 1) * 64 + lane];
      const float M = fmaxf(mrun[qs], m2);
      const float e1 = __builtin_amdgcn_exp2f(mrun[qs] - M), e2 = __builtin_amdgcn_exp2f(m2 - M);
      const float inv = 1.f / (lrun[qs] * e1 + l2 * e2);
      const float f1 = e1 * inv, f2 = e2 * inv;
      const size_t tk = (size_t)b * SEQ + q0 + pr * 64 + qs * 32 + c;
      const us* ga = p.projB + tk * LDB_ + hd * 64;
      us* zo = p.za + tk * 1024 + hd * 64;
#pragma unroll
      for (int dt = 0; dt < 2; ++dt) {
#pragma unroll
        for (int g = 0; g < 4; ++g) {
          const int d0 = 32 * dt + 8 * g + 4 * hh;
          const uint2 gg = *(const uint2*)(ga + d0);
          f32x4 v;
#pragma unroll
          for (int r = 0; r < 4; ++r) v[r] = ot[qs][dt][4 * g + r] * f1 + xo[((qs * 2 + dt) * 16 + 4 * g + r) * 64 + lane] * f2;
          v[0] *= bflo(gg.x); v[1] *= bfhi(gg.x); v[2] *= bflo(gg.y); v[3] *= bfhi(gg.y);
          *(uint2*)(zo + d0) = pack4(v);
        }
      }
    }
  }
  lds_barrier();
}

__device__ void phase4(const Params& p, unsigned char* smraw) {
  const int wid = tidx() >> 6;
#pragma nounroll
  for (int it = blockIdx.x; it < 256; it += gridDim.x) wkv_scan_block(p, it, smraw);
  const int G = gridDim.x;
#pragma nounroll
  for (int r = 0;; ++r) {
    const int pos = (r & 1) ? (G - 1 - (int)blockIdx.x) : (int)blockIdx.x;
    const int k = r * G + pos;
    if (r * G >= 1024) break;
    if (k < 1024) attn_item(p, k & 63, 15 - (k >> 6), smraw);
  }
}

__device__ void phase5(const Params& p) {
  const int lane = tidx() & 63, wid = tidx() >> 6, fr = lane & 15, fq = lane >> 4;
  for (int it = blockIdx.x * 8 + wid; it < 4096 * 4; it += gridDim.x * 8) {
    const int ch = it >> 2, tt = it & 3;
    const int bh = ch >> 6, cc = ch & 63, b = bh >> 3, hd = bh & 7;
    const us* y1 = p.Y1 + (size_t)ch * 4096;
    const us* hh = p.Hh + (size_t)ch * 4096;
    const us* y0 = p.Y0t + (size_t)ch * 4096;
    const size_t tk = (size_t)b * SEQ + cc * 64 + tt * 16 + fr;
    const int ci0 = hd * 64 + fq * 4;
    bf16x8 bq[2];
#pragma unroll
    for (int ks = 0; ks < 2; ++ks) bq[ks] = *(const bf16x8*)(y1 + (tt * 16 + fr) * 64 + ks * 32 + fq * 8);
    uint2 bvv[4], gbv[4];
    f32x4 y[4];
#pragma unroll
    for (int mt = 0; mt < 4; ++mt) {
      const uint2 yy = *(const uint2*)(y0 + (tt * 16 + fr) * 64 + mt * 16 + fq * 4);
      bvv[mt] = *(const uint2*)(p.bv + tk * 512 + ci0 + mt * 16);
      gbv[mt] = *(const uint2*)(p.projB + tk * LDB_ + 512 + ci0 + mt * 16);
      y[mt][0] = bflo(yy.x); y[mt][1] = bfhi(yy.x); y[mt][2] = bflo(yy.y); y[mt][3] = bfhi(yy.y);
#pragma unroll
      for (int ks = 0; ks < 2; ++ks) {
        const bf16x8 a = *(const bf16x8*)(hh + (mt * 16 + fr) * 64 + ks * 32 + fq * 8);
        y[mt] = mfma16(a, bq[ks], y[mt]);
      }
    }
    float s1 = 0.f;
#pragma unroll
    for (int mt = 0; mt < 4; ++mt) s1 += y[mt][0] + y[mt][1] + y[mt][2] + y[mt][3];
    s1 += __shfl_xor(s1, 16); s1 += __shfl_xor(s1, 32);
    const float mean = s1 * (1.f / 64.f);
    float s2 = 0.f;
#pragma unroll
    for (int mt = 0; mt < 4; ++mt)
#pragma unroll
      for (int r = 0; r < 4; ++r) { y[mt][r] -= mean; s2 += y[mt][r] * y[mt][r]; }
    s2 += __shfl_xor(s2, 16); s2 += __shfl_xor(s2, 32);
    const float rstd = rsqrtf(s2 * (1.f / 64.f) + 64e-5f);
#pragma unroll
    for (int mt = 0; mt < 4; ++mt) {
      const float4 gg = *(const float4*)(p.gn_g + ci0 + mt * 16), gb = *(const float4*)(p.gn_b + ci0 + mt * 16);
      f32x4 v;
      v[0] = (y[mt][0] * rstd * gg.x + gb.x + bflo(bvv[mt].x)) * bflo(gbv[mt].x);
      v[1] = (y[mt][1] * rstd * gg.y + gb.y + bfhi(bvv[mt].x)) * bfhi(gbv[mt].x);
      v[2] = (y[mt][2] * rstd * gg.z + gb.z + bflo(bvv[mt].y)) * bflo(gbv[mt].y);
      v[3] = (y[mt][3] * rstd * gg.w + gb.w + bfhi(bvv[mt].y)) * bfhi(gbv[mt].y);
      *(uint2*)(p.za + tk * 1024 + 512 + ci0 + mt * 16) = pack4(v);
    }
  }
}

DEVI void unpack8(uint4 g, float (&o)[8]) {
  o[0] = bflo(g.x); o[1] = bfhi(g.x); o[2] = bflo(g.y); o[3] = bfhi(g.y);
  o[4] = bflo(g.z); o[5] = bfhi(g.z); o[6] = bflo(g.w); o[7] = bfhi(g.w);
}
struct EpiMerge {
  static constexpr bool PERM = true, AFTER_DRAIN = false; static constexpr int MID_T = 8;
  const us* projB; us* merged;
  DEVI void mid(f32x4 (&acc)[2][2][4][2], const pg8::Unit& u, int wr, int wc, int fr, int fq) const {
    const int row0 = u.pm * 256 + wr * 64 + fr, col0 = u.pn * 256 + wc * 32 + 8 * fq;
    const us* gbase = projB + (size_t)row0 * LDB_ + 1024 + col0;
#pragma unroll
    for (int ai = 0; ai < 2; ++ai) {
#pragma unroll
      for (int m = 0; m < 4; ++m) {
#pragma unroll
        for (int bj = 0; bj < 2; ++bj) {
          const us* gp = gbase + (size_t)(ai * 128 + m * 16) * LDB_ + bj * 128;
          float ga[8], gb[8];
          unpack8(*(const uint4*)gp, ga);
          unpack8(*(const uint4*)(gp + 1024), gb);
#pragma unroll
          for (int e = 0; e < 4; ++e) {
            acc[ai][bj][m][0][e] *= ga[e] * __builtin_amdgcn_rcpf(gb[e]);
            acc[ai][bj][m][1][e] *= ga[4 + e] * __builtin_amdgcn_rcpf(gb[4 + e]);
          }
        }
      }
    }
  }
  DEVI void operator()(const f32x4 (&acc)[2][2][4][2], const pg8::Unit& u, int wr, int wc, int fr, int fq) const {
    const int row0 = u.pm * 256 + wr * 64 + fr, col0 = u.pn * 256 + wc * 32 + 8 * fq;
#pragma unroll
    for (int ai = 0; ai < 2; ++ai)
#pragma unroll
      for (int m = 0; m < 4; ++m) {
        const size_t row = row0 + ai * 128 + m * 16;
#pragma unroll
        for (int bj = 0; bj < 2; ++bj) {
          const int c = col0 + bj * 128;
          float gb[8];
          unpack8(*(const uint4*)(projB + row * LDB_ + 2048 + c), gb);
          const f32x4 v0 = acc[ai][bj][m][0], v1 = acc[ai][bj][m][1];
          uint4 q;
          q.x = pack2(v0[0] * gb[0], v0[1] * gb[1]); q.y = pack2(v0[2] * gb[2], v0[3] * gb[3]);
          q.z = pack2(v1[0] * gb[4], v1[1] * gb[5]); q.w = pack2(v1[2] * gb[6], v1[3] * gb[7]);
          *(uint4*)(merged + row * 1024 + c) = q;
        }
      }
  }
};
__device__ void phase6(const Params& p, unsigned char* smraw) {
  pg8::Gemm g{p.za, p.Wt_pa, T_TOK, 1024, 1024};
  pg8::StaticOrder S; S.init(g.M, g.N, (int)gridDim.x, (int)blockIdx.x);
  EpiMerge E{p.projB, p.merged};
  pg8::gemm_phase<EpiMerge, pg8::StaticOrder, false>((PG8_LAS unsigned char*)smraw, g, S, E, nullptr);
}

struct EpiSub {
  static constexpr bool PERM = true, AFTER_DRAIN = false; static constexpr int MID_T = 0;
  us* sub;
  DEVI void operator()(const f32x4 (&acc)[2][2][4][2], const pg8::Unit& u, int wr, int wc, int fr, int fq) const {
    const int row0 = u.pm * 256 + wr * 64 + fr, col0 = u.pn * 256 + wc * 32 + 8 * fq;
#pragma unroll
    for (int ai = 0; ai < 2; ++ai)
#pragma unroll
      for (int m = 0; m < 4; ++m) {
        const size_t row = row0 + ai * 128 + m * 16;
#pragma unroll
        for (int bj = 0; bj < 2; ++bj) {
          const f32x4 v0 = acc[ai][bj][m][0], v1 = acc[ai][bj][m][1];
          uint4 q; q.x = pack2(v0[0], v0[1]); q.y = pack2(v0[2], v0[3]); q.z = pack2(v1[0], v1[1]); q.w = pack2(v1[2], v1[3]);
          *(uint4*)(sub + row * 1024 + col0 + bj * 128) = q;
        }
      }
  }
};
__device__ void phase7(const Params& p, unsigned char* smraw) {
  pg8::Gemm g{p.merged, p.Wt_out, T_TOK, 1024, 1024};
  pg8::StaticOrder S; S.init(g.M, g.N, (int)gridDim.x, (int)blockIdx.x);
  EpiSub E{p.sub};
  pg8::gemm_phase<EpiSub, pg8::StaticOrder, false>((PG8_LAS unsigned char*)smraw, g, S, E, nullptr);
}

__device__ void phase8(const Params& p) {
  const int lane = tidx() & 63, wid = tidx() >> 6;
  for (int row0 = (blockIdx.x * 8 + wid) * 2; row0 < T_TOK; row0 += gridDim.x * 16) {
    const float* gate = p.mod + (row0 >> 12) * 3072 + 2048;
    float4 z[2][4];
#pragma unroll
    for (int r = 0; r < 2; ++r) {
      const float4* xr = (const float4*)(p.x + (size_t)(row0 + r) * DM);
      const uint2* sr = (const uint2*)(p.sub + (size_t)(row0 + r) * DM);
#pragma unroll
      for (int i = 0; i < 4; ++i) {
        const int c4 = i * 64 + lane;
        const float4 xv = xr[c4];
        const uint2 sv = sr[c4];
        const float4 g = ((const float4*)gate)[c4];
        z[r][i].x = ALPHA_ * xv.x + (1.f + g.x) * bflo(sv.x);
        z[r][i].y = ALPHA_ * xv.y + (1.f + g.y) * bfhi(sv.x);
        z[r][i].z = ALPHA_ * xv.z + (1.f + g.z) * bflo(sv.y);
        z[r][i].w = ALPHA_ * xv.w + (1.f + g.w) * bfhi(sv.y);
      }
    }
#pragma unroll
    for (int r = 0; r < 2; ++r) {
      float s = 0.f;
#pragma unroll
      for (int i = 0; i < 4; ++i) s += z[r][i].x + z[r][i].y + z[r][i].z + z[r][i].w;
#pragma unroll
      for (int o = 32; o; o >>= 1) s += __shfl_xor(s, o);
      const float mean = s * (1.f / 1024.f);
      float q = 0.f;
#pragma unroll
      for (int i = 0; i < 4; ++i) {
        z[r][i].x -= mean; z[r][i].y -= mean; z[r][i].z -= mean; z[r][i].w -= mean;
        q += z[r][i].x * z[r][i].x + z[r][i].y * z[r][i].y + z[r][i].z * z[r][i].z + z[r][i].w * z[r][i].w;
      }
#pragma unroll
      for (int o = 32; o; o >>= 1) q += __shfl_xor(q, o);
      const float rstd = rsqrtf(q * (1.f / 1024.f) + 1e-5f);
      float4* orow = (float4*)(p.out + (size_t)(row0 + r) * DM);
#pragma unroll
      for (int i = 0; i < 4; ++i) {
        const int c4 = i * 64 + lane;
        const float4 g = ((const float4*)p.post_g)[c4], bb = ((const float4*)p.post_b)[c4];
        float4 v;
        v.x = z[r][i].x * rstd * g.x + bb.x; v.y = z[r][i].y * rstd * g.y + bb.y;
        v.z = z[r][i].z * rstd * g.z + bb.z; v.w = z[r][i].w * rstd * g.w + bb.w;
        orow[c4] = v;
      }
    }
  }
}

#define XB_TMO      128
#define XB_XCNT(j)  (256  + 64 * (j))
#define XB_XSUB(j)  (1280 + 64 * (j))
#define XB_XGEN(j)  (2304 + 64 * (j))
#define XB_TOP      3328
#define XB_TOPGEN   3392
#define XCD_BAR_WORDS 3456
#define XB_SPIN_CAP (1u << 18)
#define LAS __attribute__((address_space(3)))

__device__ __forceinline__ unsigned xb_ld(unsigned* p)              { return __hip_atomic_load(p, __ATOMIC_RELAXED, __HIP_MEMORY_SCOPE_AGENT); }
__device__ __forceinline__ unsigned xb_add(unsigned* p, unsigned v) { return __hip_atomic_fetch_add(p, v, __ATOMIC_RELAXED, __HIP_MEMORY_SCOPE_AGENT); }
__device__ __forceinline__ unsigned xb_xcc_id() { return (unsigned)__builtin_amdgcn_s_getreg((3 << 11) | 20) & 0xFu; }
#define XB_SPIN(cond, bar) do { unsigned _sp = 0; while (cond) { __builtin_amdgcn_s_sleep(1); \
    if ((++_sp & 255u) == 0u) { if (xb_ld(&(bar)[XB_TMO])) break; if (_sp > XB_SPIN_CAP) { atomicAdd(&(bar)[XB_TMO], 1u); break; } } } } while (0)

struct XcdBarrier {
    unsigned* bar; unsigned x;
    volatile LAS unsigned* st;
};

__device__ __forceinline__ XcdBarrier xcd_barrier_post(unsigned* bar, volatile LAS unsigned* st) {
    XcdBarrier b; b.bar = bar; b.x = xb_xcc_id(); b.st = st;
    if (threadIdx.x == 0) (void)xb_add(&bar[XB_XCNT(b.x)], 1u);
    return b;
}
__device__ __forceinline__ void xcd_barrier_complete(unsigned* bar, unsigned x, unsigned& nloc, unsigned& nx) {
    const unsigned G = gridDim.x * gridDim.y * gridDim.z;
    unsigned sum, cnt, mine, sp = 0u;
    for (;;) {
        sum = 0u; cnt = 0u; mine = 0u;
#pragma unroll
        for (unsigned j = 0; j < 16; ++j) { const unsigned c = xb_ld(&bar[XB_XCNT(j)]); sum += c; cnt += (c > 0u) ? 1u : 0u; mine = (j == x) ? c : mine; }
        if (sum == G) break;
        __builtin_amdgcn_s_sleep(1);
        if ((++sp & 255u) == 0u) { if (xb_ld(&bar[XB_TMO])) break; if (sp > XB_SPIN_CAP) { atomicAdd(&bar[XB_TMO], 1u); break; } }
    }
    nloc = mine > 0u ? mine : 1u; nx = cnt > 0u ? cnt : 1u;
}

__device__ __forceinline__ void xcd_barrier(const XcdBarrier& b) {
    asm volatile("s_waitcnt vmcnt(0)" ::: "memory");
    __syncthreads();
    if (threadIdx.x == 0) {
        unsigned* bar = b.bar;
        __builtin_amdgcn_s_waitcnt(0);
        unsigned nloc = b.st[0], nx = b.st[1];
        if (nloc == 0u) { xcd_barrier_complete(bar, b.x, nloc, nx); b.st[0] = nloc; b.st[1] = nx; }
        const unsigned old = xb_add(&bar[XB_XSUB(b.x)], 1u);
        const unsigned gen = old / nloc;
        if (old + 1u == (gen + 1u) * nloc) {
            __builtin_amdgcn_fence(__ATOMIC_RELEASE, "agent");
            asm volatile("s_waitcnt vmcnt(0)" ::: "memory");
            const unsigned og = xb_add(&bar[XB_TOP], 1u);
            const unsigned tg = og / nx;
            if (og + 1u == (tg + 1u) * nx) xb_add(&bar[XB_TOPGEN], 1u);
            else XB_SPIN(xb_ld(&bar[XB_TOPGEN]) == tg, bar);
            __builtin_amdgcn_fence(__ATOMIC_ACQUIRE, "agent");
            xb_add(&bar[XB_XGEN(b.x)], 1u);
            asm volatile("s_waitcnt vmcnt(0)" ::: "memory");
        } else {
            XB_SPIN(xb_ld(&bar[XB_XGEN(b.x)]) == gen, bar);
            __builtin_amdgcn_fence(__ATOMIC_ACQUIRE, "agent");
            asm volatile("s_waitcnt vmcnt(0)" ::: "memory");
        }
    }
    __syncthreads();
}


#ifdef ONE_LAUNCH
__global__ void __launch_bounds__(NTHR) fwd_kernel(Params p) {
  extern __shared__ __attribute__((aligned(16))) unsigned char smraw[];
  cg::grid_group grid = cg::this_grid();
  volatile LAS unsigned* xst = (volatile LAS unsigned*)(smraw + LDSB0);
  if (threadIdx.x == 0) { xst[0] = 0u; xst[1] = 0u; }
  __syncthreads();
  const XcdBarrier xb = xcd_barrier_post(p.bar, xst);
  if (p.bar == nullptr) grid.sync();
  phase0(p, smraw); xcd_barrier(xb);
  phase1(p); xcd_barrier(xb);
  phase2(p, smraw); xcd_barrier(xb);
  phase3q(p, smraw); phase3kv(p, smraw); phase3w(p, smraw); xcd_barrier(xb);
  phase4(p, smraw); xcd_barrier(xb);
  phase5(p); xcd_barrier(xb);
  phase6(p, smraw); xcd_barrier(xb);
  phase7(p, smraw); xcd_barrier(xb);
  phase8(p);
}
#else
#define PK(name, call) __global__ void __launch_bounds__(NTHR) name(Params p) { \
  extern __shared__ __attribute__((aligned(16))) unsigned char smraw[]; call; }
PK(k_p0, phase0(p, smraw)) PK(k_p1, phase1(p)) PK(k_p2, phase2(p, smraw)) PK(k_p3q, phase3q(p, smraw))
PK(k_p3kv, phase3kv(p, smraw)) PK(k_p3w, phase3w(p, smraw)) PK(k_p4, phase4(p, smraw)) PK(k_p5, phase5(p))
PK(k_p6, phase6(p, smraw)) PK(k_p7, phase7(p, smraw)) PK(k_p8, phase8(p))
#endif

extern "C" void kernel_launch(void* const* d_in, const int* in_sizes, int n_in, void* d_out, int out_size,
                              void* d_ws, size_t ws_size, hipStream_t stream) {
  static int grid_blocks = 0;
#ifdef ONE_LAUNCH
  if (!grid_blocks) {
    int dev = 0, cus = 0, per_cu = 0;
    (void)hipGetDevice(&dev);
    (void)hipDeviceGetAttribute(&cus, hipDeviceAttributeMultiprocessorCount, dev);
    (void)hipFuncSetAttribute((const void*)fwd_kernel, hipFuncAttributeMaxDynamicSharedMemorySize, LDSB);
    (void)hipOccupancyMaxActiveBlocksPerMultiprocessor(&per_cu, fwd_kernel, NTHR, LDSB);
    if (per_cu < 1) per_cu = 1;
    grid_blocks = cus * per_cu;
  }
#else
  if (!grid_blocks) {
    const void* ks[] = {(const void*)k_p0, (const void*)k_p1, (const void*)k_p2, (const void*)k_p3q, (const void*)k_p3kv,
                        (const void*)k_p3w, (const void*)k_p4, (const void*)k_p5, (const void*)k_p6, (const void*)k_p7,
                        (const void*)k_p8};
    for (int i = 0; i < 11; ++i) (void)hipFuncSetAttribute(ks[i], hipFuncAttributeMaxDynamicSharedMemorySize, LDSB);
    grid_blocks = 256;
  }
#endif
  Params p{};
  p.x = (const float*)d_in[0]; p.c = (const float*)d_in[1]; p.pos = (const int*)d_in[2];
  p.w_ada = (const float*)d_in[3]; p.b_ada = (const float*)d_in[4]; p.w_in = (const float*)d_in[5];
  p.q_norm_g = (const float*)d_in[6]; p.w_uq = (const float*)d_in[7]; p.kv_norm_g = (const float*)d_in[8];
  p.w_ukv = (const float*)d_in[9]; p.mu = (const float*)d_in[10]; p.w0 = (const float*)d_in[11];
  p.w_dec = (const float*)d_in[12]; p.a0 = (const float*)d_in[13]; p.w_icl = (const float*)d_in[14];
  p.k_k = (const float*)d_in[15]; p.k_a = (const float*)d_in[16]; p.r_k = (const float*)d_in[17];
  p.gn_g = (const float*)d_in[18]; p.gn_b = (const float*)d_in[19]; p.w_pa = (const float*)d_in[20];
  p.w_pb = (const float*)d_in[21]; p.w_out = (const float*)d_in[22]; p.post_g = (const float*)d_in[23];
  p.post_b = (const float*)d_in[24];
  p.out = (float*)d_out;
  unsigned char* ws = (unsigned char*)d_ws;
  size_t off = 0;
  auto take = [&](size_t bytes) { unsigned char* r = ws + off; off += (bytes + 255) & ~(size_t)255; return r; };
  const size_t MiB = 1u << 20;
  p.bar = (unsigned*)take(XCD_BAR_WORDS * 4);
  p.mod = (float*)take(8 * 3072 * 4);
  p.cs = (float*)take((size_t)T_TOK * 32 * 4);
  p.stats = (float*)take((size_t)T_TOK * 2 * 4);
  p.Gc = (float*)take(4096 * 64 * 4);
  p.Wt_in = (us*)take((size_t)5376 * 1024 * 2);
  p.Wt_uq = (us*)take(768 * 256 * 2);
  p.Wt_ukv = (us*)take(1024 * 128 * 2);
  p.Wt_dec = (us*)take(512 * 64 * 2);
  p.Wt_icl = (us*)take(512 * 64 * 2);
  p.Wt_pa = (us*)take(1024 * 1024 * 2);
  p.Wt_pb = p.Wt_pa;
  p.Wt_out = (us*)take(1024 * 1024 * 2);
  unsigned char* r1 = take(64 * MiB);
  unsigned char* r2 = take((size_t)T_TOK * LDA_ * 2);
  p.projB = (us*)take((size_t)T_TOK * LDB_ * 2);
  p.Y1 = (us*)take(32 * MiB);
  p.Y0t = (us*)take(32 * MiB);
  p.bv = (us*)take(32 * MiB);
  p.h = (us*)r1; p.Mp = (us*)r1; p.Nt = (us*)(r1 + 32 * MiB); p.merged = (us*)r1;
  p.projA = (us*)r2; p.sub = (us*)r2; p.Hh = (us*)r2; p.za = (us*)(r2 + 32 * MiB); p.zb = p.za;
  unsigned char* ob = (unsigned char*)d_out;
  p.Q = (us*)ob; p.K = (us*)(ob + 48 * MiB); p.Vt = (us*)(ob + 96 * MiB);
  if (off > ws_size) { fprintf(stderr, "workspace too small: need %zu have %zu\n", off, ws_size); return; }
#ifndef ONE_LAUNCH
  const dim3 g(grid_blocks), bdim(NTHR);
  k_p0<<<g, bdim, LDSB, stream>>>(p);
  k_p1<<<g, bdim, LDSB, stream>>>(p);
  k_p2<<<g, bdim, LDSB, stream>>>(p);
  k_p3q<<<g, bdim, LDSB, stream>>>(p);
  k_p3kv<<<g, bdim, LDSB, stream>>>(p);
  k_p3w<<<g, bdim, LDSB, stream>>>(p);
  k_p4<<<g, bdim, LDSB, stream>>>(p);
  k_p5<<<g, bdim, LDSB, stream>>>(p);
  k_p6<<<g, bdim, LDSB, stream>>>(p);
  k_p7<<<g, bdim, LDSB, stream>>>(p);
  k_p8<<<g, bdim, LDSB, stream>>>(p);
#else
  (void)hipMemsetAsync(p.bar, 0, XCD_BAR_WORDS * 4, stream);
  void* args[] = {&p};
  hipError_t e = hipLaunchCooperativeKernel((void*)fwd_kernel, dim3(grid_blocks), dim3(NTHR), args, LDSB, stream);
  if (e != hipSuccess) fprintf(stderr, "cooperative launch failed: %s (grid %d)\n", hipGetErrorString(e), grid_blocks);
#endif
}
```

```cpp
#include <hip/hip_runtime.h>
#include <hip/hip_cooperative_groups.h>
#include <cstdio>
#include <cstdint>
namespace cg = cooperative_groups;
#define ONE_LAUNCH 1

typedef unsigned short us;
typedef __attribute__((ext_vector_type(8))) short bf16x8;
typedef __attribute__((ext_vector_type(4))) float f32x4;
typedef __attribute__((ext_vector_type(16))) float f32x16;
typedef unsigned u32x2n_ __attribute__((ext_vector_type(2)));
#define DEVI __device__ __forceinline__

constexpr int T_TOK = 32768, SEQ = 4096, DM = 1024;
constexpr int LDA_ = 2080;
constexpr int LDB_ = 3072;
constexpr int NTHR = 512;
constexpr int LDSB0 = 16 * 9216 + 2048;
constexpr int LDSB = LDSB0 + 64;
constexpr float QSCALE = 0.10206207261596575f * 1.4426950408889634f;
constexpr float ALPHA_ = 1.189207115002721f;

struct Params {
  const float *x, *c; const int* pos;
  const float *w_ada, *b_ada, *w_in, *q_norm_g, *w_uq, *kv_norm_g, *w_ukv, *mu, *w0, *w_dec, *a0, *w_icl,
      *k_k, *k_a, *r_k, *gn_g, *gn_b, *w_pa, *w_pb, *w_out, *post_g, *post_b;
  float* out;
  float *mod, *cs, *stats, *Gc; unsigned* bar;
  us *Wt_in, *Wt_uq, *Wt_ukv, *Wt_dec, *Wt_icl, *Wt_pa, *Wt_pb, *Wt_out;
  us *h, *projA, *projB, *Q, *K, *Vt, *za, *zb, *bv, *Mp, *Nt, *Y1, *Y0t, *Hh, *merged, *sub;
};

DEVI int tidx() { int t = (int)threadIdx.x; asm volatile("" : "+v"(t)); return t; }
DEVI us f2bf(float f) { unsigned u = __float_as_uint(f); u += 0x7fffu + ((u >> 16) & 1u); return (us)(u >> 16); }
DEVI float bf2f(us h) { return __uint_as_float(((unsigned)h) << 16); }
typedef float f32x2_ __attribute__((ext_vector_type(2)));
typedef __bf16 bf16x2_ __attribute__((ext_vector_type(2)));
DEVI unsigned pack2(float a, float b) {
  f32x2_ v = {a, b};
  bf16x2_ r = __builtin_convertvector(v, bf16x2_);
  return *(unsigned*)&r;
}
DEVI uint2 pack4(f32x4 v) { uint2 r; r.x = pack2(v[0], v[1]); r.y = pack2(v[2], v[3]); return r; }
DEVI f32x4 mfma16(bf16x8 a, bf16x8 b, f32x4 c) { return __builtin_amdgcn_mfma_f32_16x16x32_bf16(a, b, c, 0, 0, 0); }
DEVI f32x16 mfma32(bf16x8 a, bf16x8 b, f32x16 c) { return __builtin_amdgcn_mfma_f32_32x32x16_bf16(a, b, c, 0, 0, 0); }
DEVI void lds_barrier() { asm volatile("s_waitcnt lgkmcnt(0)" ::: "memory"); __builtin_amdgcn_s_barrier(); asm volatile("" ::: "memory"); }
DEVI float sigmoidf_(float v) { return __builtin_amdgcn_rcpf(1.f + __builtin_amdgcn_exp2f(-1.4426950408889634f * v)); }
DEVI float siluf_(float v) { return v * __builtin_amdgcn_rcpf(1.f + __builtin_amdgcn_exp2f(-1.4426950408889634f * v)); }

DEVI void conv_job(const float* __restrict__ src, us* __restrict__ dst, int K, int N, int ld, int koff, const float* rs, float sc,
                   int gw, int nw, int lane) {
  const int ngrp = (N + 63) >> 6, noct = K >> 3;
  for (int wi = gw; wi < ngrp * noct; wi += nw) {
    const int nt = wi % ngrp, oc = wi / ngrp;
    const int n = nt * 64 + lane, k0 = oc * 8;
    if (n < N) {
      const float* sp = src + (size_t)k0 * N + n;
      const float v0 = sp[0], v1 = sp[(size_t)N], v2 = sp[(size_t)2 * N], v3 = sp[(size_t)3 * N];
      const float v4 = sp[(size_t)4 * N], v5 = sp[(size_t)5 * N], v6 = sp[(size_t)6 * N], v7 = sp[(size_t)7 * N];
      float4 ra = make_float4(sc, sc, sc, sc), rb = ra;
      if (rs) {
        const float4 a = *(const float4*)(rs + k0), b = *(const float4*)(rs + k0 + 4);
        ra = make_float4(a.x * sc, a.y * sc, a.z * sc, a.w * sc); rb = make_float4(b.x * sc, b.y * sc, b.z * sc, b.w * sc);
      }
      uint4 o;
      o.x = pack2(v0 * ra.x, v1 * ra.y); o.y = pack2(v2 * ra.z, v3 * ra.w);
      o.z = pack2(v4 * rb.x, v5 * rb.y); o.w = pack2(v6 * rb.z, v7 * rb.w);
      *(uint4*)(dst + (size_t)n * ld + koff + k0) = o;
    }
  }
}
__device__ void phase0(const Params& p, unsigned char* smraw) {
  float* smf = (float*)smraw;
  const int tid = tidx();
  for (int it = blockIdx.x; it < 48; it += gridDim.x) {
    {
      const int n0 = it * 64;
      for (int i = tid; i < 8192; i += NTHR) smf[i] = siluf_(p.c[i]);
      __syncthreads();
      const int nl = tid & 63, kg = tid >> 6;
      float acc[8];
#pragma unroll
      for (int b = 0; b < 8; ++b) acc[b] = 0.f;
      for (int k0 = kg * 128; k0 < kg * 128 + 128; k0 += 16) {
        float wv[16];
#pragma unroll
        for (int u = 0; u < 16; ++u) wv[u] = p.w_ada[(size_t)(k0 + u) * 3072 + n0 + nl];
#pragma unroll
        for (int u = 0; u < 16; ++u)
#pragma unroll
          for (int b = 0; b < 8; ++b) acc[b] += smf[b * 1024 + k0 + u] * wv[u];
      }
      float* red = smf + 8192;
#pragma unroll
      for (int b = 0; b < 8; ++b) red[(kg * 8 + b) * 64 + nl] = acc[b];
      __syncthreads();
      {
        const int b = tid >> 6;
        float s = p.b_ada[n0 + nl];
#pragma unroll
        for (int g = 0; g < 8; ++g) s += red[(g * 8 + b) * 64 + nl];
        p.mod[b * 3072 + n0 + nl] = s;
      }
      __syncthreads();
    }
  }
  {
    const int gw = blockIdx.x * 8 + (tid >> 6), nw = gridDim.x * 8;
    conv_job(p.w_in, p.Wt_in, 1024, 5152, 1024, 0, nullptr, 1.f, gw, nw, tid & 63);
    conv_job(p.w_uq, p.Wt_uq, 256, 768, 256, 0, p.q_norm_g, QSCALE, gw, nw, tid & 63);
    conv_job(p.w_ukv, p.Wt_ukv, 128, 1024, 128, 0, p.kv_norm_g, 1.f, gw, nw, tid & 63);
    conv_job(p.w_dec, p.Wt_dec, 64, 512, 64, 0, nullptr, 1.f, gw, nw, tid & 63);
    conv_job(p.w_icl, p.Wt_icl, 64, 512, 64, 0, nullptr, 1.f, gw, nw, tid & 63);
    conv_job(p.w_pa, p.Wt_pa, 512, 1024, 1024, 0, nullptr, 1.f, gw, nw, tid & 63);
    conv_job(p.w_pb, p.Wt_pa, 512, 1024, 1024, 512, nullptr, 1.f, gw, nw, tid & 63);
    conv_job(p.w_out, p.Wt_out, 1024, 1024, 1024, 0, nullptr, 1.f, gw, nw, tid & 63);
  }
  const int gt = blockIdx.x * NTHR + tid, gs = gridDim.x * NTHR;
  {
    const double inv = pow(10000.0, -(double)(gt & 15) / 16.0);
    for (int i = gt; i < T_TOK * 16; i += gs) {
      const int t = i >> 4, pi = i & 15;
      double ang = (double)p.pos[t] * inv;
      ang -= 6.283185307179586476925 * rint(ang * 0.15915494309189533577);
      float sv, cv;
      sincosf((float)ang, &sv, &cv);
      p.cs[t * 32 + pi] = cv;
      p.cs[t * 32 + 16 + pi] = sv;
    }
  }
  for (int i = gt; i < T_TOK * 2; i += gs) p.stats[i] = 0.f;
  unsigned* padz = (unsigned*)(p.Wt_in + (size_t)5152 * 1024);
  for (int i = gt; i < 224 * 512; i += gs) padz[i] = 0u;
}

__device__ void phase1(const Params& p) {
  const int lane = tidx() & 63, wid = tidx() >> 6;
  for (int row0 = (blockIdx.x * 8 + wid) * 2; row0 < T_TOK; row0 += gridDim.x * 16) {
    float4 v[2][4];
#pragma unroll
    for (int r = 0; r < 2; ++r) {
      const float4* xr = (const float4*)(p.x + (size_t)(row0 + r) * DM);
#pragma unroll
      for (int i = 0; i < 4; ++i) { const f32x4 t = __builtin_nontemporal_load((const f32x4*)xr + i * 64 + lane); v[r][i] = make_float4(t[0], t[1], t[2], t[3]); }
    }
    const float* md = p.mod + (row0 >> 12) * 3072;
#pragma unroll
    for (int r = 0; r < 2; ++r) {
      float s = 0.f;
#pragma unroll
      for (int i = 0; i < 4; ++i) s += v[r][i].x + v[r][i].y + v[r][i].z + v[r][i].w;
#pragma unroll
      for (int o = 32; o; o >>= 1) s += __shfl_xor(s, o);
      const float mean = s * (1.f / 1024.f);
      float q = 0.f;
#pragma unroll
      for (int i = 0; i < 4; ++i) {
        v[r][i].x -= mean; v[r][i].y -= mean; v[r][i].z -= mean; v[r][i].w -= mean;
        q += v[r][i].x * v[r][i].x + v[r][i].y * v[r][i].y + v[r][i].z * v[r][i].z + v[r][i].w * v[r][i].w;
      }
#pragma unroll
      for (int o = 32; o; o >>= 1) q += __shfl_xor(q, o);
      const float rstd = rsqrtf(q * (1.f / 1024.f) + 1e-5f);
#pragma unroll
      for (int i = 0; i < 4; ++i) {
        const int col = i * 256 + lane * 4;
        float4 sh = *(const float4*)(md + col), scl = *(const float4*)(md + 1024 + col);
        uint2 o;
        o.x = pack2(v[r][i].x * rstd * (1.f + scl.x) + sh.x, v[r][i].y * rstd * (1.f + scl.y) + sh.y);
        o.y = pack2(v[r][i].z * rstd * (1.f + scl.z) + sh.z, v[r][i].w * rstd * (1.f + scl.w) + sh.w);
        *(uint2*)(p.h + (size_t)(row0 + r) * DM + col) = o;
      }
    }
  }
}

constexpr int GST = 384 * 72;
template <bool SUMSQ = false, bool SWAPV = false>
DEVI void gemm_main(const us* __restrict__ X, int ldx, const us* __restrict__ Y, int ldy, int K, us* sm,
                    f32x4 (&acc)[4][4], float* rs_out = nullptr, float rs_scale = 0.f, float rs_eps = 0.f) {
  const int tid = tidx(), lane = tid & 63, wid = tid >> 6;
  const int wx = wid >> 2, wy = wid & 3, fr = lane & 15, fq = lane >> 4;
  const int sr = tid >> 3, sc = (tid & 7) * 8;
  bf16x8 gx[2], gy[4];
  float ssq[4] = {0.f, 0.f, 0.f, 0.f};
#define GM_ACCSQ() if (SUMSQ) { _Pragma("unroll") for (int i = 0; i < 4; ++i) { _Pragma("unroll") for (int e = 0; e < 8; ++e) { const float f = bf2f((us)gy[i][e]); ssq[i] += f * f; } } }
#pragma unroll
  for (int i = 0; i < 2; ++i) gx[i] = *(const bf16x8*)(X + (size_t)(sr + i * 64) * ldx + sc);
#pragma unroll
  for (int i = 0; i < 4; ++i) gy[i] = *(const bf16x8*)(Y + (size_t)(sr + i * 64) * ldy + sc);
#pragma unroll
  for (int i = 0; i < 2; ++i) *(bf16x8*)(sm + (sr + i * 64) * 72 + sc) = gx[i];
#pragma unroll
  for (int i = 0; i < 4; ++i) *(bf16x8*)(sm + (128 + sr + i * 64) * 72 + sc) = gy[i];
  GM_ACCSQ()
  lds_barrier();
  const int nk = K >> 6;
  for (int kt = 0; kt < nk; ++kt) {
    const int cur = kt & 1;
    if (kt + 1 < nk) {
      const int k0 = (kt + 1) * 64 + sc;
#pragma unroll
      for (int i = 0; i < 2; ++i) gx[i] = *(const bf16x8*)(X + (size_t)(sr + i * 64) * ldx + k0);
#pragma unroll
      for (int i = 0; i < 4; ++i) gy[i] = *(const bf16x8*)(Y + (size_t)(sr + i * 64) * ldy + k0);
    }
    const us* xs = sm + cur * GST;
    const us* ys = xs + 128 * 72;
#pragma unroll
    for (int ks = 0; ks < 2; ++ks) {
      bf16x8 a[4], b[4];
#pragma unroll
      for (int i = 0; i < 4; ++i) a[i] = *(const bf16x8*)(xs + (wx * 64 + i * 16 + fr) * 72 + ks * 32 + fq * 8);
#pragma unroll
      for (int j = 0; j < 4; ++j) b[j] = *(const bf16x8*)(ys + (wy * 64 + j * 16 + fr) * 72 + ks * 32 + fq * 8);
#pragma unroll
      for (int i = 0; i < 4; ++i)
#pragma unroll
        for (int j = 0; j < 4; ++j) {
          if (SWAPV && wx == 1) acc[i][j] = mfma16(b[j], a[i], acc[i][j]);
          else acc[i][j] = mfma16(a[i], b[j], acc[i][j]);
        }
    }
    if (kt + 1 < nk) {
      us* xn = sm + (cur ^ 1) * GST;
#pragma unroll
      for (int i = 0; i < 2; ++i) *(bf16x8*)(xn + (sr + i * 64) * 72 + sc) = gx[i];
#pragma unroll
      for (int i = 0; i < 4; ++i) *(bf16x8*)(xn + (128 + sr + i * 64) * 72 + sc) = gy[i];
      GM_ACCSQ()
    }
    lds_barrier();
  }
  if (SUMSQ) {
#pragma unroll
    for (int i = 0; i < 4; ++i) {
      float v = ssq[i];
      v += __shfl_xor(v, 1); v += __shfl_xor(v, 2); v += __shfl_xor(v, 4);
      if ((tid & 7) == 0) rs_out[sr + i * 64] = rsqrtf(v * rs_scale + rs_eps);
    }
    lds_barrier();
  }
#undef GM_ACCSQ
}
DEVI void zero_acc(f32x4 (&acc)[4][4]) {
#pragma unroll
  for (int i = 0; i < 4; ++i)
#pragma unroll
    for (int j = 0; j < 4; ++j) acc[i][j] = f32x4{0.f, 0.f, 0.f, 0.f};
}

namespace pg8 {
#define PG8_LAS __attribute__((address_space(3)))
typedef unsigned short bf16_t;
typedef short bf16x8 __attribute__((ext_vector_type(8)));
typedef float f32x4 __attribute__((ext_vector_type(4)));
typedef unsigned u32x4 __attribute__((ext_vector_type(4)));
constexpr int BM = 256, BK = 64, HALF = 128, HTB = HALF * BK * 2  , STAGE_BYTES = 8 * HTB, NXCD = 8, WGM = 8;

__host__ __device__ __forceinline__ int lds_byte(int r, int c) { const int st = (r >> 4) * 2 + (c >> 5), rr = r & 15, cc = c & 31, ob = rr * 64 + cc * 2; return st * 1024 + (ob ^ (((ob >> 9) & 1) << 5)); }
__host__ __device__ __forceinline__ void stage_rc(int b, int& R, int& C) { const int st = b / 1024, sb = b % 1024, swz = sb ^ (((sb >> 9) & 1) << 5); R = (st >> 1) * 16 + swz / 64; C = (st & 1) * 32 + (swz % 64) / 2; }
__host__ __device__ __forceinline__ int perm32(int rho) { const int n = rho >> 4, i = rho & 15; return 8 * (i >> 2) + 4 * n + (i & 3); }

struct Unit { int pm, pn; };
struct Gemm { const bf16_t* A; const bf16_t* Bt; int M, N, K; };

struct StaticOrder {
    int nM, nN, nwg, G, c;
    __host__ __device__ void init(int M, int N, int G_, int c_) { nM = M / BM; nN = N / BM; nwg = nM * nN; G = G_; c = c_; }
    __host__ __device__ bool next(int i, Unit& u) const {
        const long L = (long)i * G + c; if (L >= nwg) return false;
        int wgid = (int)L; { const int q = nwg / NXCD, r = nwg % NXCD, xcd = wgid % NXCD, off = wgid / NXCD; wgid = (xcd < r ? xcd * (q + 1) : r * (q + 1) + (xcd - r) * q) + off; }
        const int nig = WGM * nN, gid = wgid / nig, fm = gid * WGM, gsz = (nM - fm) < WGM ? (nM - fm) : WGM;
        u.pm = fm + ((wgid % nig) % gsz); u.pn = (wgid % nig) / gsz; return true;
    }
    __device__ __forceinline__ void a_ready(const Unit&) const {}
    __device__ __forceinline__ void done(const Unit&) const {}
};

template <class Epi, class Sched, bool STAMP = false>
__device__ __forceinline__ void gemm_phase(PG8_LAS unsigned char* lds, const Gemm g, const Sched& S, const Epi& E, unsigned long long* stamps) {
    const int tid = tidx(), wid = __builtin_amdgcn_readfirstlane(tid >> 6), lane = tid & 63, wr = wid >> 2, wc = wid & 3, fr = lane & 15, fq = lane >> 4;
    const int K = g.K, nt = K / BK;
    int ts_lo = 0, ts_hi = 0, nts = 0; const unsigned long long rt_entry = STAMP ? (unsigned long long)wall_clock64() : 0ull;
#define PG8_STAMP() do { if (STAMP && wid == 0 && nts < 64) { const unsigned long long _c = (unsigned long long)clock64(); \
        ts_lo = (lane == nts) ? (int)(unsigned)_c : ts_lo; ts_hi = (lane == nts) ? (int)(unsigned)(_c >> 32) : ts_hi; ++nts; } } while (0)
    unsigned voffA[2], voffB[2];
#pragma unroll
    for (int i = 0; i < 2; ++i) { int R, C; stage_rc(tid * 16 + i * 8192, R, C); const int Rb = Epi::PERM ? ((R & ~31) + perm32(R & 31)) : R;
        voffA[i] = (unsigned)(R * K + C) * 2u; voffB[i] = (unsigned)(Rb * K + C) * 2u; }
    const size_t kstep = (size_t)(BK * 2);
    const size_t hstep = (size_t)HALF * K * 2;
    const size_t tstep = 2 * hstep;
    const unsigned ldsw = (unsigned)wid * 1024u;
    const int aoff = lds_byte(wr * 64 + fr, fq * 8), boff = lds_byte(wc * 32 + fr, fq * 8);
#define PG8_SA(b, h) (((b) * 2 + (h)) * HTB)
#define PG8_SB(b, h) ((4 + (b) * 2 + (h)) * HTB)
#define PG8_STAGE(bufoff, gbase, voff) do { _Pragma("unroll") for (int _i = 0; _i < 2; ++_i) \
        __builtin_amdgcn_global_load_lds((const unsigned*)((const char*)(gbase) + (voff)[_i]), (PG8_LAS unsigned*)(lds + (bufoff) + ldsw + _i * 8192), 16, 0, 0); } while (0)
#define PG8_LDA(dst, b, h) do { _Pragma("unroll") for (int m = 0; m < 4; ++m) _Pragma("unroll") for (int k = 0; k < 2; ++k) dst[m][k] = *(const PG8_LAS bf16x8*)(lds + PG8_SA(b, h) + aoff + m * 2048 + k * 1024); } while (0)
#define PG8_LDB(dst, b, h) do { _Pragma("unroll") for (int n = 0; n < 2; ++n) _Pragma("unroll") for (int k = 0; k < 2; ++k) dst[n][k] = *(const PG8_LAS bf16x8*)(lds + PG8_SB(b, h) + boff + n * 2048 + k * 1024); } while (0)
#define PG8_MMA(ai, bj, At, Bt) do { __builtin_amdgcn_s_setprio(1); _Pragma("unroll") for (int m = 0; m < 4; ++m) _Pragma("unroll") for (int n = 0; n < 2; ++n) _Pragma("unroll") for (int k = 0; k < 2; ++k) \
        acc[ai][bj][m][n] = __builtin_amdgcn_mfma_f32_16x16x32_bf16(Bt[n][k], At[m][k], acc[ai][bj][m][n], 0, 0, 0); __builtin_amdgcn_s_setprio(0); } while (0)
#define PG8_WAIT_V(n) asm volatile("s_waitcnt vmcnt(" #n ")" ::: "memory")
#define PG8_WAIT_L(n) asm volatile("s_waitcnt lgkmcnt(" #n ")" ::: "memory")
#define PG8_BAR __builtin_amdgcn_s_barrier()
#define PG8_SCHED __builtin_amdgcn_sched_barrier(0)
    Unit cur, nxt; int ui = 0;
    if (!S.next(0, cur)) return;
    f32x4 acc[2][2][4][2];
#pragma unroll
    for (int a = 0; a < 2; ++a)
#pragma unroll
        for (int b = 0; b < 2; ++b)
#pragma unroll
            for (int m = 0; m < 4; ++m)
#pragma unroll
                for (int n = 0; n < 2; ++n) acc[a][b][m][n] = (f32x4){0.f, 0.f, 0.f, 0.f};
    bf16x8 At[4][2], B0[2][2], B1[2][2];
    const char* cA = (const char*)g.A + (size_t)cur.pm * tstep; const char* cB = (const char*)g.Bt + (size_t)cur.pn * tstep;
    S.a_ready(cur);
    PG8_STAGE(PG8_SB(0, 0), cB, voffB); PG8_STAGE(PG8_SA(0, 0), cA, voffA); PG8_STAGE(PG8_SB(0, 1), cB + hstep, voffB); PG8_STAGE(PG8_SA(0, 1), cA + hstep, voffA);
    if (wr == 1) PG8_BAR;
    PG8_WAIT_V(4); PG8_BAR;
    PG8_STAGE(PG8_SB(1, 0), cB + kstep, voffB); PG8_STAGE(PG8_SA(1, 0), cA + kstep, voffA); PG8_STAGE(PG8_SB(1, 1), cB + hstep + kstep, voffB);
    PG8_WAIT_V(6); PG8_BAR;
    for (;;) {
        const bool has_next = S.next(ui + 1, nxt);
        const char* nA = has_next ? (const char*)g.A + (size_t)nxt.pm * tstep : cA; const char* nB = has_next ? (const char*)g.Bt + (size_t)nxt.pn * tstep : cB;
        if constexpr (Epi::MID_T > 0) {
        for (int t = 0; t < Epi::MID_T; t += 2) {
            const bool last = (t == nt - 2);
            const char* a1 = cA + (size_t)(t + 1) * kstep;
            const char* a2 = last ? nA : cA + (size_t)(t + 2) * kstep; const char* b2 = last ? nB : cB + (size_t)(t + 2) * kstep;
            const char* a3 = a2 + kstep; const char* b3 = b2 + kstep;
            if (last && has_next) S.a_ready(nxt);
            PG8_LDB(B0, 0, 0); PG8_SCHED; PG8_LDA(At, 0, 0); PG8_STAGE(PG8_SA(1, 1), a1 + hstep, voffA);
            PG8_WAIT_L(8); PG8_BAR; PG8_WAIT_L(0); PG8_MMA(0, 0, At, B0); PG8_BAR; PG8_SCHED;
            PG8_LDB(B1, 0, 1); PG8_STAGE(PG8_SB(0, 0), b2, voffB);
            PG8_BAR; PG8_WAIT_L(0); PG8_MMA(0, 1, At, B1); PG8_BAR;
            PG8_LDA(At, 0, 1); PG8_STAGE(PG8_SA(0, 0), a2, voffA);
            PG8_BAR; PG8_WAIT_L(0); PG8_MMA(1, 0, At, B0); PG8_BAR; PG8_SCHED;
            PG8_STAGE(PG8_SB(0, 1), b2 + hstep, voffB);
            PG8_WAIT_V(6); PG8_BAR; PG8_MMA(1, 1, At, B1); PG8_BAR;
            PG8_LDB(B0, 1, 0); PG8_SCHED; PG8_LDA(At, 1, 0); PG8_STAGE(PG8_SA(0, 1), a2 + hstep, voffA);
            PG8_WAIT_L(8); PG8_BAR; PG8_WAIT_L(0); PG8_MMA(0, 0, At, B0); PG8_BAR; PG8_SCHED;
            PG8_LDB(B1, 1, 1); PG8_STAGE(PG8_SB(1, 0), b3, voffB);
            PG8_BAR; PG8_WAIT_L(0); PG8_MMA(0, 1, At, B1); PG8_BAR;
            PG8_LDA(At, 1, 1); PG8_STAGE(PG8_SA(1, 0), a3, voffA);
            PG8_BAR; PG8_WAIT_L(0); PG8_MMA(1, 0, At, B0); PG8_BAR; PG8_SCHED;
            PG8_STAGE(PG8_SB(1, 1), b3 + hstep, voffB);
            PG8_WAIT_V(6); PG8_BAR; PG8_MMA(1, 1, At, B1); PG8_BAR;
        }
        E.mid(acc, cur, wr, wc, fr, fq);
        for (int t = Epi::MID_T; t < nt; t += 2) {
            const bool last = (t == nt - 2);
            const char* a1 = cA + (size_t)(t + 1) * kstep;
            const char* a2 = last ? nA : cA + (size_t)(t + 2) * kstep; const char* b2 = last ? nB : cB + (size_t)(t + 2) * kstep;
            const char* a3 = a2 + kstep; const char* b3 = b2 + kstep;
            if (last && has_next) S.a_ready(nxt);
            PG8_LDB(B0, 0, 0); PG8_SCHED; PG8_LDA(At, 0, 0); PG8_STAGE(PG8_SA(1, 1), a1 + hstep, voffA);
            PG8_WAIT_L(8); PG8_BAR; PG8_WAIT_L(0); PG8_MMA(0, 0, At, B0); PG8_BAR; PG8_SCHED;
            PG8_LDB(B1, 0, 1); PG8_STAGE(PG8_SB(0, 0), b2, voffB);
            PG8_BAR; PG8_WAIT_L(0); PG8_MMA(0, 1, At, B1); PG8_BAR;
            PG8_LDA(At, 0, 1); PG8_STAGE(PG8_SA(0, 0), a2, voffA);
            PG8_BAR; PG8_WAIT_L(0); PG8_MMA(1, 0, At, B0); PG8_BAR; PG8_SCHED;
            PG8_STAGE(PG8_SB(0, 1), b2 + hstep, voffB);
            PG8_WAIT_V(6); PG8_BAR; PG8_MMA(1, 1, At, B1); PG8_BAR;
            PG8_LDB(B0, 1, 0); PG8_SCHED; PG8_LDA(At, 1, 0); PG8_STAGE(PG8_SA(0, 1), a2 + hstep, voffA);
            PG8_WAIT_L(8); PG8_BAR; PG8_WAIT_L(0); PG8_MMA(0, 0, At, B0); PG8_BAR; PG8_SCHED;
            PG8_LDB(B1, 1, 1); PG8_STAGE(PG8_SB(1, 0), b3, voffB);
            PG8_BAR; PG8_WAIT_L(0); PG8_MMA(0, 1, At, B1); PG8_BAR;
            PG8_LDA(At, 1, 1); PG8_STAGE(PG8_SA(1, 0), a3, voffA);
            PG8_BAR; PG8_WAIT_L(0); PG8_MMA(1, 0, At, B0); PG8_BAR; PG8_SCHED;
            PG8_STAGE(PG8_SB(1, 1), b3 + hstep, voffB);
            PG8_WAIT_V(6); PG8_BAR; PG8_MMA(1, 1, At, B1); PG8_BAR;
        }
        } else {
        for (int t = 0; t < nt; t += 2) {
            const bool last = (t == nt - 2);
            const char* a1 = cA + (size_t)(t + 1) * kstep;
            const char* a2 = last ? nA : cA + (size_t)(t + 2) * kstep; const char* b2 = last ? nB : cB + (size_t)(t + 2) * kstep;
            const char* a3 = a2 + kstep; const char* b3 = b2 + kstep;
            if (last && has_next) S.a_ready(nxt);
            PG8_LDB(B0, 0, 0); PG8_SCHED; PG8_LDA(At, 0, 0); PG8_STAGE(PG8_SA(1, 1), a1 + hstep, voffA);
            PG8_WAIT_L(8); PG8_BAR; PG8_WAIT_L(0); PG8_MMA(0, 0, At, B0); PG8_BAR; PG8_SCHED;
            PG8_LDB(B1, 0, 1); PG8_STAGE(PG8_SB(0, 0), b2, voffB);
            PG8_BAR; PG8_WAIT_L(0); PG8_MMA(0, 1, At, B1); PG8_BAR;
            PG8_LDA(At, 0, 1); PG8_STAGE(PG8_SA(0, 0), a2, voffA);
            PG8_BAR; PG8_WAIT_L(0); PG8_MMA(1, 0, At, B0); PG8_BAR; PG8_SCHED;
            PG8_STAGE(PG8_SB(0, 1), b2 + hstep, voffB);
            PG8_WAIT_V(6); PG8_BAR; PG8_MMA(1, 1, At, B1); PG8_BAR;
            PG8_LDB(B0, 1, 0); PG8_SCHED; PG8_LDA(At, 1, 0); PG8_STAGE(PG8_SA(0, 1), a2 + hstep, voffA);
            PG8_WAIT_L(8); PG8_BAR; PG8_WAIT_L(0); PG8_MMA(0, 0, At, B0); PG8_BAR; PG8_SCHED;
            PG8_LDB(B1, 1, 1); PG8_STAGE(PG8_SB(1, 0), b3, voffB);
            PG8_BAR; PG8_WAIT_L(0); PG8_MMA(0, 1, At, B1); PG8_BAR;
            PG8_LDA(At, 1, 1); PG8_STAGE(PG8_SA(1, 0), a3, voffA);
            PG8_BAR; PG8_WAIT_L(0); PG8_MMA(1, 0, At, B0); PG8_BAR; PG8_SCHED;
            PG8_STAGE(PG8_SB(1, 1), b3 + hstep, voffB);
            PG8_WAIT_V(6); PG8_BAR; PG8_MMA(1, 1, At, B1); PG8_BAR;
        }
        }
            if constexpr (!Epi::AFTER_DRAIN) { E(acc, cur, wr, wc, fr, fq); S.done(cur); }
            if (!has_next) break;
#pragma unroll
        for (int a = 0; a < 2; ++a)
#pragma unroll
            for (int b = 0; b < 2; ++b)
#pragma unroll
                for (int m = 0; m < 4; ++m)
#pragma unroll
                    for (int n = 0; n < 2; ++n) acc[a][b][m][n] = (f32x4){0.f, 0.f, 0.f, 0.f};
        cur = nxt; cA = nA; cB = nB; ++ui;
    }
    PG8_WAIT_V(0);
    if (wr == 0) PG8_BAR;
    PG8_BAR;
    if constexpr (Epi::AFTER_DRAIN) { E.fused(acc, cur, wr, wc, fr, fq, lds, wid, lane); S.done(cur); }
    if (STAMP && wid == 0) { stamps[lane] = lane < nts ? (((unsigned long long)(unsigned)ts_hi << 32) | (unsigned)ts_lo) : 0ull;
        if (lane == 62) stamps[62] = rt_entry; if (lane == 63) stamps[63] = (unsigned long long)wall_clock64(); }
#undef PG8_STAMP
#undef PG8_SA
#undef PG8_SB
#undef PG8_STAGE
#undef PG8_LDA
#undef PG8_LDB
#undef PG8_MMA
#undef PG8_WAIT_V
#undef PG8_WAIT_L
#undef PG8_BAR
#undef PG8_SCHED
}
}

typedef unsigned u32x4_ __attribute__((ext_vector_type(4)));
DEVI bf16x8 mk8(unsigned a, unsigned b, unsigned c, unsigned d) { u32x4_ v = {a, b, c, d}; return __builtin_bit_cast(bf16x8, v); }
DEVI float bflo(unsigned v) { return __uint_as_float(v << 16); }
DEVI float bfhi(unsigned v) { return __uint_as_float(v & 0xffff0000u); }
struct EpiProj {
  static constexpr bool PERM = true, AFTER_DRAIN = false; static constexpr int MID_T = 0;
  us *projA, *projB;
  DEVI void operator()(const f32x4 (&acc)[2][2][4][2], const pg8::Unit& u, int wr, int wc, int fr, int fq) const {
    const int row0 = u.pm * 256 + wr * 64 + fr;
#pragma unroll
    for (int bj = 0; bj < 2; ++bj) {
      const int nb = u.pn * 256 + bj * 128 + wc * 32;
      if (nb >= 5152) continue;
      us* dst; int ld, col, act;
      if (nb < 416) { dst = projA; ld = LDA_; col = nb; act = 0; }
      else if (nb < 928) { dst = projB; ld = LDB_; col = nb - 416; act = 1; }
      else if (nb < 2592) { dst = projA; ld = LDA_; col = nb - 928 + 416; act = 0; }
      else if (nb < 3104) { dst = projB; ld = LDB_; col = nb - 2592 + 512; act = 1; }
      else { dst = projB; ld = LDB_; col = nb - 3104 + 1024; act = 2; }
#pragma unroll
      for (int ai = 0; ai < 2; ++ai)
#pragma unroll
        for (int m = 0; m < 4; ++m) {
          f32x4 v0 = acc[ai][bj][m][0], v1 = acc[ai][bj][m][1];
          if (act == 1) {
#pragma unroll
            for (int r = 0; r < 4; ++r) { v0[r] = siluf_(v0[r]); v1[r] = siluf_(v1[r]); }
          } else if (act == 2) {
#pragma unroll
            for (int r = 0; r < 4; ++r) { v0[r] = sigmoidf_(v0[r]); v1[r] = sigmoidf_(v1[r]); }
          }
          uint4 o; o.x = pack2(v0[0], v0[1]); o.y = pack2(v0[2], v0[3]); o.z = pack2(v1[0], v1[1]); o.w = pack2(v1[2], v1[3]);
          __builtin_nontemporal_store(u32x4_{o.x, o.y, o.z, o.w}, (u32x4_*)(dst + (size_t)(row0 + ai * 128 + m * 16) * ld + col + 8 * fq));
        }
    }
  }
};
__device__ void phase2(const Params& p, unsigned char* smraw) {
  pg8::Gemm g{p.h, p.Wt_in, T_TOK, 5376, 1024};
  pg8::StaticOrder S; S.init(g.M, g.N, (int)gridDim.x, (int)blockIdx.x);
  EpiProj E{p.projA, p.projB};
  pg8::gemm_phase<EpiProj, pg8::StaticOrder, false>((PG8_LAS unsigned char*)smraw, g, S, E, nullptr);
}

#define REG_(i) ((us*)(smraw + (i) * 9216))
DEVI f32x4 mm_tile(const us* A, const us* B, int mt, int nt, int fr, int fq, f32x4 acc) {
#pragma unroll
  for (int ks = 0; ks < 2; ++ks) {
    bf16x8 a = *(const bf16x8*)(A + (mt * 16 + fr) * 72 + ks * 32 + fq * 8);
    bf16x8 b = *(const bf16x8*)(B + (nt * 16 + fr) * 72 + ks * 32 + fq * 8);
    acc = mfma16(a, b, acc);
  }
  return acc;
}
typedef short v4s_ __attribute__((ext_vector_type(4)));
DEVI bf16x8 frag_tr(const us* X, int r0, int ks, int lane) {
  const int grp = lane >> 4, i = lane & 15;
  const us* a0 = X + (ks * 32 + 8 * grp + (i >> 2)) * 72 + r0 + 4 * (i & 3);
  const v4s_ lo = __builtin_amdgcn_ds_read_tr16_b64_v4i16((__attribute__((address_space(3))) v4s_*)a0);
  const v4s_ hi = __builtin_amdgcn_ds_read_tr16_b64_v4i16((__attribute__((address_space(3))) v4s_*)(a0 + 4 * 72));
  return bf16x8{lo[0], lo[1], lo[2], lo[3], hi[0], hi[1], hi[2], hi[3]};
}
template <bool TA, bool TB>
DEVI f32x4 mm_tile_x(const us* A, const us* B, int mt, int nt, int lane, f32x4 acc) {
  const int fr = lane & 15, fq = lane >> 4;
#pragma unroll
  for (int ks = 0; ks < 2; ++ks) {
    const bf16x8 a = TA ? frag_tr(A, mt * 16, ks, lane) : *(const bf16x8*)(A + (mt * 16 + fr) * 72 + ks * 32 + fq * 8);
    const bf16x8 b = TB ? frag_tr(B, nt * 16, ks, lane) : *(const bf16x8*)(B + (nt * 16 + fr) * 72 + ks * 32 + fq * 8);
    acc = mfma16(a, b, acc);
  }
  return acc;
}
DEVI void storeT_nt(us* dst, int ld, int mt, int nt, int fr, int fq, f32x4 v) {
  const uint2 q = pack4(v);
  __builtin_nontemporal_store(u32x2n_{q.x, q.y}, (u32x2n_*)(dst + (nt * 16 + fr) * ld + mt * 16 + fq * 4));
}
DEVI void storeT(us* dst, int ld, int mt, int nt, int fr, int fq, f32x4 v) {
  *(uint2*)(dst + (nt * 16 + fr) * ld + mt * 16 + fq * 4) = pack4(v);
}
DEVI f32x4 maskv(f32x4 v, int mt, int nt, int fr, int fq, int mode) {
  const int n = nt * 16 + fr, m0 = mt * 16 + fq * 4;
#pragma unroll
  for (int r = 0; r < 4; ++r) {
    const int m = m0 + r;
    bool keep = (mode == 0) ? (m < n) : (mode == 1) ? (m <= n) : (n < m);
    if (!keep) v[r] = 0.f;
  }
  return v;
}
struct WkvRaw { bf16x8 cur[5], prv[5]; };
DEVI void wkv_load_raw(const Params& p, int item, WkvRaw& R) {
  const int tid = tidx();
  const int h = item & 7, bc = item >> 3, b = bc >> 6, c = bc & 63;
  const int t = tid >> 3, j0 = (tid & 7) * 8, jc = h * 64 + j0;
  const bool hp = (c * 64 + t) > 0;
  const us* rowp = p.projA + (size_t)(b * SEQ + c * 64 + t) * LDA_ + 416;
  const int offs[5] = {jc, 512 + jc, 1024 + jc, 1536 + j0, 1600 + j0};
#pragma unroll
  for (int q = 0; q < 5; ++q) {
    R.cur[q] = *(const bf16x8*)(rowp + offs[q]);
    R.prv[q] = hp ? *(const bf16x8*)(rowp + offs[q] - LDA_) : R.cur[q];
  }
}
DEVI void shift8(bf16x8 cur, bf16x8 prv, bool hasprev, const float* mu, float (&o)[8]) {
  const float4 m0 = *(const float4*)mu, m1 = *(const float4*)(mu + 4);
  const float mm[8] = {m0.x, m0.y, m0.z, m0.w, m1.x, m1.y, m1.z, m1.w};
#pragma unroll
  for (int e = 0; e < 8; ++e) {
    float cv = bf2f((us)cur[e]);
    float pv = hasprev ? bf2f((us)prv[e]) : 0.f;
    o[e] = cv + (pv - cv) * mm[e];
  }
}
DEVI void ld8f(const float* ptr, float (&o)[8]) {
  const float4 a = *(const float4*)ptr, b = *(const float4*)(ptr + 4);
  o[0] = a.x; o[1] = a.y; o[2] = a.z; o[3] = a.w; o[4] = b.x; o[5] = b.y; o[6] = b.z; o[7] = b.w;
}
DEVI float fast_tanh(float x) { const float e = __builtin_amdgcn_exp2f(2.8853900817779268f * x); return 1.f - 2.f * __builtin_amdgcn_rcpf(e + 1.f); }

__device__ void wkv_prep_item(const Params& p, int item, int next_item, WkvRaw& RW, unsigned char* smraw) {
  const int tid = tidx(), lane = tid & 63, w = tid >> 6, fr = lane & 15, fq = lane >> 4;
  const int h = item & 7, bc = item >> 3, b = bc >> 6, c = bc & 63;
  const int ch = (b * 8 + h) * 64 + c;
  const int tok0 = b * SEQ + c * 64;
  const int t = tid >> 3, j0 = (tid & 7) * 8, jc = h * 64 + j0;
  const f32x4 z4 = {0.f, 0.f, 0.f, 0.f};
  us *At = REG_(0), *Bt = REG_(1), *Kt = REG_(2), *Rt = REG_(3), *BhT = REG_(4), *KhT = REG_(5), *VT = REG_(6);
  us *P0 = REG_(7), *PT0 = REG_(8), *P1 = REG_(9), *PT1 = REG_(10), *Aak = REG_(11), *Arb = REG_(12), *Ark = REG_(13);
  us* UT = REG_(14);
  float* F = (float*)REG_(9);
  float* G = (float*)REG_(14);
  float* segsum = (float*)(smraw + 16 * 9216);

  float rr[8], kk_[8], vv[8], wd[8], ad[8];
  {
    const bool hp = (c * 64 + t) > 0;
    shift8(RW.cur[0], RW.prv[0], hp, p.mu + jc, rr);
    shift8(RW.cur[1], RW.prv[1], hp, p.mu + 512 + jc, kk_);
    shift8(RW.cur[2], RW.prv[2], hp, p.mu + 1024 + jc, vv);
    shift8(RW.cur[3], RW.prv[3], hp, p.mu + 1536 + j0, wd);
    shift8(RW.cur[4], RW.prv[4], hp, p.mu + 1600 + j0, ad);
  }
  {
    uint4 o1, o2;
    o1.x = pack2(fast_tanh(wd[0]), fast_tanh(wd[1])); o1.y = pack2(fast_tanh(wd[2]), fast_tanh(wd[3]));
    o1.z = pack2(fast_tanh(wd[4]), fast_tanh(wd[5])); o1.w = pack2(fast_tanh(wd[6]), fast_tanh(wd[7]));
    o2.x = pack2(ad[0], ad[1]); o2.y = pack2(ad[2], ad[3]); o2.z = pack2(ad[4], ad[5]); o2.w = pack2(ad[6], ad[7]);
    *(uint4*)(P0 + t * 72 + j0) = o1;
    *(uint4*)(PT0 + t * 72 + j0) = o2;
  }
  lds_barrier();
  {
    const int which = w >> 2, tt = w & 3;
    const us* A = which ? PT0 : P0;
    const us* Wt = (which ? p.Wt_icl : p.Wt_dec) + (size_t)h * 64 * 64;
    float* Fw = F + which * 4160;
#pragma unroll
    for (int jt = 0; jt < 4; ++jt) {
      f32x4 acc = z4;
#pragma unroll
      for (int ks = 0; ks < 2; ++ks) {
        bf16x8 a = *(const bf16x8*)(A + (tt * 16 + fr) * 72 + ks * 32 + fq * 8);
        bf16x8 bq = *(const bf16x8*)(Wt + (jt * 16 + fr) * 64 + ks * 32 + fq * 8);
        acc = mfma16(a, bq, acc);
      }
#pragma unroll
      for (int r = 0; r < 4; ++r) Fw[(tt * 16 + fq * 4 + r) * 65 + jt * 16 + fr] = acc[r];
    }
  }
  lds_barrier();
  float lw[8], av[8], kn[8], kp[8];
  {
    float ss = 0.f;
    float pw0[8], pa0[8], pkk[8], pka[8];
    ld8f(p.w0 + jc, pw0); ld8f(p.a0 + jc, pa0); ld8f(p.k_k + jc, pkk); ld8f(p.k_a + jc, pka);
#pragma unroll
    for (int e = 0; e < 8; ++e) {
      float dl = pw0[e] + F[t * 65 + j0 + e];
      float al = pa0[e] + F[4160 + t * 65 + j0 + e];
      float xneg = -dl;
      float sp = fmaxf(xneg, 0.f) + __logf(1.f + __expf(-fabsf(xneg)));
      float wl = -sp - 0.5f;
      lw[e] = -__expf(wl);
      av[e] = sigmoidf_(al);
      float kq = kk_[e] * pkk[e];
      kn[e] = kq;
      ss += kq * kq;
      kp[e] = kk_[e] * (1.f + (av[e] - 1.f) * pka[e]);
    }
    ss += __shfl_xor(ss, 1); ss += __shfl_xor(ss, 2); ss += __shfl_xor(ss, 4);
    const float inv = 1.f / fmaxf(sqrtf(ss), 1e-12f);
    float bon = 0.f;
    float prk[8];
    ld8f(p.r_k + jc, prk);
#pragma unroll
    for (int e = 0; e < 8; ++e) {
      kn[e] *= inv;
      bon += rr[e] * kp[e] * prk[e];
    }
    bon += __shfl_xor(bon, 1); bon += __shfl_xor(bon, 2); bon += __shfl_xor(bon, 4);
    uint4 o;
    o.x = pack2(bon * vv[0], bon * vv[1]); o.y = pack2(bon * vv[2], bon * vv[3]);
    o.z = pack2(bon * vv[4], bon * vv[5]); o.w = pack2(bon * vv[6], bon * vv[7]);
    __builtin_nontemporal_store(u32x4_{o.x, o.y, o.z, o.w}, (u32x4_*)(p.bv + (size_t)(tok0 + t) * 512 + jc));
  }
  lds_barrier();
#pragma unroll
  for (int e = 0; e < 8; ++e) G[t * 65 + j0 + e] = lw[e];
  lds_barrier();
  {
    const int j = tid & 63, seg = tid >> 6;
    float run = 0.f;
#pragma unroll
    for (int i = 0; i < 8; ++i) { run += G[(seg * 8 + i) * 65 + j]; G[(seg * 8 + i) * 65 + j] = run; }
    segsum[seg * 64 + j] = run;
    lds_barrier();
    float off = 0.f;
    for (int s2 = 0; s2 < seg; ++s2) off += segsum[s2 * 64 + j];
#pragma unroll
    for (int i = 0; i < 8; ++i) G[(seg * 8 + i) * 65 + j] += off;
  }
  lds_barrier();
  {
    float ta[8], tb[8], tk[8], tr[8], tbh[8], tkh[8];
#pragma unroll
    for (int e = 0; e < 8; ++e) {
      const float g = G[t * 65 + j0 + e], gC = G[63 * 65 + j0 + e];
      const float eg = __expf(g), eng = __expf(-g), egx = __expf(g - lw[e]), egc = __expf(gC - g);
      ta[e] = -kn[e] * egx;
      tb[e] = kn[e] * av[e] * eng;
      tk[e] = kp[e] * eng;
      tr[e] = rr[e] * eg;
      tbh[e] = kn[e] * av[e] * egc;
      tkh[e] = kp[e] * egc;
      if (t == 0) p.Gc[ch * 64 + j0 + e] = __expf(gC);
    }
    uint4 o;
    o.x = pack2(ta[0], ta[1]); o.y = pack2(ta[2], ta[3]); o.z = pack2(ta[4], ta[5]); o.w = pack2(ta[6], ta[7]);
    *(uint4*)(At + t * 72 + j0) = o;
    o.x = pack2(tb[0], tb[1]); o.y = pack2(tb[2], tb[3]); o.z = pack2(tb[4], tb[5]); o.w = pack2(tb[6], tb[7]);
    *(uint4*)(Bt + t * 72 + j0) = o;
    o.x = pack2(tk[0], tk[1]); o.y = pack2(tk[2], tk[3]); o.z = pack2(tk[4], tk[5]); o.w = pack2(tk[6], tk[7]);
    *(uint4*)(Kt + t * 72 + j0) = o;
    o.x = pack2(tr[0], tr[1]); o.y = pack2(tr[2], tr[3]); o.z = pack2(tr[4], tr[5]); o.w = pack2(tr[6], tr[7]);
    *(uint4*)(Rt + t * 72 + j0) = o;
    o.x = pack2(tbh[0], tbh[1]); o.y = pack2(tbh[2], tbh[3]); o.z = pack2(tbh[4], tbh[5]); o.w = pack2(tbh[6], tbh[7]);
    *(uint4*)(BhT + t * 72 + j0) = o;
    o.x = pack2(tkh[0], tkh[1]); o.y = pack2(tkh[2], tkh[3]); o.z = pack2(tkh[4], tkh[5]); o.w = pack2(tkh[6], tkh[7]);
    *(uint4*)(KhT + t * 72 + j0) = o;
    o.x = pack2(vv[0], vv[1]); o.y = pack2(vv[2], vv[3]); o.z = pack2(vv[4], vv[5]); o.w = pack2(vv[6], vv[7]);
    *(uint4*)(VT + t * 72 + j0) = o;
  }
  lds_barrier();
#pragma unroll
  for (int q = 0; q < 2; ++q) {
    const int id = w * 2 + q, mt = id >> 2, nt = id & 3;
    storeT(P0, 72, mt, nt, fr, fq, maskv(mm_tile(Bt, At, mt, nt, fr, fq, z4), mt, nt, fr, fq, 0));
  }
  lds_barrier();
  us* Tb = PT0;
  us* UTw = UT + w * 16 * 72;
  if (w == 0) {
    const int blk = lane >> 4, cc = lane & 15;
    float Tc[16];
#pragma unroll
    for (int r = 0; r < 16; ++r) Tc[r] = 0.f;
#pragma unroll
    for (int r = 0; r < 16; ++r) {
      float v = (r == cc) ? 1.f : 0.f;
      if (r > 0) {
        const us* arow = P0 + (blk * 16 + r) * 72 + blk * 16;
        const uint4 lo = *(const uint4*)arow;
        const uint4 hi = *(const uint4*)(arow + 8);
        const unsigned wv[8] = {lo.x, lo.y, lo.z, lo.w, hi.x, hi.y, hi.z, hi.w};
#pragma unroll
        for (int s2 = 0; s2 < r; ++s2) v += ((s2 & 1) ? bfhi(wv[s2 >> 1]) : bflo(wv[s2 >> 1])) * Tc[s2];
      }
      Tc[r] = v;
    }
#pragma unroll
    for (int r = 0; r < 16; ++r) Tb[blk * 256 + r * 16 + cc] = f2bf(Tc[r]);
  } else {
    for (int L = w - 1; L < 48; L += 7) {
      const int which = L >> 4, id = L & 15, mt = id >> 2, nt = id & 3;
      if (which == 0) storeT(Aak, 72, mt, nt, fr, fq, maskv(mm_tile(Kt, At, mt, nt, fr, fq, z4), mt, nt, fr, fq, 0));
      else if (which == 1) storeT(Arb, 72, mt, nt, fr, fq, maskv(mm_tile(Bt, Rt, mt, nt, fr, fq, z4), mt, nt, fr, fq, 1));
      else storeT(Ark, 72, mt, nt, fr, fq, maskv(mm_tile(Kt, Rt, mt, nt, fr, fq, z4), mt, nt, fr, fq, 1));
    }
  }
  {
    const uint4 zz = make_uint4(0u, 0u, 0u, 0u);
    *(uint4*)(UTw + (lane >> 2) * 72 + (lane & 3) * 16) = zz;
    *(uint4*)(UTw + (lane >> 2) * 72 + (lane & 3) * 16 + 8) = zz;
  }
  lds_barrier();
  if (next_item < 4096) wkv_load_raw(p, next_item, RW);
  {
    f32x4 zI[4];
    if (w >= 4) {
#pragma unroll
      for (int I = 0; I < 4; ++I) zI[I] = mm_tile_x<false, true>(Aak, VT, I, w - 4, lane, z4);
    } else {
#pragma unroll
      for (int I = 0; I < 4; ++I)
#pragma unroll
        for (int r = 0; r < 4; ++r) zI[I][r] = bf2f(At[(I * 16 + fq * 4 + r) * 72 + w * 16 + fr]);
    }
#pragma unroll
    for (int I = 0; I < 4; ++I) {
      f32x4 rhs = zI[I];
      if (I >= 1) {
#pragma unroll
        for (int ks = 0; ks < (I == 3 ? 2 : 1); ++ks) {
          const bf16x8 a = *(const bf16x8*)(P0 + (I * 16 + fr) * 72 + ks * 32 + fq * 8);
          const bf16x8 b = *(const bf16x8*)(UTw + fr * 72 + ks * 32 + fq * 8);
          rhs = mfma16(a, b, rhs);
        }
      }
      const uint2 tq = *(const uint2*)(Tb + I * 256 + fr * 16 + fq * 4);
      const uint2 rq = pack4(rhs);
      const f32x4 uI = mfma16(mk8(tq.x, tq.y, 0u, 0u), mk8(rq.x, rq.y, 0u, 0u), z4);
      *(uint2*)(UTw + fr * 72 + I * 16 + fq * 4) = pack4(uI);
    }
  }
  lds_barrier();
  {
    const int o = w >> 1;
    const us* U1 = UT;
    const us* U0 = UT + 64 * 72;
    for (int q = 0; q < 8; ++q) {
      const int id = (w & 1) * 8 + q, mt = id >> 2, nt = id & 3;
      if (o == 0) {
        f32x4 cc = mm_tile_x<false, true>(U1, BhT, mt, nt, lane, z4);
        storeT_nt(p.Mp + (size_t)ch * 4096, 64, mt, nt, fr, fq, cc);
      } else if (o == 1) {
        f32x4 cc = mm_tile_x<true, false>(BhT, U0, mt, nt, lane, z4);
        cc = mm_tile_x<true, true>(KhT, VT, mt, nt, lane, cc);
        storeT_nt(p.Nt + (size_t)ch * 4096, 64, mt, nt, fr, fq, cc);
      } else if (o == 2) {
        f32x4 cc = mm_tile(U1, Arb, mt, nt, fr, fq, z4);
#pragma unroll
        for (int r = 0; r < 4; ++r) cc[r] += bf2f(Rt[(nt * 16 + fr) * 72 + mt * 16 + fq * 4 + r]);
        storeT_nt(p.Y1 + (size_t)ch * 4096, 64, mt, nt, fr, fq, cc);
      } else {
        f32x4 cc = mm_tile(U0, Arb, mt, nt, fr, fq, z4);
        cc = mm_tile_x<true, false>(VT, Ark, mt, nt, lane, cc);
        storeT_nt(p.Y0t + (size_t)ch * 4096, 64, mt, nt, fr, fq, cc);
      }
    }
  }
  lds_barrier();
}

#define P3_COMMON \
  us* sm = (us*)smraw; \
  float* rs = (float*)(smraw + 2 * GST * 2); \
  const int tid = tidx(), lane = tid & 63, wid = tid >> 6; \
  const int wx = wid >> 2, wy = wid & 3, fr = lane & 15, fq = lane >> 4;
__device__ void phase3q(const Params& p, unsigned char* smraw) {
  P3_COMMON
  for (int it = blockIdx.x; it < 6 * 128; it += gridDim.x) {
    {
      const int yt = it / 6, xt = it % 6, x0 = xt * 128, y0 = yt * 256;
      f32x4 acc[4][4];
      zero_acc(acc);
      gemm_main<true>(p.Wt_uq + (size_t)x0 * 256, 256, p.projA + (size_t)y0 * LDA_, LDA_, 256, sm, acc, rs, 1.f / 256.f, 1e-6f);
#pragma unroll
      for (int j = 0; j < 4; ++j) {
        const int tl = wy * 64 + j * 16 + fr, tk = y0 + tl;
        const float rstd = rs[tl];
        const int bb = tk >> 12, s = tk & 4095;
#pragma unroll
        for (int i = 0; i < 4; ++i) {
          const int nb = x0 + wx * 64 + i * 16;
          const int hd = nb / 96, dq = nb % 96;
          us* qrow = p.Q + ((size_t)(bb * 8 + hd) * SEQ + s) * 96;
          if (dq < 64) {
            f32x4 v = acc[i][j] * rstd;
            *(uint2*)(qrow + dq + fq * 4) = pack4(v);
          } else if (dq == 64) {
            if (i < 3) {
              f32x4 t1 = acc[i][j] * rstd, t2 = acc[(i + 1) & 3][j] * rstd, o1, o2;
              const float4 cv = *(const float4*)(p.cs + (size_t)tk * 32 + fq * 4);
              const float4 sv = *(const float4*)(p.cs + (size_t)tk * 32 + 16 + fq * 4);
              o1[0] = t1[0] * cv.x - t2[0] * sv.x; o2[0] = t1[0] * sv.x + t2[0] * cv.x;
              o1[1] = t1[1] * cv.y - t2[1] * sv.y; o2[1] = t1[1] * sv.y + t2[1] * cv.y;
              o1[2] = t1[2] * cv.z - t2[2] * sv.z; o2[2] = t1[2] * sv.z + t2[2] * cv.z;
              o1[3] = t1[3] * cv.w - t2[3] * sv.w; o2[3] = t1[3] * sv.w + t2[3] * cv.w;
              *(uint2*)(qrow + 64 + fq * 4) = pack4(o1);
              *(uint2*)(qrow + 80 + fq * 4) = pack4(o2);
            }
          }
        }
      }
      lds_barrier();
    }
  }
}
__device__ void phase3kv(const Params& p, unsigned char* smraw) {
  P3_COMMON
  for (int it = blockIdx.x; it < 8 * 128; it += gridDim.x) {
    {
      const int r = it, yt = r >> 3, xt = r & 7, x0 = xt * 128, y0 = yt * 256;
      f32x4 acc[4][4];
      zero_acc(acc);
      gemm_main<true, true>(p.Wt_ukv + (size_t)x0 * 128, 128, p.projA + (size_t)y0 * LDA_ + 256, LDA_, 128, sm, acc, rs, 1.f / 128.f, 1e-6f);
      const int hd = xt;
      if (wx == 0) {
#pragma unroll
        for (int j = 0; j < 4; ++j) {
          const int tl = wy * 64 + j * 16 + fr, tk = y0 + tl;
          const float rstd = rs[tl];
          const int bb = tk >> 12, s = tk & 4095;
#pragma unroll
          for (int i = 0; i < 4; ++i) {
            f32x4 v = acc[i][j] * rstd;
            *(uint2*)(p.K + ((size_t)(bb * 8 + hd) * SEQ + s) * 96 + i * 16 + fq * 4) = pack4(v);
          }
        }
      } else {
#pragma unroll
        for (int j = 0; j < 4; ++j) {
          const int tl0 = wy * 64 + j * 16 + fq * 4, tk0 = y0 + tl0;
          const f32x4 r4 = *(const f32x4*)(rs + tl0);
          const int bb = tk0 >> 12, s0 = tk0 & 4095;
#pragma unroll
          for (int i = 0; i < 4; ++i) {
            f32x4 v = acc[i][j] * r4;
            *(uint2*)(p.Vt + ((size_t)(bb * 8 + hd) * 64 + i * 16 + fr) * SEQ + s0) = pack4(v);
          }
        }
      }
      lds_barrier();
    }
  }
}
__device__ void phase3w(const Params& p, unsigned char* smraw) {
  const int tid = tidx();
  {
    WkvRaw RW;
    if ((int)blockIdx.x < 4096) wkv_load_raw(p, blockIdx.x, RW);
    for (int it = blockIdx.x; it < 4096; it += gridDim.x) wkv_prep_item(p, it, it + (int)gridDim.x, RW, smraw);
  }
  const int gt = blockIdx.x * NTHR + tid, gs = gridDim.x * NTHR;
  for (int i = gt; i < T_TOK * 16; i += gs) {
    const int tk = i >> 4, pi = i & 15;
    const float k1 = bf2f(p.projA[(size_t)tk * LDA_ + 384 + pi]), k2 = bf2f(p.projA[(size_t)tk * LDA_ + 400 + pi]);
    const float cv = p.cs[tk * 32 + pi], sv = p.cs[tk * 32 + 16 + pi];
    const us o1 = f2bf(k1 * cv - k2 * sv), o2 = f2bf(k1 * sv + k2 * cv);
    const int bb = tk >> 12, s = tk & 4095;
#pragma unroll
    for (int hd = 0; hd < 8; ++hd) {
      us* kr = p.K + ((size_t)(bb * 8 + hd) * SEQ + s) * 96;
      kr[64 + pi] = o1;
      kr[80 + pi] = o2;
    }
  }
}

typedef unsigned u32x2_ __attribute__((ext_vector_type(2)));
struct ScanLd { u32x4_ a[4][2]; f32x4 g[4]; u32x2_ nn[4]; };
DEVI void scan_load(const Params& p, size_t ch, int vs, int fr, int fq, ScanLd& L) {
  const us* mp = p.Mp + ch * 4096;
  const us* nt = p.Nt + ch * 4096 + (vs * 16 + fr) * 64 + fq * 4;
  const float* gc = p.Gc + ch * 64 + fq * 4;
#pragma unroll
  for (int m = 0; m < 4; ++m) {
    L.g[m] = *(const f32x4*)(gc + m * 16);
    L.nn[m] = *(const u32x2_*)(nt + m * 16);
#pragma unroll
    for (int ks = 0; ks < 2; ++ks) {
      const u32x2_ lo = *(const u32x2_*)(mp + (m * 16 + fr) * 64 + ks * 32 + fq * 4);
      const u32x2_ hi = *(const u32x2_*)(mp + (m * 16 + fr) * 64 + ks * 32 + 16 + fq * 4);
      L.a[m][ks] = u32x4_{lo[0], lo[1], hi[0], hi[1]};
    }
  }
}
DEVI void scan_step(f32x4 (&H)[4], const ScanLd& L) {
  bf16x8 bop[2];
#pragma unroll
  for (int ks = 0; ks < 2; ++ks) {
    uint2 lo = pack4(H[2 * ks]), hi = pack4(H[2 * ks + 1]);
    bop[ks] = mk8(lo.x, lo.y, hi.x, hi.y);
  }
#pragma unroll
  for (int m = 0; m < 4; ++m) {
    f32x4 hn;
    hn[0] = L.g[m][0] * H[m][0] + bflo(L.nn[m][0]);
    hn[1] = L.g[m][1] * H[m][1] + bfhi(L.nn[m][0]);
    hn[2] = L.g[m][2] * H[m][2] + bflo(L.nn[m][1]);
    hn[3] = L.g[m][3] * H[m][3] + bfhi(L.nn[m][1]);
#pragma unroll
    for (int ks = 0; ks < 2; ++ks) hn = mfma16(__builtin_bit_cast(bf16x8, L.a[m][ks]), bop[ks], hn);
    H[m] = hn;
  }
}
DEVI void scan_store(const Params& p, size_t ch, int vs, int fr, int fq, const f32x4 (&H)[4]) {
  us* hh = p.Hh + ch * 4096 + (vs * 16 + fr) * 64 + fq * 4;
#pragma unroll
  for (int m = 0; m < 4; ++m) { const uint2 q = pack4(H[m]); __builtin_nontemporal_store(u32x2n_{q.x, q.y}, (u32x2n_*)(hh + m * 16)); }
}
__device__ void wkv_scan_item(const Params& p, int item) {
  const int lane = tidx() & 63, fr = lane & 15, fq = lane >> 4;
  const int bh = item >> 2, vs = item & 3;
  const size_t ch0 = (size_t)bh * 64;
  f32x4 H[4];
#pragma unroll
  for (int m = 0; m < 4; ++m) H[m] = f32x4{0.f, 0.f, 0.f, 0.f};
  ScanLd L0, L1, L2;
  scan_load(p, ch0, vs, fr, fq, L0);
  scan_load(p, ch0 + 1, vs, fr, fq, L1);
  scan_load(p, ch0 + 2, vs, fr, fq, L2);
  for (int c = 0; c < 63; c += 3) {
    scan_store(p, ch0 + c, vs, fr, fq, H); scan_step(H, L0); scan_load(p, ch0 + min(c + 3, 62), vs, fr, fq, L0);
    scan_store(p, ch0 + c + 1, vs, fr, fq, H); scan_step(H, L1); scan_load(p, ch0 + min(c + 4, 62), vs, fr, fq, L1);
    scan_store(p, ch0 + c + 2, vs, fr, fq, H); scan_step(H, L2); scan_load(p, ch0 + min(c + 5, 62), vs, fr, fq, L2);
  }
  scan_store(p, ch0 + 63, vs, fr, fq, H);
}

constexpr int SC_G = 6, SC_NT = 64 * 144, SC_GC = SC_NT + 16 * 144, SC_SLOT = SC_GC + 256, SC_NGRP = 11;
__device__ void wkv_scan_block(const Params& p, int item, unsigned char* smraw) {
  const int tid = tidx(), lane = tid & 63, w = tid >> 6, fr = lane & 15, fq = lane >> 4;
  const int bh = item >> 2, vs = item & 3;
  const size_t ch0 = (size_t)bh * 64;
  bf16x8 gm[SC_G], gn[2];
  f32x4 gg;
  const int mrow = tid >> 3, mcol = (tid & 7) * 8;
  int nslot[2], nrow[2], ncol[2];
#pragma unroll
  for (int q = 0; q < 2; ++q) { const int id = tid + 512 * q; nslot[q] = id >> 7; nrow[q] = (id & 127) >> 3; ncol[q] = (id & 7) * 8; }
  const int gslot = tid >> 4, gcol = (tid & 15) * 4;
#define SC_LOAD(g0) { \
    _Pragma("unroll") for (int q = 0; q < SC_G; ++q) gm[q] = *(const bf16x8*)(p.Mp + (ch0 + min((g0) + q, 62)) * 4096 + mrow * 64 + mcol); \
    _Pragma("unroll") for (int q = 0; q < 2; ++q) if (tid + 512 * q < SC_G * 128) \
      gn[q] = *(const bf16x8*)(p.Nt + (ch0 + min((g0) + nslot[q], 62)) * 4096 + (vs * 16 + nrow[q]) * 64 + ncol[q]); \
    if (tid < SC_G * 16) gg = *(const f32x4*)(p.Gc + (ch0 + min((g0) + gslot, 62)) * 64 + gcol); }
#define SC_WRITE(buf) { unsigned char* bb = smraw + (buf) * (SC_G * SC_SLOT); \
    _Pragma("unroll") for (int q = 0; q < SC_G; ++q) *(bf16x8*)(bb + q * SC_SLOT + mrow * 144 + mcol * 2) = gm[q]; \
    _Pragma("unroll") for (int q = 0; q < 2; ++q) if (tid + 512 * q < SC_G * 128) \
      *(bf16x8*)(bb + nslot[q] * SC_SLOT + SC_NT + nrow[q] * 144 + ncol[q] * 2) = gn[q]; \
    if (tid < SC_G * 16) *(f32x4*)(bb + gslot * SC_SLOT + SC_GC + gcol * 4) = gg; }
  f32x4 H[4];
#pragma unroll
  for (int m = 0; m < 4; ++m) H[m] = f32x4{0.f, 0.f, 0.f, 0.f};
  SC_LOAD(0)
  SC_WRITE(0)
  lds_barrier();
  for (int g = 0; g < SC_NGRP; ++g) {
    if (g + 1 < SC_NGRP) SC_LOAD((g + 1) * SC_G)
    if (w == 0) {
      const unsigned char* bb = smraw + (g & 1) * (SC_G * SC_SLOT);
#pragma unroll
      for (int q = 0; q < SC_G; ++q) {
        const int c = g * SC_G + q;
        if (c < 63) {
          scan_store(p, ch0 + c, vs, fr, fq, H);
          const unsigned char* sl = bb + q * SC_SLOT;
          bf16x8 bop[2];
#pragma unroll
          for (int ks = 0; ks < 2; ++ks) {
            const uint2 lo = pack4(H[2 * ks]), hi = pack4(H[2 * ks + 1]);
            bop[ks] = mk8(lo.x, lo.y, hi.x, hi.y);
          }
#pragma unroll
          for (int m = 0; m < 4; ++m) {
            const f32x4 gv = *(const f32x4*)(sl + SC_GC + (m * 16 + fq * 4) * 4);
            const uint2 nn = *(const uint2*)(sl + SC_NT + fr * 144 + (m * 16 + fq * 4) * 2);
            f32x4 hn;
            hn[0] = gv[0] * H[m][0] + bflo(nn.x); hn[1] = gv[1] * H[m][1] + bfhi(nn.x);
            hn[2] = gv[2] * H[m][2] + bflo(nn.y); hn[3] = gv[3] * H[m][3] + bfhi(nn.y);
#pragma unroll
            for (int ks = 0; ks < 2; ++ks) {
              const uint2 lo = *(const uint2*)(sl + (m * 16 + fr) * 144 + (ks * 32 + fq * 4) * 2);
              const uint2 hi = *(const uint2*)(sl + (m * 16 + fr) * 144 + (ks * 32 + 16 + fq * 4) * 2);
              hn = mfma16(mk8(lo.x, lo.y, hi.x, hi.y), bop[ks], hn);
            }
            H[m] = hn;
          }
        }
      }
    }
    if (g + 1 < SC_NGRP) SC_WRITE((g + 1) & 1)
    lds_barrier();
  }
  if (w == 0) scan_store(p, ch0 + 63, vs, fr, fq, H);
#undef SC_LOAD
#undef SC_WRITE
}

constexpr int AKS = 104, AVS = 68, ASTG = 64 * AKS + 64 * AVS;
__device__ void attn_item(const Params& p, int bh, int qt, unsigned char* smraw) {
  us* sm = (us*)smraw;
  const int tid = tidx(), lane = tid & 63, w = tid >> 6, c = lane & 31, hh = lane >> 5;
  const int pr = w >> 1, sub = w & 1;
  const int q0 = qt * 256;
  const us* Kg = p.K + (size_t)bh * SEQ * 96;
  const us* Vg = p.Vt + (size_t)bh * 64 * SEQ;
  bf16x8 qf[2][6];
#pragma unroll
  for (int qs = 0; qs < 2; ++qs) {
    const us* qb = p.Q + ((size_t)bh * SEQ + q0 + pr * 64 + qs * 32 + c) * 96 + 8 * hh;
#pragma unroll
    for (int s = 0; s < 6; ++s) qf[qs][s] = *(const bf16x8*)(qb + 16 * s);
  }
  const int nkt = q0 / 64 + 4, mylim = q0 / 64 + pr;
  f32x16 ot[2][2];
#pragma unroll
  for (int a = 0; a < 2; ++a)
#pragma unroll
    for (int b = 0; b < 2; ++b)
#pragma unroll
      for (int r = 0; r < 16; ++r) ot[a][b][r] = 0.f;
  float mrun[2] = {-1e30f, -1e30f}, lrun[2] = {0.f, 0.f};
  const int kr0 = tid / 12, kc0 = (tid % 12) * 8;
  const int kr1 = (tid + 512) / 12, kc1 = ((tid + 512) % 12) * 8;
  const int vr = tid >> 3, vc = (tid & 7) * 8;
  bf16x8 gk0, gk1, gv;
  gk0 = *(const bf16x8*)(Kg + (size_t)kr0 * 96 + kc0);
  if (tid < 256) gk1 = *(const bf16x8*)(Kg + (size_t)kr1 * 96 + kc1);
  gv = *(const bf16x8*)(Vg + (size_t)vr * SEQ + vc);
  {
    us* ks = sm; us* vsm = sm + 64 * AKS;
    *(bf16x8*)(ks + kr0 * AKS + kc0) = gk0;
    if (tid < 256) *(bf16x8*)(ks + kr1 * AKS + kc1) = gk1;
    const u32x4_ q4 = __builtin_bit_cast(u32x4_, gv);
    *(uint2*)(vsm + vr * AVS + vc) = make_uint2(q4.x, q4.y);
    *(uint2*)(vsm + vr * AVS + vc + 4) = make_uint2(q4.z, q4.w);
  }
  lds_barrier();
  for (int kt = 0; kt < nkt; ++kt) {
    const int cur = kt & 1;
    if (kt + 1 < nkt) {
      const size_t kb = (size_t)(kt + 1) * 64;
      gk0 = *(const bf16x8*)(Kg + (kb + kr0) * 96 + kc0);
      if (tid < 256) gk1 = *(const bf16x8*)(Kg + (kb + kr1) * 96 + kc1);
      gv = *(const bf16x8*)(Vg + (size_t)vr * SEQ + kb + vc);
    }
    if (kt <= mylim) {
      const us* ks = sm + cur * ASTG + (32 * sub + c) * AKS + 8 * hh;
      const us* vsm = sm + cur * ASTG + 64 * AKS + 32 * sub + 4 * hh;
      f32x16 sc[2];
#pragma unroll
      for (int a = 0; a < 2; ++a)
#pragma unroll
        for (int r = 0; r < 16; ++r) sc[a][r] = 0.f;
#pragma unroll
      for (int s = 0; s < 6; ++s) {
        const bf16x8 a0 = *(const bf16x8*)(ks + 16 * s);
        sc[0] = mfma32(a0, qf[0][s], sc[0]);
        sc[1] = mfma32(a0, qf[1][s], sc[1]);
      }
#pragma unroll
      for (int qs = 0; qs < 2; ++qs) {
        float mx = fmaxf(fmaxf(sc[qs][0], sc[qs][1]), sc[qs][2]);
#pragma unroll
        for (int r = 3; r < 15; r += 2) mx = fmaxf(fmaxf(mx, sc[qs][r]), sc[qs][r + 1]);
        mx = fmaxf(mx, sc[qs][15]);
        mx = fmaxf(mx, __shfl_xor(mx, 32));
        if (__builtin_amdgcn_ballot_w64(mx > mrun[qs] + 8.f) != 0ull) {
          const float mnew = fmaxf(mrun[qs], mx);
          const float alpha = __builtin_amdgcn_exp2f(mrun[qs] - mnew);
          mrun[qs] = mnew;
          lrun[qs] *= alpha;
#pragma unroll
          for (int r = 0; r < 16; ++r) { ot[qs][0][r] *= alpha; ot[qs][1][r] *= alpha; }
        }
        const float mref = mrun[qs];
        sc[qs] = sc[qs] - mref;
#pragma unroll
        for (int r = 0; r < 16; ++r) sc[qs][r] = __builtin_amdgcn_exp2f(sc[qs][r]);
        typedef float f32x8_ __attribute__((ext_vector_type(8)));
        typedef float f32x2s_ __attribute__((ext_vector_type(2)));
        const f32x8_ h8 = __builtin_shufflevector(sc[qs], sc[qs], 0, 1, 2, 3, 4, 5, 6, 7) + __builtin_shufflevector(sc[qs], sc[qs], 8, 9, 10, 11, 12, 13, 14, 15);
        const f32x4 h4 = __builtin_shufflevector(h8, h8, 0, 1, 2, 3) + __builtin_shufflevector(h8, h8, 4, 5, 6, 7);
        const f32x2s_ h2 = __builtin_shufflevector(h4, h4, 0, 1) + __builtin_shufflevector(h4, h4, 2, 3);
        float rsum = h2[0] + h2[1];
        rsum += __shfl_xor(rsum, 32);
        lrun[qs] += rsum;
      }
#pragma unroll
      for (int s = 0; s < 2; ++s) {
        bf16x8 pb[2];
#pragma unroll
        for (int qs = 0; qs < 2; ++qs)
          pb[qs] = mk8(pack2(sc[qs][8 * s + 0], sc[qs][8 * s + 1]), pack2(sc[qs][8 * s + 2], sc[qs][8 * s + 3]),
                       pack2(sc[qs][8 * s + 4], sc[qs][8 * s + 5]), pack2(sc[qs][8 * s + 6], sc[qs][8 * s + 7]));
#pragma unroll
        for (int dt = 0; dt < 2; ++dt) {
          const uint2 lo = *(const uint2*)(vsm + (32 * dt + c) * AVS + 16 * s);
          const uint2 hi = *(const uint2*)(vsm + (32 * dt + c) * AVS + 16 * s + 8);
          const bf16x8 va = mk8(lo.x, lo.y, hi.x, hi.y);
          ot[0][dt] = mfma32(va, pb[0], ot[0][dt]);
          ot[1][dt] = mfma32(va, pb[1], ot[1][dt]);
        }
      }
    }
    if (kt + 1 < nkt) {
      us* ksn = sm + (cur ^ 1) * ASTG; us* vsn = ksn + 64 * AKS;
      *(bf16x8*)(ksn + kr0 * AKS + kc0) = gk0;
      if (tid < 256) *(bf16x8*)(ksn + kr1 * AKS + kc1) = gk1;
      const u32x4_ q4 = __builtin_bit_cast(u32x4_, gv);
      *(uint2*)(vsn + vr * AVS + vc) = make_uint2(q4.x, q4.y);
      *(uint2*)(vsn + vr * AVS + vc + 4) = make_uint2(q4.z, q4.w);
    }
    lds_barrier();
  }
  float* xo = (float*)smraw + pr * 4096;
  float* xml = (float*)smraw + 16384 + pr * 256;
  if (sub == 1) {
#pragma unroll
    for (int qs = 0; qs < 2; ++qs) {
#pragma unroll
      for (int dt = 0; dt < 2; ++dt)
#pragma unroll
        for (int r = 0; r < 16; ++r) xo[((qs * 2 + dt) * 16 + r) * 64 + lane] = ot[qs][dt][r];
      xml[(qs * 2 + 0) * 64 + lane] = mrun[qs];
      xml[(qs * 2 + 1) * 64 + lane] = lrun[qs];
    }
  }
  lds_barrier();
  if (sub == 0) {
    const int b = bh >> 3, hd = bh & 7;
#pragma unroll
    for (int qs = 0; qs < 2; ++qs) {
      const float m2 = xml[(qs * 2 + 0) * 64 + lane], l2 = xml[(qs * 2 + 1) * 64 + lane];
      const float M = fmaxf(mrun[qs], m2);
      const float e1 = __builtin_amdgcn_exp2f(mrun[qs] - M), e2 = __builtin_amdgcn_exp2f(m2 - M);
      const float inv = 1.f / (lrun[qs] * e1 + l2 * e2);
      const float f1 = e1 * inv, f2 = e2 * inv;
      const size_t tk = (size_t)b * SEQ + q0 + pr * 64 + qs * 32 + c;
      const us* ga = p.projB + tk * LDB_ + hd * 64;
      us* zo = p.za + tk * 1024 + hd * 64;
#pragma unroll
      for (int dt = 0; dt < 2; ++dt) {
#pragma unroll
        for (int g = 0; g < 4; ++g) {
          const int d0 = 32 * dt + 8 * g + 4 * hh;
          const uint2 gg = *(const uint2*)(ga + d0);
          f32x4 v;
#pragma unroll
          for (int r = 0; r < 4; ++r) v[r] = ot[qs][dt][4 * g + r] * f1 + xo[((qs * 2 + dt) * 16 + 4 * g + r) * 64 + lane] * f2;
          v[0] *= bflo(gg.x); v[1] *= bfhi(gg.x); v[2] *= bflo(gg.y); v[3] *= bfhi(gg.y);
          *(uint2*)(zo + d0) = pack4(v);
        }
      }
    }
  }
  lds_barrier();
}

__device__ void phase4(const Params& p, unsigned char* smraw) {
  const int wid = tidx() >> 6;
#pragma nounroll
  for (int it = blockIdx.x; it < 256; it += gridDim.x) wkv_scan_block(p, it, smraw);
  const int G = gridDim.x;
#pragma nounroll
  for (int r = 0;; ++r) {
    const int pos = (r & 1) ? (G - 1 - (int)blockIdx.x) : (int)blockIdx.x;
    const int k = r * G + pos;
    if (r * G >= 1024) break;
    if (k < 1024) attn_item(p, k & 63, 15 - (k >> 6), smraw);
  }
}

__device__ void phase5(const Params& p) {
  const int lane = tidx() & 63, wid = tidx() >> 6, fr = lane & 15, fq = lane >> 4;
  for (int it = blockIdx.x * 8 + wid; it < 4096 * 4; it += gridDim.x * 8) {
    const int ch = it >> 2, tt = it & 3;
    const int bh = ch >> 6, cc = ch & 63, b = bh >> 3, hd = bh & 7;
    const us* y1 = p.Y1 + (size_t)ch * 4096;
    const us* hh = p.Hh + (size_t)ch * 4096;
    const us* y0 = p.Y0t + (size_t)ch * 4096;
    const size_t tk = (size_t)b * SEQ + cc * 64 + tt * 16 + fr;
    const int ci0 = hd * 64 + fq * 4;
    bf16x8 bq[2];
#pragma unroll
    for (int ks = 0; ks < 2; ++ks) bq[ks] = *(const bf16x8*)(y1 + (tt * 16 + fr) * 64 + ks * 32 + fq * 8);
    uint2 bvv[4], gbv[4];
    f32x4 y[4];
#pragma unroll
    for (int mt = 0; mt < 4; ++mt) {
      const uint2 yy = *(const uint2*)(y0 + (tt * 16 + fr) * 64 + mt * 16 + fq * 4);
      bvv[mt] = *(const uint2*)(p.bv + tk * 512 + ci0 + mt * 16);
      gbv[mt] = *(const uint2*)(p.projB + tk * LDB_ + 512 + ci0 + mt * 16);
      y[mt][0] = bflo(yy.x); y[mt][1] = bfhi(yy.x); y[mt][2] = bflo(yy.y); y[mt][3] = bfhi(yy.y);
#pragma unroll
      for (int ks = 0; ks < 2; ++ks) {
        const bf16x8 a = *(const bf16x8*)(hh + (mt * 16 + fr) * 64 + ks * 32 + fq * 8);
        y[mt] = mfma16(a, bq[ks], y[mt]);
      }
    }
    float s1 = 0.f;
#pragma unroll
    for (int mt = 0; mt < 4; ++mt) s1 += y[mt][0] + y[mt][1] + y[mt][2] + y[mt][3];
    s1 += __shfl_xor(s1, 16); s1 += __shfl_xor(s1, 32);
    const float mean = s1 * (1.f / 64.f);
    float s2 = 0.f;
#pragma unroll
    for (int mt = 0; mt < 4; ++mt)
#pragma unroll
      for (int r = 0; r < 4; ++r) { y[mt][r] -= mean; s2 += y[mt][r] * y[mt][r]; }
    s2 += __shfl_xor(s2, 16); s2 += __shfl_xor(s2, 32);
    const float rstd = rsqrtf(s2 * (1.f / 64.f) + 64e-5f);
#pragma unroll
    for (int mt = 0; mt < 4; ++mt) {
      const float4 gg = *(const float4*)(p.gn_g + ci0 + mt * 16), gb = *(const float4*)(p.gn_b + ci0 + mt * 16);
      f32x4 v;
      v[0] = (y[mt][0] * rstd * gg.x + gb.x + bflo(bvv[mt].x)) * bflo(gbv[mt].x);
      v[1] = (y[mt][1] * rstd * gg.y + gb.y + bfhi(bvv[mt].x)) * bfhi(gbv[mt].x);
      v[2] = (y[mt][2] * rstd * gg.z + gb.z + bflo(bvv[mt].y)) * bflo(gbv[mt].y);
      v[3] = (y[mt][3] * rstd * gg.w + gb.w + bfhi(bvv[mt].y)) * bfhi(gbv[mt].y);
      *(uint2*)(p.za + tk * 1024 + 512 + ci0 + mt * 16) = pack4(v);
    }
  }
}

DEVI void unpack8(uint4 g, float (&o)[8]) {
  o[0] = bflo(g.x); o[1] = bfhi(g.x); o[2] = bflo(g.y); o[3] = bfhi(g.y);
  o[4] = bflo(g.z); o[5] = bfhi(g.z); o[6] = bflo(g.w); o[7] = bfhi(g.w);
}
struct EpiMerge {
  static constexpr bool PERM = true, AFTER_DRAIN = false; static constexpr int MID_T = 8;
  const us* projB; us* merged;
  DEVI void mid(f32x4 (&acc)[2][2][4][2], const pg8::Unit& u, int wr, int wc, int fr, int fq) const {
    const int row0 = u.pm * 256 + wr * 64 + fr, col0 = u.pn * 256 + wc * 32 + 8 * fq;
    const us* gbase = projB + (size_t)row0 * LDB_ + 1024 + col0;
#pragma unroll
    for (int ai = 0; ai < 2; ++ai) {
#pragma unroll
      for (int m = 0; m < 4; ++m) {
#pragma unroll
        for (int bj = 0; bj < 2; ++bj) {
          const us* gp = gbase + (size_t)(ai * 128 + m * 16) * LDB_ + bj * 128;
          float ga[8], gb[8];
          unpack8(*(const uint4*)gp, ga);
          unpack8(*(const uint4*)(gp + 1024), gb);
#pragma unroll
          for (int e = 0; e < 4; ++e) {
            acc[ai][bj][m][0][e] *= ga[e] * __builtin_amdgcn_rcpf(gb[e]);
            acc[ai][bj][m][1][e] *= ga[4 + e] * __builtin_amdgcn_rcpf(gb[4 + e]);
          }
        }
      }
    }
  }
  DEVI void operator()(const f32x4 (&acc)[2][2][4][2], const pg8::Unit& u, int wr, int wc, int fr, int fq) const {
    const int row0 = u.pm * 256 + wr * 64 + fr, col0 = u.pn * 256 + wc * 32 + 8 * fq;
#pragma unroll
    for (int ai = 0; ai < 2; ++ai)
#pragma unroll
      for (int m = 0; m < 4; ++m) {
        const size_t row = row0 + ai * 128 + m * 16;
#pragma unroll
        for (int bj = 0; bj < 2; ++bj) {
          const int c = col0 + bj * 128;
          float gb[8];
          unpack8(*(const uint4*)(projB + row * LDB_ + 2048 + c), gb);
          const f32x4 v0 = acc[ai][bj][m][0], v1 = acc[ai][bj][m][1];
          uint4 q;
          q.x = pack2(v0[0] * gb[0], v0[1] * gb[1]); q.y = pack2(v0[2] * gb[2], v0[3] * gb[3]);
          q.z = pack2(v1[0] * gb[4], v1[1] * gb[5]); q.w = pack2(v1[2] * gb[6], v1[3] * gb[7]);
          *(uint4*)(merged + row * 1024 + c) = q;
        }
      }
  }
};
__device__ void phase6(const Params& p, unsigned char* smraw) {
  pg8::Gemm g{p.za, p.Wt_pa, T_TOK, 1024, 1024};
  pg8::StaticOrder S; S.init(g.M, g.N, (int)gridDim.x, (int)blockIdx.x);
  EpiMerge E{p.projB, p.merged};
  pg8::gemm_phase<EpiMerge, pg8::StaticOrder, false>((PG8_LAS unsigned char*)smraw, g, S, E, nullptr);
}

struct EpiSub {
  static constexpr bool PERM = true, AFTER_DRAIN = false; static constexpr int MID_T = 0;
  us* sub;
  DEVI void operator()(const f32x4 (&acc)[2][2][4][2], const pg8::Unit& u, int wr, int wc, int fr, int fq) const {
    const int row0 = u.pm * 256 + wr * 64 + fr, col0 = u.pn * 256 + wc * 32 + 8 * fq;
#pragma unroll
    for (int ai = 0; ai < 2; ++ai)
#pragma unroll
      for (int m = 0; m < 4; ++m) {
        const size_t row = row0 + ai * 128 + m * 16;
#pragma unroll
        for (int bj = 0; bj < 2; ++bj) {
          const f32x4 v0 = acc[ai][bj][m][0], v1 = acc[ai][bj][m][1];
          uint4 q; q.x = pack2(v0[0], v0[1]); q.y = pack2(v0[2], v0[3]); q.z = pack2(v1[0], v1[1]); q.w = pack2(v1[2], v1[3]);
          *(uint4*)(sub + row * 1024 + col0 + bj * 128) = q;
        }
      }
  }
};
__device__ void phase7(const Params& p, unsigned char* smraw) {
  pg8::Gemm g{p.merged, p.Wt_out, T_TOK, 1024, 1024};
  pg8::StaticOrder S; S.init(g.M, g.N, (int)gridDim.x, (int)blockIdx.x);
  EpiSub E{p.sub};
  pg8::gemm_phase<EpiSub, pg8::StaticOrder, false>((PG8_LAS unsigned char*)smraw, g, S, E, nullptr);
}

__device__ void phase8(const Params& p) {
  const int lane = tidx() & 63, wid = tidx() >> 6;
  for (int row0 = (blockIdx.x * 8 + wid) * 2; row0 < T_TOK; row0 += gridDim.x * 16) {
    const float* gate = p.mod + (row0 >> 12) * 3072 + 2048;
    float4 z[2][4];
#pragma unroll
    for (int r = 0; r < 2; ++r) {
      const float4* xr = (const float4*)(p.x + (size_t)(row0 + r) * DM);
      const uint2* sr = (const uint2*)(p.sub + (size_t)(row0 + r) * DM);
#pragma unroll
      for (int i = 0; i < 4; ++i) {
        const int c4 = i * 64 + lane;
        const float4 xv = xr[c4];
        const uint2 sv = sr[c4];
        const float4 g = ((const float4*)gate)[c4];
        z[r][i].x = ALPHA_ * xv.x + (1.f + g.x) * bflo(sv.x);
        z[r][i].y = ALPHA_ * xv.y + (1.f + g.y) * bfhi(sv.x);
        z[r][i].z = ALPHA_ * xv.z + (1.f + g.z) * bflo(sv.y);
        z[r][i].w = ALPHA_ * xv.w + (1.f + g.w) * bfhi(sv.y);
      }
    }
#pragma unroll
    for (int r = 0; r < 2; ++r) {
      float s = 0.f;
#pragma unroll
      for (int i = 0; i < 4; ++i) s += z[r][i].x + z[r][i].y + z[r][i].z + z[r][i].w;
#pragma unroll
      for (int o = 32; o; o >>= 1) s += __shfl_xor(s, o);
      const float mean = s * (1.f / 1024.f);
      float q = 0.f;
#pragma unroll
      for (int i = 0; i < 4; ++i) {
        z[r][i].x -= mean; z[r][i].y -= mean; z[r][i].z -= mean; z[r][i].w -= mean;
        q += z[r][i].x * z[r][i].x + z[r][i].y * z[r][i].y + z[r][i].z * z[r][i].z + z[r][i].w * z[r][i].w;
      }
#pragma unroll
      for (int o = 32; o; o >>= 1) q += __shfl_xor(q, o);
      const float rstd = rsqrtf(q * (1.f / 1024.f) + 1e-5f);
      float4* orow = (float4*)(p.out + (size_t)(row0 + r) * DM);
#pragma unroll
      for (int i = 0; i < 4; ++i) {
        const int c4 = i * 64 + lane;
        const float4 g = ((const float4*)p.post_g)[c4], bb = ((const float4*)p.post_b)[c4];
        float4 v;
        v.x = z[r][i].x * rstd * g.x + bb.x; v.y = z[r][i].y * rstd * g.y + bb.y;
        v.z = z[r][i].z * rstd * g.z + bb.z; v.w = z[r][i].w * rstd * g.w + bb.w;
        __builtin_nontemporal_store(f32x4{v.x, v.y, v.z, v.w}, (f32x4*)orow + c4);
      }
    }
  }
}

#define XB_TMO      128
#define XB_XCNT(j)  (256  + 64 * (j))
#define XB_XSUB(j)  (1280 + 64 * (j))
#define XB_XGEN(j)  (2304 + 64 * (j))
#define XB_TOP      3328
#define XB_TOPGEN   3392
#define XCD_BAR_WORDS 3456
#define XB_SPIN_CAP (1u << 18)
#define LAS __attribute__((address_space(3)))

__device__ __forceinline__ unsigned xb_ld(unsigned* p)              { return __hip_atomic_load(p, __ATOMIC_RELAXED, __HIP_MEMORY_SCOPE_AGENT); }
__device__ __forceinline__ unsigned xb_add(unsigned* p, unsigned v) { return __hip_atomic_fetch_add(p, v, __ATOMIC_RELAXED, __HIP_MEMORY_SCOPE_AGENT); }
__device__ __forceinline__ unsigned xb_xcc_id() { return (unsigned)__builtin_amdgcn_s_getreg((3 << 11) | 20) & 0xFu; }
#define XB_SPIN(cond, bar) do { unsigned _sp = 0; while (cond) { __builtin_amdgcn_s_sleep(1); \
    if ((++_sp & 255u) == 0u) { if (xb_ld(&(bar)[XB_TMO])) break; if (_sp > XB_SPIN_CAP) { atomicAdd(&(bar)[XB_TMO], 1u); break; } } } } while (0)

struct XcdBarrier {
    unsigned* bar; unsigned x;
    volatile LAS unsigned* st;
};

__device__ __forceinline__ XcdBarrier xcd_barrier_post(unsigned* bar, volatile LAS unsigned* st) {
    XcdBarrier b; b.bar = bar; b.x = xb_xcc_id(); b.st = st;
    if (threadIdx.x == 0) (void)xb_add(&bar[XB_XCNT(b.x)], 1u);
    return b;
}
__device__ __forceinline__ void xcd_barrier_complete(unsigned* bar, unsigned x, unsigned& nloc, unsigned& nx) {
    const unsigned G = gridDim.x * gridDim.y * gridDim.z;
    unsigned sum, cnt, mine, sp = 0u;
    for (;;) {
        sum = 0u; cnt = 0u; mine = 0u;
#pragma unroll
        for (unsigned j = 0; j < 16; ++j) { const unsigned c = xb_ld(&bar[XB_XCNT(j)]); sum += c; cnt += (c > 0u) ? 1u : 0u; mine = (j == x) ? c : mine; }
        if (sum == G) break;
        __builtin_amdgcn_s_sleep(1);
        if ((++sp & 255u) == 0u) { if (xb_ld(&bar[XB_TMO])) break; if (sp > XB_SPIN_CAP) { atomicAdd(&bar[XB_TMO], 1u); break; } }
    }
    nloc = mine > 0u ? mine : 1u; nx = cnt > 0u ? cnt : 1u;
}

__device__ __forceinline__ void xcd_barrier(const XcdBarrier& b) {
    asm volatile("s_waitcnt vmcnt(0)" ::: "memory");
    __syncthreads();
    if (threadIdx.x == 0) {
        unsigned* bar = b.bar;
        __builtin_amdgcn_s_waitcnt(0);
        unsigned nloc = b.st[0], nx = b.st[1];
        if (nloc == 0u) { xcd_barrier_complete(bar, b.x, nloc, nx); b.st[0] = nloc; b.st[1] = nx; }
        const unsigned old = xb_add(&bar[XB_XSUB(b.x)], 1u);
        const unsigned gen = old / nloc;
        if (old + 1u == (gen + 1u) * nloc) {
            __builtin_amdgcn_fence(__ATOMIC_RELEASE, "agent");
            asm volatile("s_waitcnt vmcnt(0)" ::: "memory");
            const unsigned og = xb_add(&bar[XB_TOP], 1u);
            const unsigned tg = og / nx;
            if (og + 1u == (tg + 1u) * nx) xb_add(&bar[XB_TOPGEN], 1u);
            else XB_SPIN(xb_ld(&bar[XB_TOPGEN]) == tg, bar);
            __builtin_amdgcn_fence(__ATOMIC_ACQUIRE, "agent");
            xb_add(&bar[XB_XGEN(b.x)], 1u);
            asm volatile("s_waitcnt vmcnt(0)" ::: "memory");
        } else {
            XB_SPIN(xb_ld(&bar[XB_XGEN(b.x)]) == gen, bar);
            __builtin_amdgcn_fence(__ATOMIC_ACQUIRE, "agent");
            asm volatile("s_waitcnt vmcnt(0)" ::: "memory");
        }
    }
    __syncthreads();
}


#ifdef ONE_LAUNCH
__global__ void __launch_bounds__(NTHR) fwd_kernel(Params p) {
  extern __shared__ __attribute__((aligned(16))) unsigned char smraw[];
  cg::grid_group grid = cg::this_grid();
  volatile LAS unsigned* xst = (volatile LAS unsigned*)(smraw + LDSB0);
  if (threadIdx.x == 0) { xst[0] = 0u; xst[1] = 0u; }
  __syncthreads();
  const XcdBarrier xb = xcd_barrier_post(p.bar, xst);
  if (p.bar == nullptr) grid.sync();
  phase0(p, smraw); xcd_barrier(xb);
  phase1(p); xcd_barrier(xb);
  phase2(p, smraw); xcd_barrier(xb);
  phase3q(p, smraw); phase3kv(p, smraw); phase3w(p, smraw); xcd_barrier(xb);
  phase4(p, smraw); xcd_barrier(xb);
  phase5(p); xcd_barrier(xb);
  phase6(p, smraw); xcd_barrier(xb);
  phase7(p, smraw); xcd_barrier(xb);
  phase8(p);
}
#else
#define PK(name, call) __global__ void __launch_bounds__(NTHR) name(Params p) { \
  extern __shared__ __attribute__((aligned(16))) unsigned char smraw[]; call; }
PK(k_p0, phase0(p, smraw)) PK(k_p1, phase1(p)) PK(k_p2, phase2(p, smraw)) PK(k_p3q, phase3q(p, smraw))
PK(k_p3kv, phase3kv(p, smraw)) PK(k_p3w, phase3w(p, smraw)) PK(k_p4, phase4(p, smraw)) PK(k_p5, phase5(p))
PK(k_p6, phase6(p, smraw)) PK(k_p7, phase7(p, smraw)) PK(k_p8, phase8(p))
#endif

extern "C" void kernel_launch(void* const* d_in, const int* in_sizes, int n_in, void* d_out, int out_size,
                              void* d_ws, size_t ws_size, hipStream_t stream) {
  static int grid_blocks = 0;
#ifdef ONE_LAUNCH
  if (!grid_blocks) {
    int dev = 0, cus = 0, per_cu = 0;
    (void)hipGetDevice(&dev);
    (void)hipDeviceGetAttribute(&cus, hipDeviceAttributeMultiprocessorCount, dev);
    (void)hipFuncSetAttribute((const void*)fwd_kernel, hipFuncAttributeMaxDynamicSharedMemorySize, LDSB);
    (void)hipOccupancyMaxActiveBlocksPerMultiprocessor(&per_cu, fwd_kernel, NTHR, LDSB);
    if (per_cu < 1) per_cu = 1;
    grid_blocks = cus * per_cu;
  }
#else
  if (!grid_blocks) {
    const void* ks[] = {(const void*)k_p0, (const void*)k_p1, (const void*)k_p2, (const void*)k_p3q, (const void*)k_p3kv,
                        (const void*)k_p3w, (const void*)k_p4, (const void*)k_p5, (const void*)k_p6, (const void*)k_p7,
                        (const void*)k_p8};
    for (int i = 0; i < 11; ++i) (void)hipFuncSetAttribute(ks[i], hipFuncAttributeMaxDynamicSharedMemorySize, LDSB);
    grid_blocks = 256;
  }
#endif
  Params p{};
  p.x = (const float*)d_in[0]; p.c = (const float*)d_in[1]; p.pos = (const int*)d_in[2];
  p.w_ada = (const float*)d_in[3]; p.b_ada = (const float*)d_in[4]; p.w_in = (const float*)d_in[5];
  p.q_norm_g = (const float*)d_in[6]; p.w_uq = (const float*)d_in[7]; p.kv_norm_g = (const float*)d_in[8];
  p.w_ukv = (const float*)d_in[9]; p.mu = (const float*)d_in[10]; p.w0 = (const float*)d_in[11];
  p.w_dec = (const float*)d_in[12]; p.a0 = (const float*)d_in[13]; p.w_icl = (const float*)d_in[14];
  p.k_k = (const float*)d_in[15]; p.k_a = (const float*)d_in[16]; p.r_k = (const float*)d_in[17];
  p.gn_g = (const float*)d_in[18]; p.gn_b = (const float*)d_in[19]; p.w_pa = (const float*)d_in[20];
  p.w_pb = (const float*)d_in[21]; p.w_out = (const float*)d_in[22]; p.post_g = (const float*)d_in[23];
  p.post_b = (const float*)d_in[24];
  p.out = (float*)d_out;
  unsigned char* ws = (unsigned char*)d_ws;
  size_t off = 0;
  auto take = [&](size_t bytes) { unsigned char* r = ws + off; off += (bytes + 255) & ~(size_t)255; return r; };
  const size_t MiB = 1u << 20;
  p.bar = (unsigned*)take(XCD_BAR_WORDS * 4);
  p.mod = (float*)take(8 * 3072 * 4);
  p.cs = (float*)take((size_t)T_TOK * 32 * 4);
  p.stats = (float*)take((size_t)T_TOK * 2 * 4);
  p.Gc = (float*)take(4096 * 64 * 4);
  p.Wt_in = (us*)take((size_t)5376 * 1024 * 2);
  p.Wt_uq = (us*)take(768 * 256 * 2);
  p.Wt_ukv = (us*)take(1024 * 128 * 2);
  p.Wt_dec = (us*)take(512 * 64 * 2);
  p.Wt_icl = (us*)take(512 * 64 * 2);
  p.Wt_pa = (us*)take(1024 * 1024 * 2);
  p.Wt_pb = p.Wt_pa;
  p.Wt_out = (us*)take(1024 * 1024 * 2);
  unsigned char* r1 = take(64 * MiB);
  unsigned char* r2 = take((size_t)T_TOK * LDA_ * 2);
  p.projB = (us*)take((size_t)T_TOK * LDB_ * 2);
  p.Y1 = (us*)take(32 * MiB);
  p.Y0t = (us*)take(32 * MiB);
  p.bv = (us*)take(32 * MiB);
  p.h = (us*)r1; p.Mp = (us*)r1; p.Nt = (us*)(r1 + 32 * MiB); p.merged = (us*)r1;
  p.projA = (us*)r2; p.sub = (us*)r2; p.Hh = (us*)r2; p.za = (us*)(r2 + 32 * MiB); p.zb = p.za;
  unsigned char* ob = (unsigned char*)d_out;
  p.Q = (us*)ob; p.K = (us*)(ob + 48 * MiB); p.Vt = (us*)(ob + 96 * MiB);
  if (off > ws_size) { fprintf(stderr, "workspace too small: need %zu have %zu\n", off, ws_size); return; }
#ifndef ONE_LAUNCH
  const dim3 g(grid_blocks), bdim(NTHR);
  k_p0<<<g, bdim, LDSB, stream>>>(p);
  k_p1<<<g, bdim, LDSB, stream>>>(p);
  k_p2<<<g, bdim, LDSB, stream>>>(p);
  k_p3q<<<g, bdim, LDSB, stream>>>(p);
  k_p3kv<<<g, bdim, LDSB, stream>>>(p);
  k_p3w<<<g, bdim, LDSB, stream>>>(p);
  k_p4<<<g, bdim, LDSB, stream>>>(p);
  k_p5<<<g, bdim, LDSB, stream>>>(p);
  k_p6<<<g, bdim, LDSB, stream>>>(p);
  k_p7<<<g, bdim, LDSB, stream>>>(p);
  k_p8<<<g, bdim, LDSB, stream>>>(p);
#else
  (void)hipMemsetAsync(p.bar, 0, XCD_BAR_WORDS * 4, stream);
  void* args[] = {&p};
  hipError_t e = hipLaunchCooperativeKernel((void*)fwd_kernel, dim3(grid_blocks), dim3(NTHR), args, LDSB, stream);
  if (e != hipSuccess) fprintf(stderr, "cooperative launch failed: %s (grid %d)\n", hipGetErrorString(e), grid_blocks);
#endif
}
```

```cpp
#include <hip/hip_runtime.h>
#include <hip/hip_cooperative_groups.h>
#include <cstdio>
#include <cstdint>
namespace cg = cooperative_groups;
#define ONE_LAUNCH 1

typedef unsigned short us;
typedef __attribute__((ext_vector_type(8))) short bf16x8;
typedef __attribute__((ext_vector_type(4))) float f32x4;
typedef __attribute__((ext_vector_type(16))) float f32x16;
typedef unsigned u32x2n_ __attribute__((ext_vector_type(2)));
#define DEVI __device__ __forceinline__

constexpr int T_TOK = 32768, SEQ = 4096, DM = 1024;
constexpr int LDA_ = 2080;
constexpr int LDB_ = 3072;
constexpr int NTHR = 512;
constexpr int LDSB0 = 16 * 9216 + 2048;
constexpr int LDSB = LDSB0 + 64;
constexpr float QSCALE = 0.10206207261596575f * 1.4426950408889634f;
constexpr float ALPHA_ = 1.189207115002721f;

struct Params {
  const float *x, *c; const int* pos;
  const float *w_ada, *b_ada, *w_in, *q_norm_g, *w_uq, *kv_norm_g, *w_ukv, *mu, *w0, *w_dec, *a0, *w_icl,
      *k_k, *k_a, *r_k, *gn_g, *gn_b, *w_pa, *w_pb, *w_out, *post_g, *post_b;
  float* out;
  float *mod, *cs, *stats, *Gc; unsigned* bar;
  us *Wt_in, *Wt_uq, *Wt_ukv, *Wt_dec, *Wt_icl, *Wt_pa, *Wt_pb, *Wt_out;
  us *h, *projA, *projB, *Q, *K, *Vt, *za, *zb, *bv, *Mp, *Nt, *Y1, *Y0t, *Hh, *merged, *sub;
};

DEVI int tidx() { int t = (int)threadIdx.x; asm volatile("" : "+v"(t)); return t; }
DEVI us f2bf(float f) { unsigned u = __float_as_uint(f); u += 0x7fffu + ((u >> 16) & 1u); return (us)(u >> 16); }
DEVI float bf2f(us h) { return __uint_as_float(((unsigned)h) << 16); }
typedef float f32x2_ __attribute__((ext_vector_type(2)));
typedef __bf16 bf16x2_ __attribute__((ext_vector_type(2)));
DEVI unsigned pack2(float a, float b) {
  f32x2_ v = {a, b};
  bf16x2_ r = __builtin_convertvector(v, bf16x2_);
  return *(unsigned*)&r;
}
DEVI uint2 pack4(f32x4 v) { uint2 r; r.x = pack2(v[0], v[1]); r.y = pack2(v[2], v[3]); return r; }
DEVI f32x4 mfma16(bf16x8 a, bf16x8 b, f32x4 c) { return __builtin_amdgcn_mfma_f32_16x16x32_bf16(a, b, c, 0, 0, 0); }
DEVI f32x16 mfma32(bf16x8 a, bf16x8 b, f32x16 c) { return __builtin_amdgcn_mfma_f32_32x32x16_bf16(a, b, c, 0, 0, 0); }
DEVI void lds_barrier() { asm volatile("s_waitcnt lgkmcnt(0)" ::: "memory"); __builtin_amdgcn_s_barrier(); asm volatile("" ::: "memory"); }
DEVI float sigmoidf_(float v) { return __builtin_amdgcn_rcpf(1.f + __builtin_amdgcn_exp2f(-1.4426950408889634f * v)); }
DEVI float siluf_(float v) { return v * __builtin_amdgcn_rcpf(1.f + __builtin_amdgcn_exp2f(-1.4426950408889634f * v)); }

DEVI void conv_job(const float* __restrict__ src, us* __restrict__ dst, int K, int N, int ld, int koff, const float* rs, float sc,
                   int gw, int nw, int lane) {
  const int ngrp = (N + 63) >> 6, noct = K >> 3;
  for (int wi = gw; wi < ngrp * noct; wi += nw) {
    const int nt = wi % ngrp, oc = wi / ngrp;
    const int n = nt * 64 + lane, k0 = oc * 8;
    if (n < N) {
      const float* sp = src + (size_t)k0 * N + n;
      const float v0 = sp[0], v1 = sp[(size_t)N], v2 = sp[(size_t)2 * N], v3 = sp[(size_t)3 * N];
      const float v4 = sp[(size_t)4 * N], v5 = sp[(size_t)5 * N], v6 = sp[(size_t)6 * N], v7 = sp[(size_t)7 * N];
      float4 ra = make_float4(sc, sc, sc, sc), rb = ra;
      if (rs) {
        const float4 a = *(const float4*)(rs + k0), b = *(const float4*)(rs + k0 + 4);
        ra = make_float4(a.x * sc, a.y * sc, a.z * sc, a.w * sc); rb = make_float4(b.x * sc, b.y * sc, b.z * sc, b.w * sc);
      }
      uint4 o;
      o.x = pack2(v0 * ra.x, v1 * ra.y); o.y = pack2(v2 * ra.z, v3 * ra.w);
      o.z = pack2(v4 * rb.x, v5 * rb.y); o.w = pack2(v6 * rb.z, v7 * rb.w);
      *(uint4*)(dst + (size_t)n * ld + koff + k0) = o;
    }
  }
}
__device__ void phase0(const Params& p, unsigned char* smraw) {
  float* smf = (float*)smraw;
  const int tid = tidx();
  for (int it = blockIdx.x; it < 48; it += gridDim.x) {
    {
      const int n0 = it * 64;
      for (int i = tid; i < 8192; i += NTHR) smf[i] = siluf_(p.c[i]);
      __syncthreads();
      const int nl = tid & 63, kg = tid >> 6;
      float acc[8];
#pragma unroll
      for (int b = 0; b < 8; ++b) acc[b] = 0.f;
      for (int k0 = kg * 128; k0 < kg * 128 + 128; k0 += 16) {
        float wv[16];
#pragma unroll
        for (int u = 0; u < 16; ++u) wv[u] = p.w_ada[(size_t)(k0 + u) * 3072 + n0 + nl];
#pragma unroll
        for (int u = 0; u < 16; ++u)
#pragma unroll
          for (int b = 0; b < 8; ++b) acc[b] += smf[b * 1024 + k0 + u] * wv[u];
      }
      float* red = smf + 8192;
#pragma unroll
      for (int b = 0; b < 8; ++b) red[(kg * 8 + b) * 64 + nl] = acc[b];
      __syncthreads();
      {
        const int b = tid >> 6;
        float s = p.b_ada[n0 + nl];
#pragma unroll
        for (int g = 0; g < 8; ++g) s += red[(g * 8 + b) * 64 + nl];
        p.mod[b * 3072 + n0 + nl] = s;
      }
      __syncthreads();
    }
  }
  {
    const int gw = blockIdx.x * 8 + (tid >> 6), nw = gridDim.x * 8;
    conv_job(p.w_in, p.Wt_in, 1024, 5152, 1024, 0, nullptr, 1.f, gw, nw, tid & 63);
    conv_job(p.w_uq, p.Wt_uq, 256, 768, 256, 0, p.q_norm_g, QSCALE, gw, nw, tid & 63);
    conv_job(p.w_ukv, p.Wt_ukv, 128, 1024, 128, 0, p.kv_norm_g, 1.f, gw, nw, tid & 63);
    conv_job(p.w_dec, p.Wt_dec, 64, 512, 64, 0, nullptr, 1.f, gw, nw, tid & 63);
    conv_job(p.w_icl, p.Wt_icl, 64, 512, 64, 0, nullptr, 1.f, gw, nw, tid & 63);
    conv_job(p.w_pa, p.Wt_pa, 512, 1024, 1024, 0, nullptr, 1.f, gw, nw, tid & 63);
    conv_job(p.w_pb, p.Wt_pa, 512, 1024, 1024, 512, nullptr, 1.f, gw, nw, tid & 63);
    conv_job(p.w_out, p.Wt_out, 1024, 1024, 1024, 0, nullptr, 1.f, gw, nw, tid & 63);
  }
  const int gt = blockIdx.x * NTHR + tid, gs = gridDim.x * NTHR;
  {
    const double inv = pow(10000.0, -(double)(gt & 15) / 16.0);
    for (int i = gt; i < T_TOK * 16; i += gs) {
      const int t = i >> 4, pi = i & 15;
      double ang = (double)p.pos[t] * inv;
      ang -= 6.283185307179586476925 * rint(ang * 0.15915494309189533577);
      float sv, cv;
      sincosf((float)ang, &sv, &cv);
      p.cs[t * 32 + pi] = cv;
      p.cs[t * 32 + 16 + pi] = sv;
    }
  }
  for (int i = gt; i < T_TOK * 2; i += gs) p.stats[i] = 0.f;
  unsigned* padz = (unsigned*)(p.Wt_in + (size_t)5152 * 1024);
  for (int i = gt; i < 224 * 512; i += gs) padz[i] = 0u;
}

__device__ void phase1(const Params& p) {
  const int lane = tidx() & 63, wid = tidx() >> 6;
  for (int row0 = (blockIdx.x * 8 + wid) * 4; row0 < T_TOK; row0 += gridDim.x * 32) {
    float4 v[4][4];
#pragma unroll
    for (int r = 0; r < 4; ++r) {
      const float4* xr = (const float4*)(p.x + (size_t)(row0 + r) * DM);
#pragma unroll
      for (int i = 0; i < 4; ++i) { const f32x4 t = __builtin_nontemporal_load((const f32x4*)xr + i * 64 + lane); v[r][i] = make_float4(t[0], t[1], t[2], t[3]); }
    }
    const float* md = p.mod + (row0 >> 12) * 3072;
#pragma unroll
    for (int r = 0; r < 4; ++r) {
      float s = 0.f;
#pragma unroll
      for (int i = 0; i < 4; ++i) s += v[r][i].x + v[r][i].y + v[r][i].z + v[r][i].w;
#pragma unroll
      for (int o = 32; o; o >>= 1) s += __shfl_xor(s, o);
      const float mean = s * (1.f / 1024.f);
      float q = 0.f;
#pragma unroll
      for (int i = 0; i < 4; ++i) {
        v[r][i].x -= mean; v[r][i].y -= mean; v[r][i].z -= mean; v[r][i].w -= mean;
        q += v[r][i].x * v[r][i].x + v[r][i].y * v[r][i].y + v[r][i].z * v[r][i].z + v[r][i].w * v[r][i].w;
      }
#pragma unroll
      for (int o = 32; o; o >>= 1) q += __shfl_xor(q, o);
      const float rstd = rsqrtf(q * (1.f / 1024.f) + 1e-5f);
#pragma unroll
      for (int i = 0; i < 4; ++i) {
        const int col = i * 256 + lane * 4;
        float4 sh = *(const float4*)(md + col), scl = *(const float4*)(md + 1024 + col);
        uint2 o;
        o.x = pack2(v[r][i].x * rstd * (1.f + scl.x) + sh.x, v[r][i].y * rstd * (1.f + scl.y) + sh.y);
        o.y = pack2(v[r][i].z * rstd * (1.f + scl.z) + sh.z, v[r][i].w * rstd * (1.f + scl.w) + sh.w);
        *(uint2*)(p.h + (size_t)(row0 + r) * DM + col) = o;
      }
    }
  }
}

constexpr int GST = 384 * 72;
template <bool SUMSQ = false, bool SWAPV = false>
DEVI void gemm_main(const us* __restrict__ X, int ldx, const us* __restrict__ Y, int ldy, int K, us* sm,
                    f32x4 (&acc)[4][4], float* rs_out = nullptr, float rs_scale = 0.f, float rs_eps = 0.f) {
  const int tid = tidx(), lane = tid & 63, wid = tid >> 6;
  const int wx = wid >> 2, wy = wid & 3, fr = lane & 15, fq = lane >> 4;
  const int sr = tid >> 3, sc = (tid & 7) * 8;
  bf16x8 gx[2], gy[4];
  float ssq[4] = {0.f, 0.f, 0.f, 0.f};
#define GM_ACCSQ() if (SUMSQ) { _Pragma("unroll") for (int i = 0; i < 4; ++i) { _Pragma("unroll") for (int e = 0; e < 8; ++e) { const float f = bf2f((us)gy[i][e]); ssq[i] += f * f; } } }
#pragma unroll
  for (int i = 0; i < 2; ++i) gx[i] = *(const bf16x8*)(X + (size_t)(sr + i * 64) * ldx + sc);
#pragma unroll
  for (int i = 0; i < 4; ++i) gy[i] = *(const bf16x8*)(Y + (size_t)(sr + i * 64) * ldy + sc);
#pragma unroll
  for (int i = 0; i < 2; ++i) *(bf16x8*)(sm + (sr + i * 64) * 72 + sc) = gx[i];
#pragma unroll
  for (int i = 0; i < 4; ++i) *(bf16x8*)(sm + (128 + sr + i * 64) * 72 + sc) = gy[i];
  GM_ACCSQ()
  lds_barrier();
  const int nk = K >> 6;
  for (int kt = 0; kt < nk; ++kt) {
    const int cur = kt & 1;
    if (kt + 1 < nk) {
      const int k0 = (kt + 1) * 64 + sc;
#pragma unroll
      for (int i = 0; i < 2; ++i) gx[i] = *(const bf16x8*)(X + (size_t)(sr + i * 64) * ldx + k0);
#pragma unroll
      for (int i = 0; i < 4; ++i) gy[i] = *(const bf16x8*)(Y + (size_t)(sr + i * 64) * ldy + k0);
    }
    const us* xs = sm + cur * GST;
    const us* ys = xs + 128 * 72;
#pragma unroll
    for (int ks = 0; ks < 2; ++ks) {
      bf16x8 a[4], b[4];
#pragma unroll
      for (int i = 0; i < 4; ++i) a[i] = *(const bf16x8*)(xs + (wx * 64 + i * 16 + fr) * 72 + ks * 32 + fq * 8);
#pragma unroll
      for (int j = 0; j < 4; ++j) b[j] = *(const bf16x8*)(ys + (wy * 64 + j * 16 + fr) * 72 + ks * 32 + fq * 8);
#pragma unroll
      for (int i = 0; i < 4; ++i)
#pragma unroll
        for (int j = 0; j < 4; ++j) {
          if (SWAPV && wx == 1) acc[i][j] = mfma16(b[j], a[i], acc[i][j]);
          else acc[i][j] = mfma16(a[i], b[j], acc[i][j]);
        }
    }
    if (kt + 1 < nk) {
      us* xn = sm + (cur ^ 1) * GST;
#pragma unroll
      for (int i = 0; i < 2; ++i) *(bf16x8*)(xn + (sr + i * 64) * 72 + sc) = gx[i];
#pragma unroll
      for (int i = 0; i < 4; ++i) *(bf16x8*)(xn + (128 + sr + i * 64) * 72 + sc) = gy[i];
      GM_ACCSQ()
    }
    lds_barrier();
  }
  if (SUMSQ) {
#pragma unroll
    for (int i = 0; i < 4; ++i) {
      float v = ssq[i];
      v += __shfl_xor(v, 1); v += __shfl_xor(v, 2); v += __shfl_xor(v, 4);
      if ((tid & 7) == 0) rs_out[sr + i * 64] = rsqrtf(v * rs_scale + rs_eps);
    }
    lds_barrier();
  }
#undef GM_ACCSQ
}
DEVI void zero_acc(f32x4 (&acc)[4][4]) {
#pragma unroll
  for (int i = 0; i < 4; ++i)
#pragma unroll
    for (int j = 0; j < 4; ++j) acc[i][j] = f32x4{0.f, 0.f, 0.f, 0.f};
}

namespace pg8 {
#define PG8_LAS __attribute__((address_space(3)))
typedef unsigned short bf16_t;
typedef short bf16x8 __attribute__((ext_vector_type(8)));
typedef float f32x4 __attribute__((ext_vector_type(4)));
typedef unsigned u32x4 __attribute__((ext_vector_type(4)));
constexpr int BM = 256, BK = 64, HALF = 128, HTB = HALF * BK * 2  , STAGE_BYTES = 8 * HTB, NXCD = 8, WGM = 8;

__host__ __device__ __forceinline__ int lds_byte(int r, int c) { const int st = (r >> 4) * 2 + (c >> 5), rr = r & 15, cc = c & 31, ob = rr * 64 + cc * 2; return st * 1024 + (ob ^ (((ob >> 9) & 1) << 5)); }
__host__ __device__ __forceinline__ void stage_rc(int b, int& R, int& C) { const int st = b / 1024, sb = b % 1024, swz = sb ^ (((sb >> 9) & 1) << 5); R = (st >> 1) * 16 + swz / 64; C = (st & 1) * 32 + (swz % 64) / 2; }
__host__ __device__ __forceinline__ int perm32(int rho) { const int n = rho >> 4, i = rho & 15; return 8 * (i >> 2) + 4 * n + (i & 3); }

struct Unit { int pm, pn; };
struct Gemm { const bf16_t* A; const bf16_t* Bt; int M, N, K; };

struct StaticOrder {
    int nM, nN, nwg, G, c;
    __host__ __device__ void init(int M, int N, int G_, int c_) { nM = M / BM; nN = N / BM; nwg = nM * nN; G = G_; c = c_; }
    __host__ __device__ bool next(int i, Unit& u) const {
        const long L = (long)i * G + c; if (L >= nwg) return false;
        int wgid = (int)L; { const int q = nwg / NXCD, r = nwg % NXCD, xcd = wgid % NXCD, off = wgid / NXCD; wgid = (xcd < r ? xcd * (q + 1) : r * (q + 1) + (xcd - r) * q) + off; }
        const int nig = WGM * nN, gid = wgid / nig, fm = gid * WGM, gsz = (nM - fm) < WGM ? (nM - fm) : WGM;
        u.pm = fm + ((wgid % nig) % gsz); u.pn = (wgid % nig) / gsz; return true;
    }
    __device__ __forceinline__ void a_ready(const Unit&) const {}
    __device__ __forceinline__ void done(const Unit&) const {}
};

template <class Epi, class Sched, bool STAMP = false>
__device__ __forceinline__ void gemm_phase(PG8_LAS unsigned char* lds, const Gemm g, const Sched& S, const Epi& E, unsigned long long* stamps) {
    const int tid = tidx(), wid = __builtin_amdgcn_readfirstlane(tid >> 6), lane = tid & 63, wr = wid >> 2, wc = wid & 3, fr = lane & 15, fq = lane >> 4;
    const int K = g.K, nt = K / BK;
    int ts_lo = 0, ts_hi = 0, nts = 0; const unsigned long long rt_entry = STAMP ? (unsigned long long)wall_clock64() : 0ull;
#define PG8_STAMP() do { if (STAMP && wid == 0 && nts < 64) { const unsigned long long _c = (unsigned long long)clock64(); \
        ts_lo = (lane == nts) ? (int)(unsigned)_c : ts_lo; ts_hi = (lane == nts) ? (int)(unsigned)(_c >> 32) : ts_hi; ++nts; } } while (0)
    unsigned voffA[2], voffB[2];
#pragma unroll
    for (int i = 0; i < 2; ++i) { int R, C; stage_rc(tid * 16 + i * 8192, R, C); const int Rb = Epi::PERM ? ((R & ~31) + perm32(R & 31)) : R;
        voffA[i] = (unsigned)(R * K + C) * 2u; voffB[i] = (unsigned)(Rb * K + C) * 2u; }
    const size_t kstep = (size_t)(BK * 2);
    const size_t hstep = (size_t)HALF * K * 2;
    const size_t tstep = 2 * hstep;
    const unsigned ldsw = (unsigned)wid * 1024u;
    const int aoff = lds_byte(wr * 64 + fr, fq * 8), boff = lds_byte(wc * 32 + fr, fq * 8);
#define PG8_SA(b, h) (((b) * 2 + (h)) * HTB)
#define PG8_SB(b, h) ((4 + (b) * 2 + (h)) * HTB)
#define PG8_STAGE(bufoff, gbase, voff) do { _Pragma("unroll") for (int _i = 0; _i < 2; ++_i) \
        __builtin_amdgcn_global_load_lds((const unsigned*)((const char*)(gbase) + (voff)[_i]), (PG8_LAS unsigned*)(lds + (bufoff) + ldsw + _i * 8192), 16, 0, 0); } while (0)
#define PG8_LDA(dst, b, h) do { _Pragma("unroll") for (int m = 0; m < 4; ++m) _Pragma("unroll") for (int k = 0; k < 2; ++k) dst[m][k] = *(const PG8_LAS bf16x8*)(lds + PG8_SA(b, h) + aoff + m * 2048 + k * 1024); } while (0)
#define PG8_LDB(dst, b, h) do { _Pragma("unroll") for (int n = 0; n < 2; ++n) _Pragma("unroll") for (int k = 0; k < 2; ++k) dst[n][k] = *(const PG8_LAS bf16x8*)(lds + PG8_SB(b, h) + boff + n * 2048 + k * 1024); } while (0)
#define PG8_MMA(ai, bj, At, Bt) do { __builtin_amdgcn_s_setprio(1); _Pragma("unroll") for (int m = 0; m < 4; ++m) _Pragma("unroll") for (int n = 0; n < 2; ++n) _Pragma("unroll") for (int k = 0; k < 2; ++k) \
        acc[ai][bj][m][n] = __builtin_amdgcn_mfma_f32_16x16x32_bf16(Bt[n][k], At[m][k], acc[ai][bj][m][n], 0, 0, 0); __builtin_amdgcn_s_setprio(0); } while (0)
#define PG8_WAIT_V(n) asm volatile("s_waitcnt vmcnt(" #n ")" ::: "memory")
#define PG8_WAIT_L(n) asm volatile("s_waitcnt lgkmcnt(" #n ")" ::: "memory")
#define PG8_BAR __builtin_amdgcn_s_barrier()
#define PG8_SCHED __builtin_amdgcn_sched_barrier(0)
    Unit cur, nxt; int ui = 0;
    if (!S.next(0, cur)) return;
    f32x4 acc[2][2][4][2];
#pragma unroll
    for (int a = 0; a < 2; ++a)
#pragma unroll
        for (int b = 0; b < 2; ++b)
#pragma unroll
            for (int m = 0; m < 4; ++m)
#pragma unroll
                for (int n = 0; n < 2; ++n) acc[a][b][m][n] = (f32x4){0.f, 0.f, 0.f, 0.f};
    bf16x8 At[4][2], B0[2][2], B1[2][2];
    const char* cA = (const char*)g.A + (size_t)cur.pm * tstep; const char* cB = (const char*)g.Bt + (size_t)cur.pn * tstep;
    S.a_ready(cur);
    PG8_STAGE(PG8_SB(0, 0), cB, voffB); PG8_STAGE(PG8_SA(0, 0), cA, voffA); PG8_STAGE(PG8_SB(0, 1), cB + hstep, voffB); PG8_STAGE(PG8_SA(0, 1), cA + hstep, voffA);
    if (wr == 1) PG8_BAR;
    PG8_WAIT_V(4); PG8_BAR;
    PG8_STAGE(PG8_SB(1, 0), cB + kstep, voffB); PG8_STAGE(PG8_SA(1, 0), cA + kstep, voffA); PG8_STAGE(PG8_SB(1, 1), cB + hstep + kstep, voffB);
    PG8_WAIT_V(6); PG8_BAR;
    for (;;) {
        const bool has_next = S.next(ui + 1, nxt);
        const char* nA = has_next ? (const char*)g.A + (size_t)nxt.pm * tstep : cA; const char* nB = has_next ? (const char*)g.Bt + (size_t)nxt.pn * tstep : cB;
        if constexpr (Epi::MID_T > 0) {
        for (int t = 0; t < Epi::MID_T; t += 2) {
            const bool last = (t == nt - 2);
            const char* a1 = cA + (size_t)(t + 1) * kstep;
            const char* a2 = last ? nA : cA + (size_t)(t + 2) * kstep; const char* b2 = last ? nB : cB + (size_t)(t + 2) * kstep;
            const char* a3 = a2 + kstep; const char* b3 = b2 + kstep;
            if (last && has_next) S.a_ready(nxt);
            PG8_LDB(B0, 0, 0); PG8_SCHED; PG8_LDA(At, 0, 0); PG8_STAGE(PG8_SA(1, 1), a1 + hstep, voffA);
            PG8_WAIT_L(8); PG8_BAR; PG8_WAIT_L(0); PG8_MMA(0, 0, At, B0); PG8_BAR; PG8_SCHED;
            PG8_LDB(B1, 0, 1); PG8_STAGE(PG8_SB(0, 0), b2, voffB);
            PG8_BAR; PG8_WAIT_L(0); PG8_MMA(0, 1, At, B1); PG8_BAR;
            PG8_LDA(At, 0, 1); PG8_STAGE(PG8_SA(0, 0), a2, voffA);
            PG8_BAR; PG8_WAIT_L(0); PG8_MMA(1, 0, At, B0); PG8_BAR; PG8_SCHED;
            PG8_STAGE(PG8_SB(0, 1), b2 + hstep, voffB);
            PG8_WAIT_V(6); PG8_BAR; PG8_MMA(1, 1, At, B1); PG8_BAR;
            PG8_LDB(B0, 1, 0); PG8_SCHED; PG8_LDA(At, 1, 0); PG8_STAGE(PG8_SA(0, 1), a2 + hstep, voffA);
            PG8_WAIT_L(8); PG8_BAR; PG8_WAIT_L(0); PG8_MMA(0, 0, At, B0); PG8_BAR; PG8_SCHED;
            PG8_LDB(B1, 1, 1); PG8_STAGE(PG8_SB(1, 0), b3, voffB);
            PG8_BAR; PG8_WAIT_L(0); PG8_MMA(0, 1, At, B1); PG8_BAR;
            PG8_LDA(At, 1, 1); PG8_STAGE(PG8_SA(1, 0), a3, voffA);
            PG8_BAR; PG8_WAIT_L(0); PG8_MMA(1, 0, At, B0); PG8_BAR; PG8_SCHED;
            PG8_STAGE(PG8_SB(1, 1), b3 + hstep, voffB);
            PG8_WAIT_V(6); PG8_BAR; PG8_MMA(1, 1, At, B1); PG8_BAR;
        }
        E.mid(acc, cur, wr, wc, fr, fq);
        for (int t = Epi::MID_T; t < nt; t += 2) {
            const bool last = (t == nt - 2);
            const char* a1 = cA + (size_t)(t + 1) * kstep;
            const char* a2 = last ? nA : cA + (size_t)(t + 2) * kstep; const char* b2 = last ? nB : cB + (size_t)(t + 2) * kstep;
            const char* a3 = a2 + kstep; const char* b3 = b2 + kstep;
            if (last && has_next) S.a_ready(nxt);
            PG8_LDB(B0, 0, 0); PG8_SCHED; PG8_LDA(At, 0, 0); PG8_STAGE(PG8_SA(1, 1), a1 + hstep, voffA);
            PG8_WAIT_L(8); PG8_BAR; PG8_WAIT_L(0); PG8_MMA(0, 0, At, B0); PG8_BAR; PG8_SCHED;
            PG8_LDB(B1, 0, 1); PG8_STAGE(PG8_SB(0, 0), b2, voffB);
            PG8_BAR; PG8_WAIT_L(0); PG8_MMA(0, 1, At, B1); PG8_BAR;
            PG8_LDA(At, 0, 1); PG8_STAGE(PG8_SA(0, 0), a2, voffA);
            PG8_BAR; PG8_WAIT_L(0); PG8_MMA(1, 0, At, B0); PG8_BAR; PG8_SCHED;
            PG8_STAGE(PG8_SB(0, 1), b2 + hstep, voffB);
            PG8_WAIT_V(6); PG8_BAR; PG8_MMA(1, 1, At, B1); PG8_BAR;
            PG8_LDB(B0, 1, 0); PG8_SCHED; PG8_LDA(At, 1, 0); PG8_STAGE(PG8_SA(0, 1), a2 + hstep, voffA);
            PG8_WAIT_L(8); PG8_BAR; PG8_WAIT_L(0); PG8_MMA(0, 0, At, B0); PG8_BAR; PG8_SCHED;
            PG8_LDB(B1, 1, 1); PG8_STAGE(PG8_SB(1, 0), b3, voffB);
            PG8_BAR; PG8_WAIT_L(0); PG8_MMA(0, 1, At, B1); PG8_BAR;
            PG8_LDA(At, 1, 1); PG8_STAGE(PG8_SA(1, 0), a3, voffA);
            PG8_BAR; PG8_WAIT_L(0); PG8_MMA(1, 0, At, B0); PG8_BAR; PG8_SCHED;
            PG8_STAGE(PG8_SB(1, 1), b3 + hstep, voffB);
            PG8_WAIT_V(6); PG8_BAR; PG8_MMA(1, 1, At, B1); PG8_BAR;
        }
        } else {
        for (int t = 0; t < nt; t += 2) {
            const bool last = (t == nt - 2);
            const char* a1 = cA + (size_t)(t + 1) * kstep;
            const char* a2 = last ? nA : cA + (size_t)(t + 2) * kstep; const char* b2 = last ? nB : cB + (size_t)(t + 2) * kstep;
            const char* a3 = a2 + kstep; const char* b3 = b2 + kstep;
            if (last && has_next) S.a_ready(nxt);
            PG8_LDB(B0, 0, 0); PG8_SCHED; PG8_LDA(At, 0, 0); PG8_STAGE(PG8_SA(1, 1), a1 + hstep, voffA);
            PG8_WAIT_L(8); PG8_BAR; PG8_WAIT_L(0); PG8_MMA(0, 0, At, B0); PG8_BAR; PG8_SCHED;
            PG8_LDB(B1, 0, 1); PG8_STAGE(PG8_SB(0, 0), b2, voffB);
            PG8_BAR; PG8_WAIT_L(0); PG8_MMA(0, 1, At, B1); PG8_BAR;
            PG8_LDA(At, 0, 1); PG8_STAGE(PG8_SA(0, 0), a2, voffA);
            PG8_BAR; PG8_WAIT_L(0); PG8_MMA(1, 0, At, B0); PG8_BAR; PG8_SCHED;
            PG8_STAGE(PG8_SB(0, 1), b2 + hstep, voffB);
            PG8_WAIT_V(6); PG8_BAR; PG8_MMA(1, 1, At, B1); PG8_BAR;
            PG8_LDB(B0, 1, 0); PG8_SCHED; PG8_LDA(At, 1, 0); PG8_STAGE(PG8_SA(0, 1), a2 + hstep, voffA);
            PG8_WAIT_L(8); PG8_BAR; PG8_WAIT_L(0); PG8_MMA(0, 0, At, B0); PG8_BAR; PG8_SCHED;
            PG8_LDB(B1, 1, 1); PG8_STAGE(PG8_SB(1, 0), b3, voffB);
            PG8_BAR; PG8_WAIT_L(0); PG8_MMA(0, 1, At, B1); PG8_BAR;
            PG8_LDA(At, 1, 1); PG8_STAGE(PG8_SA(1, 0), a3, voffA);
            PG8_BAR; PG8_WAIT_L(0); PG8_MMA(1, 0, At, B0); PG8_BAR; PG8_SCHED;
            PG8_STAGE(PG8_SB(1, 1), b3 + hstep, voffB);
            PG8_WAIT_V(6); PG8_BAR; PG8_MMA(1, 1, At, B1); PG8_BAR;
        }
        }
            if constexpr (!Epi::AFTER_DRAIN) { E(acc, cur, wr, wc, fr, fq); S.done(cur); }
            if (!has_next) break;
#pragma unroll
        for (int a = 0; a < 2; ++a)
#pragma unroll
            for (int b = 0; b < 2; ++b)
#pragma unroll
                for (int m = 0; m < 4; ++m)
#pragma unroll
                    for (int n = 0; n < 2; ++n) acc[a][b][m][n] = (f32x4){0.f, 0.f, 0.f, 0.f};
        cur = nxt; cA = nA; cB = nB; ++ui;
    }
    PG8_WAIT_V(0);
    if (wr == 0) PG8_BAR;
    PG8_BAR;
    if constexpr (Epi::AFTER_DRAIN) { E.fused(acc, cur, wr, wc, fr, fq, lds, wid, lane); S.done(cur); }
    if (STAMP && wid == 0) { stamps[lane] = lane < nts ? (((unsigned long long)(unsigned)ts_hi << 32) | (unsigned)ts_lo) : 0ull;
        if (lane == 62) stamps[62] = rt_entry; if (lane == 63) stamps[63] = (unsigned long long)wall_clock64(); }
#undef PG8_STAMP
#undef PG8_SA
#undef PG8_SB
#undef PG8_STAGE
#undef PG8_LDA
#undef PG8_LDB
#undef PG8_MMA
#undef PG8_WAIT_V
#undef PG8_WAIT_L
#undef PG8_BAR
#undef PG8_SCHED
}
}

typedef unsigned u32x4_ __attribute__((ext_vector_type(4)));
DEVI bf16x8 mk8(unsigned a, unsigned b, unsigned c, unsigned d) { u32x4_ v = {a, b, c, d}; return __builtin_bit_cast(bf16x8, v); }
DEVI float bflo(unsigned v) { return __uint_as_float(v << 16); }
DEVI float bfhi(unsigned v) { return __uint_as_float(v & 0xffff0000u); }
struct EpiProj {
  static constexpr bool PERM = true, AFTER_DRAIN = false; static constexpr int MID_T = 0;
  us *projA, *projB;
  DEVI void operator()(const f32x4 (&acc)[2][2][4][2], const pg8::Unit& u, int wr, int wc, int fr, int fq) const {
    const int row0 = u.pm * 256 + wr * 64 + fr;
#pragma unroll
    for (int bj = 0; bj < 2; ++bj) {
      const int nb = u.pn * 256 + bj * 128 + wc * 32;
      if (nb >= 5152) continue;
      us* dst; int ld, col, act;
      if (nb < 416) { dst = projA; ld = LDA_; col = nb; act = 0; }
      else if (nb < 928) { dst = projB; ld = LDB_; col = nb - 416; act = 1; }
      else if (nb < 2592) { dst = projA; ld = LDA_; col = nb - 928 + 416; act = 0; }
      else if (nb < 3104) { dst = projB; ld = LDB_; col = nb - 2592 + 512; act = 1; }
      else { dst = projB; ld = LDB_; col = nb - 3104 + 1024; act = 2; }
#pragma unroll
      for (int ai = 0; ai < 2; ++ai)
#pragma unroll
        for (int m = 0; m < 4; ++m) {
          f32x4 v0 = acc[ai][bj][m][0], v1 = acc[ai][bj][m][1];
          if (act == 1) {
#pragma unroll
            for (int r = 0; r < 4; ++r) { v0[r] = siluf_(v0[r]); v1[r] = siluf_(v1[r]); }
          } else if (act == 2) {
#pragma unroll
            for (int r = 0; r < 4; ++r) { v0[r] = sigmoidf_(v0[r]); v1[r] = sigmoidf_(v1[r]); }
          }
          uint4 o; o.x = pack2(v0[0], v0[1]); o.y = pack2(v0[2], v0[3]); o.z = pack2(v1[0], v1[1]); o.w = pack2(v1[2], v1[3]);
          __builtin_nontemporal_store(u32x4_{o.x, o.y, o.z, o.w}, (u32x4_*)(dst + (size_t)(row0 + ai * 128 + m * 16) * ld + col + 8 * fq));
        }
    }
  }
};
__device__ void phase2(const Params& p, unsigned char* smraw) {
  pg8::Gemm g{p.h, p.Wt_in, T_TOK, 5376, 1024};
  pg8::StaticOrder S; S.init(g.M, g.N, (int)gridDim.x, (int)blockIdx.x);
  EpiProj E{p.projA, p.projB};
  pg8::gemm_phase<EpiProj, pg8::StaticOrder, false>((PG8_LAS unsigned char*)smraw, g, S, E, nullptr);
}

#define REG_(i) ((us*)(smraw + (i) * 9216))
DEVI f32x4 mm_tile(const us* A, const us* B, int mt, int nt, int fr, int fq, f32x4 acc) {
#pragma unroll
  for (int ks = 0; ks < 2; ++ks) {
    bf16x8 a = *(const bf16x8*)(A + (mt * 16 + fr) * 72 + ks * 32 + fq * 8);
    bf16x8 b = *(const bf16x8*)(B + (nt * 16 + fr) * 72 + ks * 32 + fq * 8);
    acc = mfma16(a, b, acc);
  }
  return acc;
}
typedef short v4s_ __attribute__((ext_vector_type(4)));
DEVI bf16x8 frag_tr(const us* X, int r0, int ks, int lane) {
  const int grp = lane >> 4, i = lane & 15;
  const us* a0 = X + (ks * 32 + 8 * grp + (i >> 2)) * 72 + r0 + 4 * (i & 3);
  const v4s_ lo = __builtin_amdgcn_ds_read_tr16_b64_v4i16((__attribute__((address_space(3))) v4s_*)a0);
  const v4s_ hi = __builtin_amdgcn_ds_read_tr16_b64_v4i16((__attribute__((address_space(3))) v4s_*)(a0 + 4 * 72));
  return bf16x8{lo[0], lo[1], lo[2], lo[3], hi[0], hi[1], hi[2], hi[3]};
}
template <bool TA, bool TB>
DEVI f32x4 mm_tile_x(const us* A, const us* B, int mt, int nt, int lane, f32x4 acc) {
  const int fr = lane & 15, fq = lane >> 4;
#pragma unroll
  for (int ks = 0; ks < 2; ++ks) {
    const bf16x8 a = TA ? frag_tr(A, mt * 16, ks, lane) : *(const bf16x8*)(A + (mt * 16 + fr) * 72 + ks * 32 + fq * 8);
    const bf16x8 b = TB ? frag_tr(B, nt * 16, ks, lane) : *(const bf16x8*)(B + (nt * 16 + fr) * 72 + ks * 32 + fq * 8);
    acc = mfma16(a, b, acc);
  }
  return acc;
}
DEVI void storeT_nt(us* dst, int ld, int mt, int nt, int fr, int fq, f32x4 v) {
  const uint2 q = pack4(v);
  __builtin_nontemporal_store(u32x2n_{q.x, q.y}, (u32x2n_*)(dst + (nt * 16 + fr) * ld + mt * 16 + fq * 4));
}
DEVI void storeT(us* dst, int ld, int mt, int nt, int fr, int fq, f32x4 v) {
  *(uint2*)(dst + (nt * 16 + fr) * ld + mt * 16 + fq * 4) = pack4(v);
}
DEVI f32x4 maskv(f32x4 v, int mt, int nt, int fr, int fq, int mode) {
  const int n = nt * 16 + fr, m0 = mt * 16 + fq * 4;
#pragma unroll
  for (int r = 0; r < 4; ++r) {
    const int m = m0 + r;
    bool keep = (mode == 0) ? (m < n) : (mode == 1) ? (m <= n) : (n < m);
    if (!keep) v[r] = 0.f;
  }
  return v;
}
struct WkvRaw { bf16x8 cur[5], prv[5]; };
DEVI void wkv_load_raw(const Params& p, int item, WkvRaw& R) {
  const int tid = tidx();
  const int h = item & 7, bc = item >> 3, b = bc >> 6, c = bc & 63;
  const int t = tid >> 3, j0 = (tid & 7) * 8, jc = h * 64 + j0;
  const bool hp = (c * 64 + t) > 0;
  const us* rowp = p.projA + (size_t)(b * SEQ + c * 64 + t) * LDA_ + 416;
  const int offs[5] = {jc, 512 + jc, 1024 + jc, 1536 + j0, 1600 + j0};
#pragma unroll
  for (int q = 0; q < 5; ++q) {
    R.cur[q] = *(const bf16x8*)(rowp + offs[q]);
    R.prv[q] = hp ? *(const bf16x8*)(rowp + offs[q] - LDA_) : R.cur[q];
  }
}
DEVI void shift8(bf16x8 cur, bf16x8 prv, bool hasprev, const float* mu, float (&o)[8]) {
  const float4 m0 = *(const float4*)mu, m1 = *(const float4*)(mu + 4);
  const float mm[8] = {m0.x, m0.y, m0.z, m0.w, m1.x, m1.y, m1.z, m1.w};
#pragma unroll
  for (int e = 0; e < 8; ++e) {
    float cv = bf2f((us)cur[e]);
    float pv = hasprev ? bf2f((us)prv[e]) : 0.f;
    o[e] = cv + (pv - cv) * mm[e];
  }
}
DEVI void ld8f(const float* ptr, float (&o)[8]) {
  const float4 a = *(const float4*)ptr, b = *(const float4*)(ptr + 4);
  o[0] = a.x; o[1] = a.y; o[2] = a.z; o[3] = a.w; o[4] = b.x; o[5] = b.y; o[6] = b.z; o[7] = b.w;
}
DEVI float fast_tanh(float x) { const float e = __builtin_amdgcn_exp2f(2.8853900817779268f * x); return 1.f - 2.f * __builtin_amdgcn_rcpf(e + 1.f); }

__device__ void wkv_prep_item(const Params& p, int item, int next_item, WkvRaw& RW, unsigned char* smraw) {
  const int tid = tidx(), lane = tid & 63, w = tid >> 6, fr = lane & 15, fq = lane >> 4;
  const int h = item & 7, bc = item >> 3, b = bc >> 6, c = bc & 63;
  const int ch = (b * 8 + h) * 64 + c;
  const int tok0 = b * SEQ + c * 64;
  const int t = tid >> 3, j0 = (tid & 7) * 8, jc = h * 64 + j0;
  const f32x4 z4 = {0.f, 0.f, 0.f, 0.f};
  us *At = REG_(0), *Bt = REG_(1), *Kt = REG_(2), *Rt = REG_(3), *BhT = REG_(4), *KhT = REG_(5), *VT = REG_(6);
  us *P0 = REG_(7), *PT0 = REG_(8), *P1 = REG_(9), *PT1 = REG_(10), *Aak = REG_(11), *Arb = REG_(12), *Ark = REG_(13);
  us* UT = REG_(14);
  float* F = (float*)REG_(9);
  float* G = (float*)REG_(14);
  float* segsum = (float*)(smraw + 16 * 9216);

  float rr[8], kk_[8], vv[8], wd[8], ad[8];
  {
    const bool hp = (c * 64 + t) > 0;
    shift8(RW.cur[0], RW.prv[0], hp, p.mu + jc, rr);
    shift8(RW.cur[1], RW.prv[1], hp, p.mu + 512 + jc, kk_);
    shift8(RW.cur[2], RW.prv[2], hp, p.mu + 1024 + jc, vv);
    shift8(RW.cur[3], RW.prv[3], hp, p.mu + 1536 + j0, wd);
    shift8(RW.cur[4], RW.prv[4], hp, p.mu + 1600 + j0, ad);
  }
  {
    uint4 o1, o2;
    o1.x = pack2(fast_tanh(wd[0]), fast_tanh(wd[1])); o1.y = pack2(fast_tanh(wd[2]), fast_tanh(wd[3]));
    o1.z = pack2(fast_tanh(wd[4]), fast_tanh(wd[5])); o1.w = pack2(fast_tanh(wd[6]), fast_tanh(wd[7]));
    o2.x = pack2(ad[0], ad[1]); o2.y = pack2(ad[2], ad[3]); o2.z = pack2(ad[4], ad[5]); o2.w = pack2(ad[6], ad[7]);
    *(uint4*)(P0 + t * 72 + j0) = o1;
    *(uint4*)(PT0 + t * 72 + j0) = o2;
  }
  lds_barrier();
  {
    const int which = w >> 2, tt = w & 3;
    const us* A = which ? PT0 : P0;
    const us* Wt = (which ? p.Wt_icl : p.Wt_dec) + (size_t)h * 64 * 64;
    float* Fw = F + which * 4160;
#pragma unroll
    for (int jt = 0; jt < 4; ++jt) {
      f32x4 acc = z4;
#pragma unroll
      for (int ks = 0; ks < 2; ++ks) {
        bf16x8 a = *(const bf16x8*)(A + (tt * 16 + fr) * 72 + ks * 32 + fq * 8);
        bf16x8 bq = *(const bf16x8*)(Wt + (jt * 16 + fr) * 64 + ks * 32 + fq * 8);
        acc = mfma16(a, bq, acc);
      }
#pragma unroll
      for (int r = 0; r < 4; ++r) Fw[(tt * 16 + fq * 4 + r) * 65 + jt * 16 + fr] = acc[r];
    }
  }
  lds_barrier();
  float lw[8], av[8], kn[8], kp[8];
  {
    float ss = 0.f;
    float pw0[8], pa0[8], pkk[8], pka[8];
    ld8f(p.w0 + jc, pw0); ld8f(p.a0 + jc, pa0); ld8f(p.k_k + jc, pkk); ld8f(p.k_a + jc, pka);
#pragma unroll
    for (int e = 0; e < 8; ++e) {
      float dl = pw0[e] + F[t * 65 + j0 + e];
      float al = pa0[e] + F[4160 + t * 65 + j0 + e];
      float xneg = -dl;
      float sp = fmaxf(xneg, 0.f) + __logf(1.f + __expf(-fabsf(xneg)));
      float wl = -sp - 0.5f;
      lw[e] = -__expf(wl);
      av[e] = sigmoidf_(al);
      float kq = kk_[e] * pkk[e];
      kn[e] = kq;
      ss += kq * kq;
      kp[e] = kk_[e] * (1.f + (av[e] - 1.f) * pka[e]);
    }
    ss += __shfl_xor(ss, 1); ss += __shfl_xor(ss, 2); ss += __shfl_xor(ss, 4);
    const float inv = 1.f / fmaxf(sqrtf(ss), 1e-12f);
    float bon = 0.f;
    float prk[8];
    ld8f(p.r_k + jc, prk);
#pragma unroll
    for (int e = 0; e < 8; ++e) {
      kn[e] *= inv;
      bon += rr[e] * kp[e] * prk[e];
    }
    bon += __shfl_xor(bon, 1); bon += __shfl_xor(bon, 2); bon += __shfl_xor(bon, 4);
    uint4 o;
    o.x = pack2(bon * vv[0], bon * vv[1]); o.y = pack2(bon * vv[2], bon * vv[3]);
    o.z = pack2(bon * vv[4], bon * vv[5]); o.w = pack2(bon * vv[6], bon * vv[7]);
    __builtin_nontemporal_store(u32x4_{o.x, o.y, o.z, o.w}, (u32x4_*)(p.bv + (size_t)(tok0 + t) * 512 + jc));
  }
  lds_barrier();
#pragma unroll
  for (int e = 0; e < 8; ++e) G[t * 65 + j0 + e] = lw[e];
  lds_barrier();
  {
    const int j = tid & 63, seg = tid >> 6;
    float run = 0.f;
#pragma unroll
    for (int i = 0; i < 8; ++i) { run += G[(seg * 8 + i) * 65 + j]; G[(seg * 8 + i) * 65 + j] = run; }
    segsum[seg * 64 + j] = run;
    lds_barrier();
    float off = 0.f;
    for (int s2 = 0; s2 < seg; ++s2) off += segsum[s2 * 64 + j];
#pragma unroll
    for (int i = 0; i < 8; ++i) G[(seg * 8 + i) * 65 + j] += off;
  }
  lds_barrier();
  {
    float ta[8], tb[8], tk[8], tr[8], tbh[8], tkh[8];
#pragma unroll
    for (int e = 0; e < 8; ++e) {
      const float g = G[t * 65 + j0 + e], gC = G[63 * 65 + j0 + e];
      const float eg = __expf(g), eng = __expf(-g), egx = __expf(g - lw[e]), egc = __expf(gC - g);
      ta[e] = -kn[e] * egx;
      tb[e] = kn[e] * av[e] * eng;
      tk[e] = kp[e] * eng;
      tr[e] = rr[e] * eg;
      tbh[e] = kn[e] * av[e] * egc;
      tkh[e] = kp[e] * egc;
      if (t == 0) p.Gc[ch * 64 + j0 + e] = __expf(gC);
    }
    uint4 o;
    o.x = pack2(ta[0], ta[1]); o.y = pack2(ta[2], ta[3]); o.z = pack2(ta[4], ta[5]); o.w = pack2(ta[6], ta[7]);
    *(uint4*)(At + t * 72 + j0) = o;
    o.x = pack2(tb[0], tb[1]); o.y = pack2(tb[2], tb[3]); o.z = pack2(tb[4], tb[5]); o.w = pack2(tb[6], tb[7]);
    *(uint4*)(Bt + t * 72 + j0) = o;
    o.x = pack2(tk[0], tk[1]); o.y = pack2(tk[2], tk[3]); o.z = pack2(tk[4], tk[5]); o.w = pack2(tk[6], tk[7]);
    *(uint4*)(Kt + t * 72 + j0) = o;
    o.x = pack2(tr[0], tr[1]); o.y = pack2(tr[2], tr[3]); o.z = pack2(tr[4], tr[5]); o.w = pack2(tr[6], tr[7]);
    *(uint4*)(Rt + t * 72 + j0) = o;
    o.x = pack2(tbh[0], tbh[1]); o.y = pack2(tbh[2], tbh[3]); o.z = pack2(tbh[4], tbh[5]); o.w = pack2(tbh[6], tbh[7]);
    *(uint4*)(BhT + t * 72 + j0) = o;
    o.x = pack2(tkh[0], tkh[1]); o.y = pack2(tkh[2], tkh[3]); o.z = pack2(tkh[4], tkh[5]); o.w = pack2(tkh[6], tkh[7]);
    *(uint4*)(KhT + t * 72 + j0) = o;
    o.x = pack2(vv[0], vv[1]); o.y = pack2(vv[2], vv[3]); o.z = pack2(vv[4], vv[5]); o.w = pack2(vv[6], vv[7]);
    *(uint4*)(VT + t * 72 + j0) = o;
  }
  lds_barrier();
#pragma unroll
  for (int q = 0; q < 2; ++q) {
    const int id = w * 2 + q, mt = id >> 2, nt = id & 3;
    storeT(P0, 72, mt, nt, fr, fq, maskv(mm_tile(Bt, At, mt, nt, fr, fq, z4), mt, nt, fr, fq, 0));
  }
  lds_barrier();
  us* Tb = PT0;
  us* UTw = UT + w * 16 * 72;
  if (w == 0) {
    const int blk = lane >> 4, cc = lane & 15;
    float Tc[16];
#pragma unroll
    for (int r = 0; r < 16; ++r) Tc[r] = 0.f;
#pragma unroll
    for (int r = 0; r < 16; ++r) {
      float v = (r == cc) ? 1.f : 0.f;
      if (r > 0) {
        const us* arow = P0 + (blk * 16 + r) * 72 + blk * 16;
        const uint4 lo = *(const uint4*)arow;
        const uint4 hi = *(const uint4*)(arow + 8);
        const unsigned wv[8] = {lo.x, lo.y, lo.z, lo.w, hi.x, hi.y, hi.z, hi.w};
#pragma unroll
        for (int s2 = 0; s2 < r; ++s2) v += ((s2 & 1) ? bfhi(wv[s2 >> 1]) : bflo(wv[s2 >> 1])) * Tc[s2];
      }
      Tc[r] = v;
    }
#pragma unroll
    for (int r = 0; r < 16; ++r) Tb[blk * 256 + r * 16 + cc] = f2bf(Tc[r]);
  } else {
    for (int L = w - 1; L < 48; L += 7) {
      const int which = L >> 4, id = L & 15, mt = id >> 2, nt = id & 3;
      if (which == 0) storeT(Aak, 72, mt, nt, fr, fq, maskv(mm_tile(Kt, At, mt, nt, fr, fq, z4), mt, nt, fr, fq, 0));
      else if (which == 1) storeT(Arb, 72, mt, nt, fr, fq, maskv(mm_tile(Bt, Rt, mt, nt, fr, fq, z4), mt, nt, fr, fq, 1));
      else storeT(Ark, 72, mt, nt, fr, fq, maskv(mm_tile(Kt, Rt, mt, nt, fr, fq, z4), mt, nt, fr, fq, 1));
    }
  }
  {
    const uint4 zz = make_uint4(0u, 0u, 0u, 0u);
    *(uint4*)(UTw + (lane >> 2) * 72 + (lane & 3) * 16) = zz;
    *(uint4*)(UTw + (lane >> 2) * 72 + (lane & 3) * 16 + 8) = zz;
  }
  lds_barrier();
  if (next_item < 4096) wkv_load_raw(p, next_item, RW);
  {
    f32x4 zI[4];
    if (w >= 4) {
#pragma unroll
      for (int I = 0; I < 4; ++I) zI[I] = mm_tile_x<false, true>(Aak, VT, I, w - 4, lane, z4);
    } else {
#pragma unroll
      for (int I = 0; I < 4; ++I)
#pragma unroll
        for (int r = 0; r < 4; ++r) zI[I][r] = bf2f(At[(I * 16 + fq * 4 + r) * 72 + w * 16 + fr]);
    }
#pragma unroll
    for (int I = 0; I < 4; ++I) {
      f32x4 rhs = zI[I];
      if (I >= 1) {
#pragma unroll
        for (int ks = 0; ks < (I == 3 ? 2 : 1); ++ks) {
          const bf16x8 a = *(const bf16x8*)(P0 + (I * 16 + fr) * 72 + ks * 32 + fq * 8);
          const bf16x8 b = *(const bf16x8*)(UTw + fr * 72 + ks * 32 + fq * 8);
          rhs = mfma16(a, b, rhs);
        }
      }
      const uint2 tq = *(const uint2*)(Tb + I * 256 + fr * 16 + fq * 4);
      const uint2 rq = pack4(rhs);
      const f32x4 uI = mfma16(mk8(tq.x, tq.y, 0u, 0u), mk8(rq.x, rq.y, 0u, 0u), z4);
      *(uint2*)(UTw + fr * 72 + I * 16 + fq * 4) = pack4(uI);
    }
  }
  lds_barrier();
  {
    const int o = w >> 1;
    const us* U1 = UT;
    const us* U0 = UT + 64 * 72;
    for (int q = 0; q < 8; ++q) {
      const int id = (w & 1) * 8 + q, mt = id >> 2, nt = id & 3;
      if (o == 0) {
        f32x4 cc = mm_tile_x<false, true>(U1, BhT, mt, nt, lane, z4);
        storeT_nt(p.Mp + (size_t)ch * 4096, 64, mt, nt, fr, fq, cc);
      } else if (o == 1) {
        f32x4 cc = mm_tile_x<true, false>(BhT, U0, mt, nt, lane, z4);
        cc = mm_tile_x<true, true>(KhT, VT, mt, nt, lane, cc);
        storeT_nt(p.Nt + (size_t)ch * 4096, 64, mt, nt, fr, fq, cc);
      } else if (o == 2) {
        f32x4 cc = mm_tile(U1, Arb, mt, nt, fr, fq, z4);
#pragma unroll
        for (int r = 0; r < 4; ++r) cc[r] += bf2f(Rt[(nt * 16 + fr) * 72 + mt * 16 + fq * 4 + r]);
        storeT_nt(p.Y1 + (size_t)ch * 4096, 64, mt, nt, fr, fq, cc);
      } else {
        f32x4 cc = mm_tile(U0, Arb, mt, nt, fr, fq, z4);
        cc = mm_tile_x<true, false>(VT, Ark, mt, nt, lane, cc);
        storeT_nt(p.Y0t + (size_t)ch * 4096, 64, mt, nt, fr, fq, cc);
      }
    }
  }
  lds_barrier();
}

#define P3_COMMON \
  us* sm = (us*)smraw; \
  float* rs = (float*)(smraw + 2 * GST * 2); \
  const int tid = tidx(), lane = tid & 63, wid = tid >> 6; \
  const int wx = wid >> 2, wy = wid & 3, fr = lane & 15, fq = lane >> 4;
__device__ void phase3q(const Params& p, unsigned char* smraw) {
  P3_COMMON
  for (int it = blockIdx.x; it < 6 * 128; it += gridDim.x) {
    {
      const int yt = it / 6, xt = it % 6, x0 = xt * 128, y0 = yt * 256;
      f32x4 acc[4][4];
      zero_acc(acc);
      gemm_main<true>(p.Wt_uq + (size_t)x0 * 256, 256, p.projA + (size_t)y0 * LDA_, LDA_, 256, sm, acc, rs, 1.f / 256.f, 1e-6f);
#pragma unroll
      for (int j = 0; j < 4; ++j) {
        const int tl = wy * 64 + j * 16 + fr, tk = y0 + tl;
        const float rstd = rs[tl];
        const int bb = tk >> 12, s = tk & 4095;
#pragma unroll
        for (int i = 0; i < 4; ++i) {
          const int nb = x0 + wx * 64 + i * 16;
          const int hd = nb / 96, dq = nb % 96;
          us* qrow = p.Q + ((size_t)(bb * 8 + hd) * SEQ + s) * 96;
          if (dq < 64) {
            f32x4 v = acc[i][j] * rstd;
            *(uint2*)(qrow + dq + fq * 4) = pack4(v);
          } else if (dq == 64) {
            if (i < 3) {
              f32x4 t1 = acc[i][j] * rstd, t2 = acc[(i + 1) & 3][j] * rstd, o1, o2;
              const float4 cv = *(const float4*)(p.cs + (size_t)tk * 32 + fq * 4);
              const float4 sv = *(const float4*)(p.cs + (size_t)tk * 32 + 16 + fq * 4);
              o1[0] = t1[0] * cv.x - t2[0] * sv.x; o2[0] = t1[0] * sv.x + t2[0] * cv.x;
              o1[1] = t1[1] * cv.y - t2[1] * sv.y; o2[1] = t1[1] * sv.y + t2[1] * cv.y;
              o1[2] = t1[2] * cv.z - t2[2] * sv.z; o2[2] = t1[2] * sv.z + t2[2] * cv.z;
              o1[3] = t1[3] * cv.w - t2[3] * sv.w; o2[3] = t1[3] * sv.w + t2[3] * cv.w;
              *(uint2*)(qrow + 64 + fq * 4) = pack4(o1);
              *(uint2*)(qrow + 80 + fq * 4) = pack4(o2);
            }
          }
        }
      }
      lds_barrier();
    }
  }
}
__device__ void phase3kv(const Params& p, unsigned char* smraw) {
  P3_COMMON
  for (int it = blockIdx.x; it < 8 * 128; it += gridDim.x) {
    {
      const int r = it, yt = r >> 3, xt = r & 7, x0 = xt * 128, y0 = yt * 256;
      f32x4 acc[4][4];
      zero_acc(acc);
      gemm_main<true, true>(p.Wt_ukv + (size_t)x0 * 128, 128, p.projA + (size_t)y0 * LDA_ + 256, LDA_, 128, sm, acc, rs, 1.f / 128.f, 1e-6f);
      const int hd = xt;
      if (wx == 0) {
#pragma unroll
        for (int j = 0; j < 4; ++j) {
          const int tl = wy * 64 + j * 16 + fr, tk = y0 + tl;
          const float rstd = rs[tl];
          const int bb = tk >> 12, s = tk & 4095;
#pragma unroll
          for (int i = 0; i < 4; ++i) {
            f32x4 v = acc[i][j] * rstd;
            *(uint2*)(p.K + ((size_t)(bb * 8 + hd) * SEQ + s) * 96 + i * 16 + fq * 4) = pack4(v);
          }
        }
      } else {
#pragma unroll
        for (int j = 0; j < 4; ++j) {
          const int tl0 = wy * 64 + j * 16 + fq * 4, tk0 = y0 + tl0;
          const f32x4 r4 = *(const f32x4*)(rs + tl0);
          const int bb = tk0 >> 12, s0 = tk0 & 4095;
#pragma unroll
          for (int i = 0; i < 4; ++i) {
            f32x4 v = acc[i][j] * r4;
            *(uint2*)(p.Vt + ((size_t)(bb * 8 + hd) * 64 + i * 16 + fr) * SEQ + s0) = pack4(v);
          }
        }
      }
      lds_barrier();
    }
  }
}
__device__ void phase3w(const Params& p, unsigned char* smraw) {
  const int tid = tidx();
  {
    WkvRaw RW;
    if ((int)blockIdx.x < 4096) wkv_load_raw(p, blockIdx.x, RW);
    for (int it = blockIdx.x; it < 4096; it += gridDim.x) wkv_prep_item(p, it, it + (int)gridDim.x, RW, smraw);
  }
  const int gt = blockIdx.x * NTHR + tid, gs = gridDim.x * NTHR;
  for (int i = gt; i < T_TOK * 16; i += gs) {
    const int tk = i >> 4, pi = i & 15;
    const float k1 = bf2f(p.projA[(size_t)tk * LDA_ + 384 + pi]), k2 = bf2f(p.projA[(size_t)tk * LDA_ + 400 + pi]);
    const float cv = p.cs[tk * 32 + pi], sv = p.cs[tk * 32 + 16 + pi];
    const us o1 = f2bf(k1 * cv - k2 * sv), o2 = f2bf(k1 * sv + k2 * cv);
    const int bb = tk >> 12, s = tk & 4095;
#pragma unroll
    for (int hd = 0; hd < 8; ++hd) {
      us* kr = p.K + ((size_t)(bb * 8 + hd) * SEQ + s) * 96;
      kr[64 + pi] = o1;
      kr[80 + pi] = o2;
    }
  }
}

typedef unsigned u32x2_ __attribute__((ext_vector_type(2)));
struct ScanLd { u32x4_ a[4][2]; f32x4 g[4]; u32x2_ nn[4]; };
DEVI void scan_load(const Params& p, size_t ch, int vs, int fr, int fq, ScanLd& L) {
  const us* mp = p.Mp + ch * 4096;
  const us* nt = p.Nt + ch * 4096 + (vs * 16 + fr) * 64 + fq * 4;
  const float* gc = p.Gc + ch * 64 + fq * 4;
#pragma unroll
  for (int m = 0; m < 4; ++m) {
    L.g[m] = *(const f32x4*)(gc + m * 16);
    L.nn[m] = *(const u32x2_*)(nt + m * 16);
#pragma unroll
    for (int ks = 0; ks < 2; ++ks) {
      const u32x2_ lo = *(const u32x2_*)(mp + (m * 16 + fr) * 64 + ks * 32 + fq * 4);
      const u32x2_ hi = *(const u32x2_*)(mp + (m * 16 + fr) * 64 + ks * 32 + 16 + fq * 4);
      L.a[m][ks] = u32x4_{lo[0], lo[1], hi[0], hi[1]};
    }
  }
}
DEVI void scan_step(f32x4 (&H)[4], const ScanLd& L) {
  bf16x8 bop[2];
#pragma unroll
  for (int ks = 0; ks < 2; ++ks) {
    uint2 lo = pack4(H[2 * ks]), hi = pack4(H[2 * ks + 1]);
    bop[ks] = mk8(lo.x, lo.y, hi.x, hi.y);
  }
#pragma unroll
  for (int m = 0; m < 4; ++m) {
    f32x4 hn;
    hn[0] = L.g[m][0] * H[m][0] + bflo(L.nn[m][0]);
    hn[1] = L.g[m][1] * H[m][1] + bfhi(L.nn[m][0]);
    hn[2] = L.g[m][2] * H[m][2] + bflo(L.nn[m][1]);
    hn[3] = L.g[m][3] * H[m][3] + bfhi(L.nn[m][1]);
#pragma unroll
    for (int ks = 0; ks < 2; ++ks) hn = mfma16(__builtin_bit_cast(bf16x8, L.a[m][ks]), bop[ks], hn);
    H[m] = hn;
  }
}
DEVI void scan_store(const Params& p, size_t ch, int vs, int fr, int fq, const f32x4 (&H)[4]) {
  us* hh = p.Hh + ch * 4096 + (vs * 16 + fr) * 64 + fq * 4;
#pragma unroll
  for (int m = 0; m < 4; ++m) { const uint2 q = pack4(H[m]); __builtin_nontemporal_store(u32x2n_{q.x, q.y}, (u32x2n_*)(hh + m * 16)); }
}
__device__ void wkv_scan_item(const Params& p, int item) {
  const int lane = tidx() & 63, fr = lane & 15, fq = lane >> 4;
  const int bh = item >> 2, vs = item & 3;
  const size_t ch0 = (size_t)bh * 64;
  f32x4 H[4];
#pragma unroll
  for (int m = 0; m < 4; ++m) H[m] = f32x4{0.f, 0.f, 0.f, 0.f};
  ScanLd L0, L1, L2;
  scan_load(p, ch0, vs, fr, fq, L0);
  scan_load(p, ch0 + 1, vs, fr, fq, L1);
  scan_load(p, ch0 + 2, vs, fr, fq, L2);
  for (int c = 0; c < 63; c += 3) {
    scan_store(p, ch0 + c, vs, fr, fq, H); scan_step(H, L0); scan_load(p, ch0 + min(c + 3, 62), vs, fr, fq, L0);
    scan_store(p, ch0 + c + 1, vs, fr, fq, H); scan_step(H, L1); scan_load(p, ch0 + min(c + 4, 62), vs, fr, fq, L1);
    scan_store(p, ch0 + c + 2, vs, fr, fq, H); scan_step(H, L2); scan_load(p, ch0 + min(c + 5, 62), vs, fr, fq, L2);
  }
  scan_store(p, ch0 + 63, vs, fr, fq, H);
}

constexpr int SC_G = 6, SC_NT = 64 * 144, SC_GC = SC_NT + 16 * 144, SC_SLOT = SC_GC + 256, SC_NGRP = 11;
__device__ void wkv_scan_block(const Params& p, int item, unsigned char* smraw) {
  const int tid = tidx(), lane = tid & 63, w = tid >> 6, fr = lane & 15, fq = lane >> 4;
  const int bh = item >> 2, vs = item & 3;
  const size_t ch0 = (size_t)bh * 64;
  bf16x8 gm[SC_G], gn[2];
  f32x4 gg;
  const int mrow = tid >> 3, mcol = (tid & 7) * 8;
  int nslot[2], nrow[2], ncol[2];
#pragma unroll
  for (int q = 0; q < 2; ++q) { const int id = tid + 512 * q; nslot[q] = id >> 7; nrow[q] = (id & 127) >> 3; ncol[q] = (id & 7) * 8; }
  const int gslot = tid >> 4, gcol = (tid & 15) * 4;
#define SC_LOAD(g0) { \
    _Pragma("unroll") for (int q = 0; q < SC_G; ++q) gm[q] = *(const bf16x8*)(p.Mp + (ch0 + min((g0) + q, 62)) * 4096 + mrow * 64 + mcol); \
    _Pragma("unroll") for (int q = 0; q < 2; ++q) if (tid + 512 * q < SC_G * 128) \
      gn[q] = *(const bf16x8*)(p.Nt + (ch0 + min((g0) + nslot[q], 62)) * 4096 + (vs * 16 + nrow[q]) * 64 + ncol[q]); \
    if (tid < SC_G * 16) gg = *(const f32x4*)(p.Gc + (ch0 + min((g0) + gslot, 62)) * 64 + gcol); }
#define SC_WRITE(buf) { unsigned char* bb = smraw + (buf) * (SC_G * SC_SLOT); \
    _Pragma("unroll") for (int q = 0; q < SC_G; ++q) *(bf16x8*)(bb + q * SC_SLOT + mrow * 144 + mcol * 2) = gm[q]; \
    _Pragma("unroll") for (int q = 0; q < 2; ++q) if (tid + 512 * q < SC_G * 128) \
      *(bf16x8*)(bb + nslot[q] * SC_SLOT + SC_NT + nrow[q] * 144 + ncol[q] * 2) = gn[q]; \
    if (tid < SC_G * 16) *(f32x4*)(bb + gslot * SC_SLOT + SC_GC + gcol * 4) = gg; }
  f32x4 H[4];
#pragma unroll
  for (int m = 0; m < 4; ++m) H[m] = f32x4{0.f, 0.f, 0.f, 0.f};
  SC_LOAD(0)
  SC_WRITE(0)
  lds_barrier();
  for (int g = 0; g < SC_NGRP; ++g) {
    if (g + 1 < SC_NGRP) SC_LOAD((g + 1) * SC_G)
    if (w == 0) {
      const unsigned char* bb = smraw + (g & 1) * (SC_G * SC_SLOT);
#pragma unroll
      for (int q = 0; q < SC_G; ++q) {
        const int c = g * SC_G + q;
        if (c < 63) {
          scan_store(p, ch0 + c, vs, fr, fq, H);
          const unsigned char* sl = bb + q * SC_SLOT;
          bf16x8 bop[2];
#pragma unroll
          for (int ks = 0; ks < 2; ++ks) {
            const uint2 lo = pack4(H[2 * ks]), hi = pack4(H[2 * ks + 1]);
            bop[ks] = mk8(lo.x, lo.y, hi.x, hi.y);
          }
#pragma unroll
          for (int m = 0; m < 4; ++m) {
            const f32x4 gv = *(const f32x4*)(sl + SC_GC + (m * 16 + fq * 4) * 4);
            const uint2 nn = *(const uint2*)(sl + SC_NT + fr * 144 + (m * 16 + fq * 4) * 2);
            f32x4 hn;
            hn[0] = gv[0] * H[m][0] + bflo(nn.x); hn[1] = gv[1] * H[m][1] + bfhi(nn.x);
            hn[2] = gv[2] * H[m][2] + bflo(nn.y); hn[3] = gv[3] * H[m][3] + bfhi(nn.y);
#pragma unroll
            for (int ks = 0; ks < 2; ++ks) {
              const uint2 lo = *(const uint2*)(sl + (m * 16 + fr) * 144 + (ks * 32 + fq * 4) * 2);
              const uint2 hi = *(const uint2*)(sl + (m * 16 + fr) * 144 + (ks * 32 + 16 + fq * 4) * 2);
              hn = mfma16(mk8(lo.x, lo.y, hi.x, hi.y), bop[ks], hn);
            }
            H[m] = hn;
          }
        }
      }
    }
    if (g + 1 < SC_NGRP) SC_WRITE((g + 1) & 1)
    lds_barrier();
  }
  if (w == 0) scan_store(p, ch0 + 63, vs, fr, fq, H);
#undef SC_LOAD
#undef SC_WRITE
}

constexpr int AKS = 104, AVS = 68, ASTG = 64 * AKS + 64 * AVS;
__device__ void attn_item(const Params& p, int bh, int qt, unsigned char* smraw) {
  us* sm = (us*)smraw;
  const int tid = tidx(), lane = tid & 63, w = tid >> 6, c = lane & 31, hh = lane >> 5;
  const int pr = w >> 1, sub = w & 1;
  const int q0 = qt * 256;
  const us* Kg = p.K + (size_t)bh * SEQ * 96;
  const us* Vg = p.Vt + (size_t)bh * 64 * SEQ;
  bf16x8 qf[2][6];
#pragma unroll
  for (int qs = 0; qs < 2; ++qs) {
    const us* qb = p.Q + ((size_t)bh * SEQ + q0 + pr * 64 + qs * 32 + c) * 96 + 8 * hh;
#pragma unroll
    for (int s = 0; s < 6; ++s) qf[qs][s] = *(const bf16x8*)(qb + 16 * s);
  }
  const int nkt = q0 / 64 + 4, mylim = q0 / 64 + pr;
  f32x16 ot[2][2];
#pragma unroll
  for (int a = 0; a < 2; ++a)
#pragma unroll
    for (int b = 0; b < 2; ++b)
#pragma unroll
      for (int r = 0; r < 16; ++r) ot[a][b][r] = 0.f;
  float mrun[2] = {-1e30f, -1e30f}, lrun[2] = {0.f, 0.f};
  const int kr0 = tid / 12, kc0 = (tid % 12) * 8;
  const int kr1 = (tid + 512) / 12, kc1 = ((tid + 512) % 12) * 8;
  const int vr = tid >> 3, vc = (tid & 7) * 8;
  bf16x8 gk0, gk1, gv;
  gk0 = *(const bf16x8*)(Kg + (size_t)kr0 * 96 + kc0);
  if (tid < 256) gk1 = *(const bf16x8*)(Kg + (size_t)kr1 * 96 + kc1);
  gv = *(const bf16x8*)(Vg + (size_t)vr * SEQ + vc);
  {
    us* ks = sm; us* vsm = sm + 64 * AKS;
    *(bf16x8*)(ks + kr0 * AKS + kc0) = gk0;
    if (tid < 256) *(bf16x8*)(ks + kr1 * AKS + kc1) = gk1;
    const u32x4_ q4 = __builtin_bit_cast(u32x4_, gv);
    *(uint2*)(vsm + vr * AVS + vc) = make_uint2(q4.x, q4.y);
    *(uint2*)(vsm + vr * AVS + vc + 4) = make_uint2(q4.z, q4.w);
  }
  lds_barrier();
  for (int kt = 0; kt < nkt; ++kt) {
    const int cur = kt & 1;
    if (kt + 1 < nkt) {
      const size_t kb = (size_t)(kt + 1) * 64;
      gk0 = *(const bf16x8*)(Kg + (kb + kr0) * 96 + kc0);
      if (tid < 256) gk1 = *(const bf16x8*)(Kg + (kb + kr1) * 96 + kc1);
      gv = *(const bf16x8*)(Vg + (size_t)vr * SEQ + kb + vc);
    }
    if (kt <= mylim) {
      const us* ks = sm + cur * ASTG + (32 * sub + c) * AKS + 8 * hh;
      const us* vsm = sm + cur * ASTG + 64 * AKS + 32 * sub + 4 * hh;
      f32x16 sc[2];
#pragma unroll
      for (int a = 0; a < 2; ++a)
#pragma unroll
        for (int r = 0; r < 16; ++r) sc[a][r] = 0.f;
#pragma unroll
      for (int s = 0; s < 6; ++s) {
        const bf16x8 a0 = *(const bf16x8*)(ks + 16 * s);
        sc[0] = mfma32(a0, qf[0][s], sc[0]);
        sc[1] = mfma32(a0, qf[1][s], sc[1]);
      }
#pragma unroll
      for (int qs = 0; qs < 2; ++qs) {
        float mx = fmaxf(fmaxf(sc[qs][0], sc[qs][1]), sc[qs][2]);
#pragma unroll
        for (int r = 3; r < 15; r += 2) mx = fmaxf(fmaxf(mx, sc[qs][r]), sc[qs][r + 1]);
        mx = fmaxf(mx, sc[qs][15]);
        mx = fmaxf(mx, __shfl_xor(mx, 32));
        if (__builtin_amdgcn_ballot_w64(mx > mrun[qs] + 8.f) != 0ull) {
          const float mnew = fmaxf(mrun[qs], mx);
          const float alpha = __builtin_amdgcn_exp2f(mrun[qs] - mnew);
          mrun[qs] = mnew;
          lrun[qs] *= alpha;
#pragma unroll
          for (int r = 0; r < 16; ++r) { ot[qs][0][r] *= alpha; ot[qs][1][r] *= alpha; }
        }
        const float mref = mrun[qs];
        sc[qs] = sc[qs] - mref;
#pragma unroll
        for (int r = 0; r < 16; ++r) sc[qs][r] = __builtin_amdgcn_exp2f(sc[qs][r]);
        typedef float f32x8_ __attribute__((ext_vector_type(8)));
        typedef float f32x2s_ __attribute__((ext_vector_type(2)));
        const f32x8_ h8 = __builtin_shufflevector(sc[qs], sc[qs], 0, 1, 2, 3, 4, 5, 6, 7) + __builtin_shufflevector(sc[qs], sc[qs], 8, 9, 10, 11, 12, 13, 14, 15);
        const f32x4 h4 = __builtin_shufflevector(h8, h8, 0, 1, 2, 3) + __builtin_shufflevector(h8, h8, 4, 5, 6, 7);
        const f32x2s_ h2 = __builtin_shufflevector(h4, h4, 0, 1) + __builtin_shufflevector(h4, h4, 2, 3);
        float rsum = h2[0] + h2[1];
        rsum += __shfl_xor(rsum, 32);
        lrun[qs] += rsum;
      }
#pragma unroll
      for (int s = 0; s < 2; ++s) {
        bf16x8 pb[2];
#pragma unroll
        for (int qs = 0; qs < 2; ++qs)
          pb[qs] = mk8(pack2(sc[qs][8 * s + 0], sc[qs][8 * s + 1]), pack2(sc[qs][8 * s + 2], sc[qs][8 * s + 3]),
                       pack2(sc[qs][8 * s + 4], sc[qs][8 * s + 5]), pack2(sc[qs][8 * s + 6], sc[qs][8 * s + 7]));
#pragma unroll
        for (int dt = 0; dt < 2; ++dt) {
          const uint2 lo = *(const uint2*)(vsm + (32 * dt + c) * AVS + 16 * s);
          const uint2 hi = *(const uint2*)(vsm + (32 * dt + c) * AVS + 16 * s + 8);
          const bf16x8 va = mk8(lo.x, lo.y, hi.x, hi.y);
          ot[0][dt] = mfma32(va, pb[0], ot[0][dt]);
          ot[1][dt] = mfma32(va, pb[1], ot[1][dt]);
        }
      }
    }
    if (kt + 1 < nkt) {
      us* ksn = sm + (cur ^ 1) * ASTG; us* vsn = ksn + 64 * AKS;
      *(bf16x8*)(ksn + kr0 * AKS + kc0) = gk0;
      if (tid < 256) *(bf16x8*)(ksn + kr1 * AKS + kc1) = gk1;
      const u32x4_ q4 = __builtin_bit_cast(u32x4_, gv);
      *(uint2*)(vsn + vr * AVS + vc) = make_uint2(q4.x, q4.y);
      *(uint2*)(vsn + vr * AVS + vc + 4) = make_uint2(q4.z, q4.w);
    }
    lds_barrier();
  }
  float* xo = (float*)smraw + pr * 4096;
  float* xml = (float*)smraw + 16384 + pr * 256;
  if (sub == 1) {
#pragma unroll
    for (int qs = 0; qs < 2; ++qs) {
#pragma unroll
      for (int dt = 0; dt < 2; ++dt)
#pragma unroll
        for (int r = 0; r < 16; ++r) xo[((qs * 2 + dt) * 16 + r) * 64 + lane] = ot[qs][dt][r];
      xml[(qs * 2 + 0) * 64 + lane] = mrun[qs];
      xml[(qs * 2 + 1) * 64 + lane] = lrun[qs];
    }
  }
  lds_barrier();
  if (sub == 0) {
    const int b = bh >> 3, hd = bh & 7;
#pragma unroll
    for (int qs = 0; qs < 2; ++qs) {
      const float m2 = xml[(qs * 2 + 0) * 64 + lane], l2 = xml[(qs * 2 + 1) * 64 + lane];
      const float M = fmaxf(mrun[qs], m2);
      const float e1 = __builtin_amdgcn_exp2f(mrun[qs] - M), e2 = __builtin_amdgcn_exp2f(m2 - M);
      const float inv = 1.f / (lrun[qs] * e1 + l2 * e2);
      const float f1 = e1 * inv, f2 = e2 * inv;
      const size_t tk = (size_t)b * SEQ + q0 + pr * 64 + qs * 32 + c;
      const us* ga = p.projB + tk * LDB_ + hd * 64;
      us* zo = p.za + tk * 1024 + hd * 64;
#pragma unroll
      for (int dt = 0; dt < 2; ++dt) {
#pragma unroll
        for (int g = 0; g < 4; ++g) {
          const int d0 = 32 * dt + 8 * g + 4 * hh;
          const uint2 gg = *(const uint2*)(ga + d0);
          f32x4 v;
#pragma unroll
          for (int r = 0; r < 4; ++r) v[r] = ot[qs][dt][4 * g + r] * f1 + xo[((qs * 2 + dt) * 16 + 4 * g + r) * 64 + lane] * f2;
          v[0] *= bflo(gg.x); v[1] *= bfhi(gg.x); v[2] *= bflo(gg.y); v[3] *= bfhi(gg.y);
          *(uint2*)(zo + d0) = pack4(v);
        }
      }
    }
  }
  lds_barrier();
}

__device__ void phase4(const Params& p, unsigned char* smraw) {
  const int wid = tidx() >> 6;
#pragma nounroll
  for (int it = blockIdx.x; it < 256; it += gridDim.x) wkv_scan_block(p, it, smraw);
  const int G = gridDim.x;
#pragma nounroll
  for (int r = 0;; ++r) {
    const int pos = (r & 1) ? (G - 1 - (int)blockIdx.x) : (int)blockIdx.x;
    const int k = r * G + pos;
    if (r * G >= 1024) break;
    if (k < 1024) attn_item(p, k & 63, 15 - (k >> 6), smraw);
  }
}

__device__ void phase5(const Params& p) {
  const int lane = tidx() & 63, wid = tidx() >> 6, fr = lane & 15, fq = lane >> 4;
  for (int it = blockIdx.x * 8 + wid; it < 4096 * 4; it += gridDim.x * 8) {
    const int ch = it >> 2, tt = it & 3;
    const int bh = ch >> 6, cc = ch & 63, b = bh >> 3, hd = bh & 7;
    const us* y1 = p.Y1 + (size_t)ch * 4096;
    const us* hh = p.Hh + (size_t)ch * 4096;
    const us* y0 = p.Y0t + (size_t)ch * 4096;
    const size_t tk = (size_t)b * SEQ + cc * 64 + tt * 16 + fr;
    const int ci0 = hd * 64 + fq * 4;
    bf16x8 bq[2];
#pragma unroll
    for (int ks = 0; ks < 2; ++ks) bq[ks] = *(const bf16x8*)(y1 + (tt * 16 + fr) * 64 + ks * 32 + fq * 8);
    uint2 bvv[4], gbv[4];
    f32x4 y[4];
#pragma unroll
    for (int mt = 0; mt < 4; ++mt) {
      const uint2 yy = *(const uint2*)(y0 + (tt * 16 + fr) * 64 + mt * 16 + fq * 4);
      bvv[mt] = *(const uint2*)(p.bv + tk * 512 + ci0 + mt * 16);
      gbv[mt] = *(const uint2*)(p.projB + tk * LDB_ + 512 + ci0 + mt * 16);
      y[mt][0] = bflo(yy.x); y[mt][1] = bfhi(yy.x); y[mt][2] = bflo(yy.y); y[mt][3] = bfhi(yy.y);
#pragma unroll
      for (int ks = 0; ks < 2; ++ks) {
        const bf16x8 a = *(const bf16x8*)(hh + (mt * 16 + fr) * 64 + ks * 32 + fq * 8);
        y[mt] = mfma16(a, bq[ks], y[mt]);
      }
    }
    float s1 = 0.f;
#pragma unroll
    for (int mt = 0; mt < 4; ++mt) s1 += y[mt][0] + y[mt][1] + y[mt][2] + y[mt][3];
    s1 += __shfl_xor(s1, 16); s1 += __shfl_xor(s1, 32);
    const float mean = s1 * (1.f / 64.f);
    float s2 = 0.f;
#pragma unroll
    for (int mt = 0; mt < 4; ++mt)
#pragma unroll
      for (int r = 0; r < 4; ++r) { y[mt][r] -= mean; s2 += y[mt][r] * y[mt][r]; }
    s2 += __shfl_xor(s2, 16); s2 += __shfl_xor(s2, 32);
    const float rstd = rsqrtf(s2 * (1.f / 64.f) + 64e-5f);
#pragma unroll
    for (int mt = 0; mt < 4; ++mt) {
      const float4 gg = *(const float4*)(p.gn_g + ci0 + mt * 16), gb = *(const float4*)(p.gn_b + ci0 + mt * 16);
      f32x4 v;
      v[0] = (y[mt][0] * rstd * gg.x + gb.x + bflo(bvv[mt].x)) * bflo(gbv[mt].x);
      v[1] = (y[mt][1] * rstd * gg.y + gb.y + bfhi(bvv[mt].x)) * bfhi(gbv[mt].x);
      v[2] = (y[mt][2] * rstd * gg.z + gb.z + bflo(bvv[mt].y)) * bflo(gbv[mt].y);
      v[3] = (y[mt][3] * rstd * gg.w + gb.w + bfhi(bvv[mt].y)) * bfhi(gbv[mt].y);
      *(uint2*)(p.za + tk * 1024 + 512 + ci0 + mt * 16) = pack4(v);
    }
  }
}

DEVI void unpack8(uint4 g, float (&o)[8]) {
  o[0] = bflo(g.x); o[1] = bfhi(g.x); o[2] = bflo(g.y); o[3] = bfhi(g.y);
  o[4] = bflo(g.z); o[5] = bfhi(g.z); o[6] = bflo(g.w); o[7] = bfhi(g.w);
}
struct EpiMerge {
  static constexpr bool PERM = true, AFTER_DRAIN = false; static constexpr int MID_T = 8;
  const us* projB; us* merged;
  DEVI void mid(f32x4 (&acc)[2][2][4][2], const pg8::Unit& u, int wr, int wc, int fr, int fq) const {
    const int row0 = u.pm * 256 + wr * 64 + fr, col0 = u.pn * 256 + wc * 32 + 8 * fq;
    const us* gbase = projB + (size_t)row0 * LDB_ + 1024 + col0;
#pragma unroll
    for (int ai = 0; ai < 2; ++ai) {
#pragma unroll
      for (int m = 0; m < 4; ++m) {
#pragma unroll
        for (int bj = 0; bj < 2; ++bj) {
          const us* gp = gbase + (size_t)(ai * 128 + m * 16) * LDB_ + bj * 128;
          float ga[8], gb[8];
          unpack8(*(const uint4*)gp, ga);
          unpack8(*(const uint4*)(gp + 1024), gb);
#pragma unroll
          for (int e = 0; e < 4; ++e) {
            acc[ai][bj][m][0][e] *= ga[e] * __builtin_amdgcn_rcpf(gb[e]);
            acc[ai][bj][m][1][e] *= ga[4 + e] * __builtin_amdgcn_rcpf(gb[4 + e]);
          }
        }
      }
    }
  }
  DEVI void operator()(const f32x4 (&acc)[2][2][4][2], const pg8::Unit& u, int wr, int wc, int fr, int fq) const {
    const int row0 = u.pm * 256 + wr * 64 + fr, col0 = u.pn * 256 + wc * 32 + 8 * fq;
#pragma unroll
    for (int ai = 0; ai < 2; ++ai)
#pragma unroll
      for (int m = 0; m < 4; ++m) {
        const size_t row = row0 + ai * 128 + m * 16;
#pragma unroll
        for (int bj = 0; bj < 2; ++bj) {
          const int c = col0 + bj * 128;
          float gb[8];
          unpack8(*(const uint4*)(projB + row * LDB_ + 2048 + c), gb);
          const f32x4 v0 = acc[ai][bj][m][0], v1 = acc[ai][bj][m][1];
          uint4 q;
          q.x = pack2(v0[0] * gb[0], v0[1] * gb[1]); q.y = pack2(v0[2] * gb[2], v0[3] * gb[3]);
          q.z = pack2(v1[0] * gb[4], v1[1] * gb[5]); q.w = pack2(v1[2] * gb[6], v1[3] * gb[7]);
          *(uint4*)(merged + row * 1024 + c) = q;
        }
      }
  }
};
__device__ void phase6(const Params& p, unsigned char* smraw) {
  pg8::Gemm g{p.za, p.Wt_pa, T_TOK, 1024, 1024};
  pg8::StaticOrder S; S.init(g.M, g.N, (int)gridDim.x, (int)blockIdx.x);
  EpiMerge E{p.projB, p.merged};
  pg8::gemm_phase<EpiMerge, pg8::StaticOrder, false>((PG8_LAS unsigned char*)smraw, g, S, E, nullptr);
}

struct EpiSub {
  static constexpr bool PERM = true, AFTER_DRAIN = false; static constexpr int MID_T = 0;
  us* sub;
  DEVI void operator()(const f32x4 (&acc)[2][2][4][2], const pg8::Unit& u, int wr, int wc, int fr, int fq) const {
    const int row0 = u.pm * 256 + wr * 64 + fr, col0 = u.pn * 256 + wc * 32 + 8 * fq;
#pragma unroll
    for (int ai = 0; ai < 2; ++ai)
#pragma unroll
      for (int m = 0; m < 4; ++m) {
        const size_t row = row0 + ai * 128 + m * 16;
#pragma unroll
        for (int bj = 0; bj < 2; ++bj) {
          const f32x4 v0 = acc[ai][bj][m][0], v1 = acc[ai][bj][m][1];
          uint4 q; q.x = pack2(v0[0], v0[1]); q.y = pack2(v0[2], v0[3]); q.z = pack2(v1[0], v1[1]); q.w = pack2(v1[2], v1[3]);
          *(uint4*)(sub + row * 1024 + col0 + bj * 128) = q;
        }
      }
  }
};
__device__ void phase7(const Params& p, unsigned char* smraw) {
  pg8::Gemm g{p.merged, p.Wt_out, T_TOK, 1024, 1024};
  pg8::StaticOrder S; S.init(g.M, g.N, (int)gridDim.x, (int)blockIdx.x);
  EpiSub E{p.sub};
  pg8::gemm_phase<EpiSub, pg8::StaticOrder, false>((PG8_LAS unsigned char*)smraw, g, S, E, nullptr);
}

__device__ void phase8(const Params& p) {
  const int lane = tidx() & 63, wid = tidx() >> 6;
  for (int row0 = (blockIdx.x * 8 + wid) * 2; row0 < T_TOK; row0 += gridDim.x * 16) {
    const float* gate = p.mod + (row0 >> 12) * 3072 + 2048;
    float4 z[2][4];
#pragma unroll
    for (int r = 0; r < 2; ++r) {
      const float4* xr = (const float4*)(p.x + (size_t)(row0 + r) * DM);
      const uint2* sr = (const uint2*)(p.sub + (size_t)(row0 + r) * DM);
#pragma unroll
      for (int i = 0; i < 4; ++i) {
        const int c4 = i * 64 + lane;
        const float4 xv = xr[c4];
        const uint2 sv = sr[c4];
        const float4 g = ((const float4*)gate)[c4];
        z[r][i].x = ALPHA_ * xv.x + (1.f + g.x) * bflo(sv.x);
        z[r][i].y = ALPHA_ * xv.y + (1.f + g.y) * bfhi(sv.x);
        z[r][i].z = ALPHA_ * xv.z + (1.f + g.z) * bflo(sv.y);
        z[r][i].w = ALPHA_ * xv.w + (1.f + g.w) * bfhi(sv.y);
      }
    }
#pragma unroll
    for (int r = 0; r < 2; ++r) {
      float s = 0.f;
#pragma unroll
      for (int i = 0; i < 4; ++i) s += z[r][i].x + z[r][i].y + z[r][i].z + z[r][i].w;
#pragma unroll
      for (int o = 32; o; o >>= 1) s += __shfl_xor(s, o);
      const float mean = s * (1.f / 1024.f);
      float q = 0.f;
#pragma unroll
      for (int i = 0; i < 4; ++i) {
        z[r][i].x -= mean; z[r][i].y -= mean; z[r][i].z -= mean; z[r][i].w -= mean;
        q += z[r][i].x * z[r][i].x + z[r][i].y * z[r][i].y + z[r][i].z * z[r][i].z + z[r][i].w * z[r][i].w;
      }
#pragma unroll
      for (int o = 32; o; o >>= 1) q += __shfl_xor(q, o);
      const float rstd = rsqrtf(q * (1.f / 1024.f) + 1e-5f);
      float4* orow = (float4*)(p.out + (size_t)(row0 + r) * DM);
#pragma unroll
      for (int i = 0; i < 4; ++i) {
        const int c4 = i * 64 + lane;
        const float4 g = ((const float4*)p.post_g)[c4], bb = ((const float4*)p.post_b)[c4];
        float4 v;
        v.x = z[r][i].x * rstd * g.x + bb.x; v.y = z[r][i].y * rstd * g.y + bb.y;
        v.z = z[r][i].z * rstd * g.z + bb.z; v.w = z[r][i].w * rstd * g.w + bb.w;
        orow[c4] = v;
      }
    }
  }
}

#define XB_TMO      128
#define XB_XCNT(j)  (256  + 64 * (j))
#define XB_XSUB(j)  (1280 + 64 * (j))
#define XB_XGEN(j)  (2304 + 64 * (j))
#define XB_TOP      3328
#define XB_TOPGEN   3392
#define XCD_BAR_WORDS 3456
#define XB_SPIN_CAP (1u << 18)
#define LAS __attribute__((address_space(3)))

__device__ __forceinline__ unsigned xb_ld(unsigned* p)              { return __hip_atomic_load(p, __ATOMIC_RELAXED, __HIP_MEMORY_SCOPE_AGENT); }
__device__ __forceinline__ unsigned xb_add(unsigned* p, unsigned v) { return __hip_atomic_fetch_add(p, v, __ATOMIC_RELAXED, __HIP_MEMORY_SCOPE_AGENT); }
__device__ __forceinline__ unsigned xb_xcc_id() { return (unsigned)__builtin_amdgcn_s_getreg((3 << 11) | 20) & 0xFu; }
#define XB_SPIN(cond, bar) do { unsigned _sp = 0; while (cond) { __builtin_amdgcn_s_sleep(1); \
    if ((++_sp & 255u) == 0u) { if (xb_ld(&(bar)[XB_TMO])) break; if (_sp > XB_SPIN_CAP) { atomicAdd(&(bar)[XB_TMO], 1u); break; } } } } while (0)

struct XcdBarrier {
    unsigned* bar; unsigned x;
    volatile LAS unsigned* st;
};

__device__ __forceinline__ XcdBarrier xcd_barrier_post(unsigned* bar, volatile LAS unsigned* st) {
    XcdBarrier b; b.bar = bar; b.x = xb_xcc_id(); b.st = st;
    if (threadIdx.x == 0) (void)xb_add(&bar[XB_XCNT(b.x)], 1u);
    return b;
}
__device__ __forceinline__ void xcd_barrier_complete(unsigned* bar, unsigned x, unsigned& nloc, unsigned& nx) {
    const unsigned G = gridDim.x * gridDim.y * gridDim.z;
    unsigned sum, cnt, mine, sp = 0u;
    for (;;) {
        sum = 0u; cnt = 0u; mine = 0u;
#pragma unroll
        for (unsigned j = 0; j < 16; ++j) { const unsigned c = xb_ld(&bar[XB_XCNT(j)]); sum += c; cnt += (c > 0u) ? 1u : 0u; mine = (j == x) ? c : mine; }
        if (sum == G) break;
        __builtin_amdgcn_s_sleep(1);
        if ((++sp & 255u) == 0u) { if (xb_ld(&bar[XB_TMO])) break; if (sp > XB_SPIN_CAP) { atomicAdd(&bar[XB_TMO], 1u); break; } }
    }
    nloc = mine > 0u ? mine : 1u; nx = cnt > 0u ? cnt : 1u;
}

__device__ __forceinline__ void xcd_barrier(const XcdBarrier& b) {
    asm volatile("s_waitcnt vmcnt(0)" ::: "memory");
    __syncthreads();
    if (threadIdx.x == 0) {
        unsigned* bar = b.bar;
        __builtin_amdgcn_s_waitcnt(0);
        unsigned nloc = b.st[0], nx = b.st[1];
        if (nloc == 0u) { xcd_barrier_complete(bar, b.x, nloc, nx); b.st[0] = nloc; b.st[1] = nx; }
        const unsigned old = xb_add(&bar[XB_XSUB(b.x)], 1u);
        const unsigned gen = old / nloc;
        if (old + 1u == (gen + 1u) * nloc) {
            __builtin_amdgcn_fence(__ATOMIC_RELEASE, "agent");
            asm volatile("s_waitcnt vmcnt(0)" ::: "memory");
            const unsigned og = xb_add(&bar[XB_TOP], 1u);
            const unsigned tg = og / nx;
            if (og + 1u == (tg + 1u) * nx) xb_add(&bar[XB_TOPGEN], 1u);
            else XB_SPIN(xb_ld(&bar[XB_TOPGEN]) == tg, bar);
            __builtin_amdgcn_fence(__ATOMIC_ACQUIRE, "agent");
            xb_add(&bar[XB_XGEN(b.x)], 1u);
            asm volatile("s_waitcnt vmcnt(0)" ::: "memory");
        } else {
            XB_SPIN(xb_ld(&bar[XB_XGEN(b.x)]) == gen, bar);
            __builtin_amdgcn_fence(__ATOMIC_ACQUIRE, "agent");
            asm volatile("s_waitcnt vmcnt(0)" ::: "memory");
        }
    }
    __syncthreads();
}


#ifdef ONE_LAUNCH
__global__ void __launch_bounds__(NTHR) fwd_kernel(Params p) {
  extern __shared__ __attribute__((aligned(16))) unsigned char smraw[];
  cg::grid_group grid = cg::this_grid();
  volatile LAS unsigned* xst = (volatile LAS unsigned*)(smraw + LDSB0);
  if (threadIdx.x == 0) { xst[0] = 0u; xst[1] = 0u; }
  __syncthreads();
  const XcdBarrier xb = xcd_barrier_post(p.bar, xst);
  if (p.bar == nullptr) grid.sync();
  phase0(p, smraw); xcd_barrier(xb);
  phase1(p); xcd_barrier(xb);
  phase2(p, smraw); xcd_barrier(xb);
  phase3q(p, smraw); phase3kv(p, smraw); phase3w(p, smraw); xcd_barrier(xb);
  phase4(p, smraw); xcd_barrier(xb);
  phase5(p); xcd_barrier(xb);
  phase6(p, smraw); xcd_barrier(xb);
  phase7(p, smraw); xcd_barrier(xb);
  phase8(p);
}
#else
#define PK(name, call) __global__ void __launch_bounds__(NTHR) name(Params p) { \
  extern __shared__ __attribute__((aligned(16))) unsigned char smraw[]; call; }
PK(k_p0, phase0(p, smraw)) PK(k_p1, phase1(p)) PK(k_p2, phase2(p, smraw)) PK(k_p3q, phase3q(p, smraw))
PK(k_p3kv, phase3kv(p, smraw)) PK(k_p3w, phase3w(p, smraw)) PK(k_p4, phase4(p, smraw)) PK(k_p5, phase5(p))
PK(k_p6, phase6(p, smraw)) PK(k_p7, phase7(p, smraw)) PK(k_p8, phase8(p))
#endif

extern "C" void kernel_launch(void* const* d_in, const int* in_sizes, int n_in, void* d_out, int out_size,
                              void* d_ws, size_t ws_size, hipStream_t stream) {
  static int grid_blocks = 0;
#ifdef ONE_LAUNCH
  if (!grid_blocks) {
    int dev = 0, cus = 0, per_cu = 0;
    (void)hipGetDevice(&dev);
    (void)hipDeviceGetAttribute(&cus, hipDeviceAttributeMultiprocessorCount, dev);
    (void)hipFuncSetAttribute((const void*)fwd_kernel, hipFuncAttributeMaxDynamicSharedMemorySize, LDSB);
    (void)hipOccupancyMaxActiveBlocksPerMultiprocessor(&per_cu, fwd_kernel, NTHR, LDSB);
    if (per_cu < 1) per_cu = 1;
    grid_blocks = cus * per_cu;
  }
#else
  if (!grid_blocks) {
    const void* ks[] = {(const void*)k_p0, (const void*)k_p1, (const void*)k_p2, (const void*)k_p3q, (const void*)k_p3kv,
                        (const void*)k_p3w, (const void*)k_p4, (const void*)k_p5, (const void*)k_p6, (const void*)k_p7,
                        (const void*)k_p8};
    for (int i = 0; i < 11; ++i) (void)hipFuncSetAttribute(ks[i], hipFuncAttributeMaxDynamicSharedMemorySize, LDSB);
    grid_blocks = 256;
  }
#endif
  Params p{};
  p.x = (const float*)d_in[0]; p.c = (const float*)d_in[1]; p.pos = (const int*)d_in[2];
  p.w_ada = (const float*)d_in[3]; p.b_ada = (const float*)d_in[4]; p.w_in = (const float*)d_in[5];
  p.q_norm_g = (const float*)d_in[6]; p.w_uq = (const float*)d_in[7]; p.kv_norm_g = (const float*)d_in[8];
  p.w_ukv = (const float*)d_in[9]; p.mu = (const float*)d_in[10]; p.w0 = (const float*)d_in[11];
  p.w_dec = (const float*)d_in[12]; p.a0 = (const float*)d_in[13]; p.w_icl = (const float*)d_in[14];
  p.k_k = (const float*)d_in[15]; p.k_a = (const float*)d_in[16]; p.r_k = (const float*)d_in[17];
  p.gn_g = (const float*)d_in[18]; p.gn_b = (const float*)d_in[19]; p.w_pa = (const float*)d_in[20];
  p.w_pb = (const float*)d_in[21]; p.w_out = (const float*)d_in[22]; p.post_g = (const float*)d_in[23];
  p.post_b = (const float*)d_in[24];
  p.out = (float*)d_out;
  unsigned char* ws = (unsigned char*)d_ws;
  size_t off = 0;
  auto take = [&](size_t bytes) { unsigned char* r = ws + off; off += (bytes + 255) & ~(size_t)255; return r; };
  const size_t MiB = 1u << 20;
  p.bar = (unsigned*)take(XCD_BAR_WORDS * 4);
  p.mod = (float*)take(8 * 3072 * 4);
  p.cs = (float*)take((size_t)T_TOK * 32 * 4);
  p.stats = (float*)take((size_t)T_TOK * 2 * 4);
  p.Gc = (float*)take(4096 * 64 * 4);
  p.Wt_in = (us*)take((size_t)5376 * 1024 * 2);
  p.Wt_uq = (us*)take(768 * 256 * 2);
  p.Wt_ukv = (us*)take(1024 * 128 * 2);
  p.Wt_dec = (us*)take(512 * 64 * 2);
  p.Wt_icl = (us*)take(512 * 64 * 2);
  p.Wt_pa = (us*)take(1024 * 1024 * 2);
  p.Wt_pb = p.Wt_pa;
  p.Wt_out = (us*)take(1024 * 1024 * 2);
  unsigned char* r1 = take(64 * MiB);
  unsigned char* r2 = take((size_t)T_TOK * LDA_ * 2);
  p.projB = (us*)take((size_t)T_TOK * LDB_ * 2);
  p.Y1 = (us*)take(32 * MiB);
  p.Y0t = (us*)take(32 * MiB);
  p.bv = (us*)take(32 * MiB);
  p.h = (us*)r1; p.Mp = (us*)r1; p.Nt = (us*)(r1 + 32 * MiB); p.merged = (us*)r1;
  p.projA = (us*)r2; p.sub = (us*)r2; p.Hh = (us*)r2; p.za = (us*)(r2 + 32 * MiB); p.zb = p.za;
  unsigned char* ob = (unsigned char*)d_out;
  p.Q = (us*)ob; p.K = (us*)(ob + 48 * MiB); p.Vt = (us*)(ob + 96 * MiB);
  if (off > ws_size) { fprintf(stderr, "workspace too small: need %zu have %zu\n", off, ws_size); return; }
#ifndef ONE_LAUNCH
  const dim3 g(grid_blocks), bdim(NTHR);
  k_p0<<<g, bdim, LDSB, stream>>>(p);
  k_p1<<<g, bdim, LDSB, stream>>>(p);
  k_p2<<<g, bdim, LDSB, stream>>>(p);
  k_p3q<<<g, bdim, LDSB, stream>>>(p);
  k_p3kv<<<g, bdim, LDSB, stream>>>(p);
  k_p3w<<<g, bdim, LDSB, stream>>>(p);
  k_p4<<<g, bdim, LDSB, stream>>>(p);
  k_p5<<<g, bdim, LDSB, stream>>>(p);
  k_p6<<<g, bdim, LDSB, stream>>>(p);
  k_p7<<<g, bdim, LDSB, stream>>>(p);
  k_p8<<<g, bdim, LDSB, stream>>>(p);
#else
  (void)hipMemsetAsync(p.bar, 0, XCD_BAR_WORDS * 4, stream);
  void* args[] = {&p};
  hipError_t e = hipLaunchCooperativeKernel((void*)fwd_kernel, dim3(grid_blocks), dim3(NTHR), args, LDSB, stream);
  if (e != hipSuccess) fprintf(stderr, "cooperative launch failed: %s (grid %d)\n", hipGetErrorString(e), grid_blocks);
#endif
}
```

```cpp
#include <hip/hip_runtime.h>
#include <hip/hip_cooperative_groups.h>
#include <cstdio>
#include <cstdint>
namespace cg = cooperative_groups;
#define ONE_LAUNCH 1

typedef unsigned short us;
typedef __attribute__((ext_vector_type(8))) short bf16x8;
typedef __attribute__((ext_vector_type(4))) float f32x4;
typedef __attribute__((ext_vector_type(16))) float f32x16;
typedef unsigned u32x2n_ __attribute__((ext_vector_type(2)));
#define DEVI __device__ __forceinline__

constexpr int T_TOK = 32768, SEQ = 4096, DM = 1024;
constexpr int LDA_ = 2080;
constexpr int LDB_ = 3072;
constexpr int NTHR = 512;
constexpr int LDSB0 = 16 * 9216 + 2048;
constexpr int LDSB = LDSB0 + 64;
constexpr float QSCALE = 0.10206207261596575f * 1.4426950408889634f;
constexpr float ALPHA_ = 1.189207115002721f;

struct Params {
  const float *x, *c; const int* pos;
  const float *w_ada, *b_ada, *w_in, *q_norm_g, *w_uq, *kv_norm_g, *w_ukv, *mu, *w0, *w_dec, *a0, *w_icl,
      *k_k, *k_a, *r_k, *gn_g, *gn_b, *w_pa, *w_pb, *w_out, *post_g, *post_b;
  float* out;
  float *mod, *cs, *stats, *Gc; unsigned* bar;
  us *Wt_in, *Wt_uq, *Wt_ukv, *Wt_dec, *Wt_icl, *Wt_pa, *Wt_pb, *Wt_out;
  us *h, *projA, *projB, *Q, *K, *Vt, *za, *zb, *bv, *Mp, *Nt, *Y1, *Y0t, *Hh, *merged, *sub;
};

DEVI int tidx() { int t = (int)threadIdx.x; asm volatile("" : "+v"(t)); return t; }
DEVI us f2bf(float f) { unsigned u = __float_as_uint(f); u += 0x7fffu + ((u >> 16) & 1u); return (us)(u >> 16); }
DEVI float bf2f(us h) { return __uint_as_float(((unsigned)h) << 16); }
typedef float f32x2_ __attribute__((ext_vector_type(2)));
typedef __bf16 bf16x2_ __attribute__((ext_vector_type(2)));
DEVI unsigned pack2(float a, float b) {
  f32x2_ v = {a, b};
  bf16x2_ r = __builtin_convertvector(v, bf16x2_);
  return *(unsigned*)&r;
}
DEVI uint2 pack4(f32x4 v) { uint2 r; r.x = pack2(v[0], v[1]); r.y = pack2(v[2], v[3]); return r; }
DEVI f32x4 mfma16(bf16x8 a, bf16x8 b, f32x4 c) { return __builtin_amdgcn_mfma_f32_16x16x32_bf16(a, b, c, 0, 0, 0); }
DEVI f32x16 mfma32(bf16x8 a, bf16x8 b, f32x16 c) { return __builtin_amdgcn_mfma_f32_32x32x16_bf16(a, b, c, 0, 0, 0); }
DEVI void lds_barrier() { asm volatile("s_waitcnt lgkmcnt(0)" ::: "memory"); __builtin_amdgcn_s_barrier(); asm volatile("" ::: "memory"); }
DEVI float sigmoidf_(float v) { return __builtin_amdgcn_rcpf(1.f + __builtin_amdgcn_exp2f(-1.4426950408889634f * v)); }
DEVI float siluf_(float v) { return v * __builtin_amdgcn_rcpf(1.f + __builtin_amdgcn_exp2f(-1.4426950408889634f * v)); }

DEVI void conv_job(const float* __restrict__ src, us* __restrict__ dst, int K, int N, int ld, int koff, const float* rs, float sc,
                   int gw, int nw, int lane) {
  const int ngrp = (N + 63) >> 6, noct = K >> 3;
  for (int wi = gw; wi < ngrp * noct; wi += nw) {
    const int nt = wi % ngrp, oc = wi / ngrp;
    const int n = nt * 64 + lane, k0 = oc * 8;
    if (n < N) {
      const float* sp = src + (size_t)k0 * N + n;
      const float v0 = sp[0], v1 = sp[(size_t)N], v2 = sp[(size_t)2 * N], v3 = sp[(size_t)3 * N];
      const float v4 = sp[(size_t)4 * N], v5 = sp[(size_t)5 * N], v6 = sp[(size_t)6 * N], v7 = sp[(size_t)7 * N];
      float4 ra = make_float4(sc, sc, sc, sc), rb = ra;
      if (rs) {
        const float4 a = *(const float4*)(rs + k0), b = *(const float4*)(rs + k0 + 4);
        ra = make_float4(a.x * sc, a.y * sc, a.z * sc, a.w * sc); rb = make_float4(b.x * sc, b.y * sc, b.z * sc, b.w * sc);
      }
      uint4 o;
      o.x = pack2(v0 * ra.x, v1 * ra.y); o.y = pack2(v2 * ra.z, v3 * ra.w);
      o.z = pack2(v4 * rb.x, v5 * rb.y); o.w = pack2(v6 * rb.z, v7 * rb.w);
      *(uint4*)(dst + (size_t)n * ld + koff + k0) = o;
    }
  }
}
__device__ void phase0(const Params& p, unsigned char* smraw) {
  float* smf = (float*)smraw;
  const int tid = tidx();
  for (int it = blockIdx.x; it < 48; it += gridDim.x) {
    {
      const int n0 = it * 64;
      for (int i = tid; i < 8192; i += NTHR) smf[i] = siluf_(p.c[i]);
      __syncthreads();
      const int nl = tid & 63, kg = tid >> 6;
      float acc[8];
#pragma unroll
      for (int b = 0; b < 8; ++b) acc[b] = 0.f;
      for (int k0 = kg * 128; k0 < kg * 128 + 128; k0 += 16) {
        float wv[16];
#pragma unroll
        for (int u = 0; u < 16; ++u) wv[u] = p.w_ada[(size_t)(k0 + u) * 3072 + n0 + nl];
#pragma unroll
        for (int u = 0; u < 16; ++u)
#pragma unroll
          for (int b = 0; b < 8; ++b) acc[b] += smf[b * 1024 + k0 + u] * wv[u];
      }
      float* red = smf + 8192;
#pragma unroll
      for (int b = 0; b < 8; ++b) red[(kg * 8 + b) * 64 + nl] = acc[b];
      __syncthreads();
      {
        const int b = tid >> 6;
        float s = p.b_ada[n0 + nl];
#pragma unroll
        for (int g = 0; g < 8; ++g) s += red[(g * 8 + b) * 64 + nl];
        p.mod[b * 3072 + n0 + nl] = s;
      }
      __syncthreads();
    }
  }
  {
    const int gw = blockIdx.x * 8 + (tid >> 6), nw = gridDim.x * 8;
    conv_job(p.w_in, p.Wt_in, 1024, 5152, 1024, 0, nullptr, 1.f, gw, nw, tid & 63);
    conv_job(p.w_uq, p.Wt_uq, 256, 768, 256, 0, p.q_norm_g, QSCALE, gw, nw, tid & 63);
    conv_job(p.w_ukv, p.Wt_ukv, 128, 1024, 128, 0, p.kv_norm_g, 1.f, gw, nw, tid & 63);
    conv_job(p.w_dec, p.Wt_dec, 64, 512, 64, 0, nullptr, 1.f, gw, nw, tid & 63);
    conv_job(p.w_icl, p.Wt_icl, 64, 512, 64, 0, nullptr, 1.f, gw, nw, tid & 63);
    conv_job(p.w_pa, p.Wt_pa, 512, 1024, 1024, 0, nullptr, 1.f, gw, nw, tid & 63);
    conv_job(p.w_pb, p.Wt_pa, 512, 1024, 1024, 512, nullptr, 1.f, gw, nw, tid & 63);
    conv_job(p.w_out, p.Wt_out, 1024, 1024, 1024, 0, nullptr, 1.f, gw, nw, tid & 63);
  }
  const int gt = blockIdx.x * NTHR + tid, gs = gridDim.x * NTHR;
  {
    const double inv = pow(10000.0, -(double)(gt & 15) / 16.0);
    for (int i = gt; i < T_TOK * 16; i += gs) {
      const int t = i >> 4, pi = i & 15;
      double ang = (double)p.pos[t] * inv;
      ang -= 6.283185307179586476925 * rint(ang * 0.15915494309189533577);
      float sv, cv;
      sincosf((float)ang, &sv, &cv);
      p.cs[t * 32 + pi] = cv;
      p.cs[t * 32 + 16 + pi] = sv;
    }
  }
  for (int i = gt; i < T_TOK * 2; i += gs) p.stats[i] = 0.f;
  unsigned* padz = (unsigned*)(p.Wt_in + (size_t)5152 * 1024);
  for (int i = gt; i < 224 * 512; i += gs) padz[i] = 0u;
}

__device__ void phase1(const Params& p) {
  const int lane = tidx() & 63, wid = tidx() >> 6;
  for (int row0 = (blockIdx.x * 8 + wid) * 2; row0 < T_TOK; row0 += gridDim.x * 16) {
    float4 v[2][4];
#pragma unroll
    for (int r = 0; r < 2; ++r) {
      const float4* xr = (const float4*)(p.x + (size_t)(row0 + r) * DM);
#pragma unroll
      for (int i = 0; i < 4; ++i) { const f32x4 t = __builtin_nontemporal_load((const f32x4*)xr + i * 64 + lane); v[r][i] = make_float4(t[0], t[1], t[2], t[3]); }
    }
    const float* md = p.mod + (row0 >> 12) * 3072;
#pragma unroll
    for (int r = 0; r < 2; ++r) {
      float s = 0.f;
#pragma unroll
      for (int i = 0; i < 4; ++i) s += v[r][i].x + v[r][i].y + v[r][i].z + v[r][i].w;
#pragma unroll
      for (int o = 32; o; o >>= 1) s += __shfl_xor(s, o);
      const float mean = s * (1.f / 1024.f);
      float q = 0.f;
#pragma unroll
      for (int i = 0; i < 4; ++i) {
        v[r][i].x -= mean; v[r][i].y -= mean; v[r][i].z -= mean; v[r][i].w -= mean;
        q += v[r][i].x * v[r][i].x + v[r][i].y * v[r][i].y + v[r][i].z * v[r][i].z + v[r][i].w * v[r][i].w;
      }
#pragma unroll
      for (int o = 32; o; o >>= 1) q += __shfl_xor(q, o);
      const float rstd = rsqrtf(q * (1.f / 1024.f) + 1e-5f);
#pragma unroll
      for (int i = 0; i < 4; ++i) {
        const int col = i * 256 + lane * 4;
        float4 sh = *(const float4*)(md + col), scl = *(const float4*)(md + 1024 + col);
        uint2 o;
        o.x = pack2(v[r][i].x * rstd * (1.f + scl.x) + sh.x, v[r][i].y * rstd * (1.f + scl.y) + sh.y);
        o.y = pack2(v[r][i].z * rstd * (1.f + scl.z) + sh.z, v[r][i].w * rstd * (1.f + scl.w) + sh.w);
        *(uint2*)(p.h + (size_t)(row0 + r) * DM + col) = o;
      }
    }
  }
}

constexpr int GST = 384 * 72;
template <bool SUMSQ = false, bool SWAPV = false>
DEVI void gemm_main(const us* __restrict__ X, int ldx, const us* __restrict__ Y, int ldy, int K, us* sm,
                    f32x4 (&acc)[4][4], float* rs_out = nullptr, float rs_scale = 0.f, float rs_eps = 0.f) {
  const int tid = tidx(), lane = tid & 63, wid = tid >> 6;
  const int wx = wid >> 2, wy = wid & 3, fr = lane & 15, fq = lane >> 4;
  const int sr = tid >> 3, sc = (tid & 7) * 8;
  bf16x8 gx[2], gy[4];
  float ssq[4] = {0.f, 0.f, 0.f, 0.f};
#define GM_ACCSQ() if (SUMSQ) { _Pragma("unroll") for (int i = 0; i < 4; ++i) { _Pragma("unroll") for (int e = 0; e < 8; ++e) { const float f = bf2f((us)gy[i][e]); ssq[i] += f * f; } } }
#pragma unroll
  for (int i = 0; i < 2; ++i) gx[i] = *(const bf16x8*)(X + (size_t)(sr + i * 64) * ldx + sc);
#pragma unroll
  for (int i = 0; i < 4; ++i) gy[i] = *(const bf16x8*)(Y + (size_t)(sr + i * 64) * ldy + sc);
#pragma unroll
  for (int i = 0; i < 2; ++i) *(bf16x8*)(sm + (sr + i * 64) * 72 + sc) = gx[i];
#pragma unroll
  for (int i = 0; i < 4; ++i) *(bf16x8*)(sm + (128 + sr + i * 64) * 72 + sc) = gy[i];
  GM_ACCSQ()
  lds_barrier();
  const int nk = K >> 6;
  for (int kt = 0; kt < nk; ++kt) {
    const int cur = kt & 1;
    if (kt + 1 < nk) {
      const int k0 = (kt + 1) * 64 + sc;
#pragma unroll
      for (int i = 0; i < 2; ++i) gx[i] = *(const bf16x8*)(X + (size_t)(sr + i * 64) * ldx + k0);
#pragma unroll
      for (int i = 0; i < 4; ++i) gy[i] = *(const bf16x8*)(Y + (size_t)(sr + i * 64) * ldy + k0);
    }
    const us* xs = sm + cur * GST;
    const us* ys = xs + 128 * 72;
#pragma unroll
    for (int ks = 0; ks < 2; ++ks) {
      bf16x8 a[4], b[4];
#pragma unroll
      for (int i = 0; i < 4; ++i) a[i] = *(const bf16x8*)(xs + (wx * 64 + i * 16 + fr) * 72 + ks * 32 + fq * 8);
#pragma unroll
      for (int j = 0; j < 4; ++j) b[j] = *(const bf16x8*)(ys + (wy * 64 + j * 16 + fr) * 72 + ks * 32 + fq * 8);
      __builtin_amdgcn_s_setprio(1);
#pragma unroll
      for (int i = 0; i < 4; ++i)
#pragma unroll
        for (int j = 0; j < 4; ++j) {
          if (SWAPV && wx == 1) acc[i][j] = mfma16(b[j], a[i], acc[i][j]);
          else acc[i][j] = mfma16(a[i], b[j], acc[i][j]);
        }
      __builtin_amdgcn_s_setprio(0);
    }
    if (kt + 1 < nk) {
      us* xn = sm + (cur ^ 1) * GST;
#pragma unroll
      for (int i = 0; i < 2; ++i) *(bf16x8*)(xn + (sr + i * 64) * 72 + sc) = gx[i];
#pragma unroll
      for (int i = 0; i < 4; ++i) *(bf16x8*)(xn + (128 + sr + i * 64) * 72 + sc) = gy[i];
      GM_ACCSQ()
    }
    lds_barrier();
  }
  if (SUMSQ) {
#pragma unroll
    for (int i = 0; i < 4; ++i) {
      float v = ssq[i];
      v += __shfl_xor(v, 1); v += __shfl_xor(v, 2); v += __shfl_xor(v, 4);
      if ((tid & 7) == 0) rs_out[sr + i * 64] = rsqrtf(v * rs_scale + rs_eps);
    }
    lds_barrier();
  }
#undef GM_ACCSQ
}
DEVI void zero_acc(f32x4 (&acc)[4][4]) {
#pragma unroll
  for (int i = 0; i < 4; ++i)
#pragma unroll
    for (int j = 0; j < 4; ++j) acc[i][j] = f32x4{0.f, 0.f, 0.f, 0.f};
}

namespace pg8 {
#define PG8_LAS __attribute__((address_space(3)))
typedef unsigned short bf16_t;
typedef short bf16x8 __attribute__((ext_vector_type(8)));
typedef float f32x4 __attribute__((ext_vector_type(4)));
typedef unsigned u32x4 __attribute__((ext_vector_type(4)));
constexpr int BM = 256, BK = 64, HALF = 128, HTB = HALF * BK * 2  , STAGE_BYTES = 8 * HTB, NXCD = 8, WGM = 8;

__host__ __device__ __forceinline__ int lds_byte(int r, int c) { const int st = (r >> 4) * 2 + (c >> 5), rr = r & 15, cc = c & 31, ob = rr * 64 + cc * 2; return st * 1024 + (ob ^ (((ob >> 9) & 1) << 5)); }
__host__ __device__ __forceinline__ void stage_rc(int b, int& R, int& C) { const int st = b / 1024, sb = b % 1024, swz = sb ^ (((sb >> 9) & 1) << 5); R = (st >> 1) * 16 + swz / 64; C = (st & 1) * 32 + (swz % 64) / 2; }
__host__ __device__ __forceinline__ int perm32(int rho) { const int n = rho >> 4, i = rho & 15; return 8 * (i >> 2) + 4 * n + (i & 3); }

struct Unit { int pm, pn; };
struct Gemm { const bf16_t* A; const bf16_t* Bt; int M, N, K; };

struct StaticOrder {
    int nM, nN, nwg, G, c;
    __host__ __device__ void init(int M, int N, int G_, int c_) { nM = M / BM; nN = N / BM; nwg = nM * nN; G = G_; c = c_; }
    __host__ __device__ bool next(int i, Unit& u) const {
        const long L = (long)i * G + c; if (L >= nwg) return false;
        int wgid = (int)L; { const int q = nwg / NXCD, r = nwg % NXCD, xcd = wgid % NXCD, off = wgid / NXCD; wgid = (xcd < r ? xcd * (q + 1) : r * (q + 1) + (xcd - r) * q) + off; }
        const int nig = WGM * nN, gid = wgid / nig, fm = gid * WGM, gsz = (nM - fm) < WGM ? (nM - fm) : WGM;
        u.pm = fm + ((wgid % nig) % gsz); u.pn = (wgid % nig) / gsz; return true;
    }
    __device__ __forceinline__ void a_ready(const Unit&) const {}
    __device__ __forceinline__ void done(const Unit&) const {}
};

template <class Epi, class Sched, bool STAMP = false>
__device__ __forceinline__ void gemm_phase(PG8_LAS unsigned char* lds, const Gemm g, const Sched& S, const Epi& E, unsigned long long* stamps) {
    const int tid = tidx(), wid = __builtin_amdgcn_readfirstlane(tid >> 6), lane = tid & 63, wr = wid >> 2, wc = wid & 3, fr = lane & 15, fq = lane >> 4;
    const int K = g.K, nt = K / BK;
    int ts_lo = 0, ts_hi = 0, nts = 0; const unsigned long long rt_entry = STAMP ? (unsigned long long)wall_clock64() : 0ull;
#define PG8_STAMP() do { if (STAMP && wid == 0 && nts < 64) { const unsigned long long _c = (unsigned long long)clock64(); \
        ts_lo = (lane == nts) ? (int)(unsigned)_c : ts_lo; ts_hi = (lane == nts) ? (int)(unsigned)(_c >> 32) : ts_hi; ++nts; } } while (0)
    unsigned voffA[2], voffB[2];
#pragma unroll
    for (int i = 0; i < 2; ++i) { int R, C; stage_rc(tid * 16 + i * 8192, R, C); const int Rb = Epi::PERM ? ((R & ~31) + perm32(R & 31)) : R;
        voffA[i] = (unsigned)(R * K + C) * 2u; voffB[i] = (unsigned)(Rb * K + C) * 2u; }
    const size_t kstep = (size_t)(BK * 2);
    const size_t hstep = (size_t)HALF * K * 2;
    const size_t tstep = 2 * hstep;
    const unsigned ldsw = (unsigned)wid * 1024u;
    const int aoff = lds_byte(wr * 64 + fr, fq * 8), boff = lds_byte(wc * 32 + fr, fq * 8);
#define PG8_SA(b, h) (((b) * 2 + (h)) * HTB)
#define PG8_SB(b, h) ((4 + (b) * 2 + (h)) * HTB)
#define PG8_STAGE(bufoff, gbase, voff) do { _Pragma("unroll") for (int _i = 0; _i < 2; ++_i) \
        __builtin_amdgcn_global_load_lds((const unsigned*)((const char*)(gbase) + (voff)[_i]), (PG8_LAS unsigned*)(lds + (bufoff) + ldsw + _i * 8192), 16, 0, 0); } while (0)
#define PG8_LDA(dst, b, h) do { _Pragma("unroll") for (int m = 0; m < 4; ++m) _Pragma("unroll") for (int k = 0; k < 2; ++k) dst[m][k] = *(const PG8_LAS bf16x8*)(lds + PG8_SA(b, h) + aoff + m * 2048 + k * 1024); } while (0)
#define PG8_LDB(dst, b, h) do { _Pragma("unroll") for (int n = 0; n < 2; ++n) _Pragma("unroll") for (int k = 0; k < 2; ++k) dst[n][k] = *(const PG8_LAS bf16x8*)(lds + PG8_SB(b, h) + boff + n * 2048 + k * 1024); } while (0)
#define PG8_MMA(ai, bj, At, Bt) do { __builtin_amdgcn_s_setprio(1); _Pragma("unroll") for (int m = 0; m < 4; ++m) _Pragma("unroll") for (int n = 0; n < 2; ++n) _Pragma("unroll") for (int k = 0; k < 2; ++k) \
        acc[ai][bj][m][n] = __builtin_amdgcn_mfma_f32_16x16x32_bf16(Bt[n][k], At[m][k], acc[ai][bj][m][n], 0, 0, 0); __builtin_amdgcn_s_setprio(0); } while (0)
#define PG8_WAIT_V(n) asm volatile("s_waitcnt vmcnt(" #n ")" ::: "memory")
#define PG8_WAIT_L(n) asm volatile("s_waitcnt lgkmcnt(" #n ")" ::: "memory")
#define PG8_BAR __builtin_amdgcn_s_barrier()
#define PG8_SCHED __builtin_amdgcn_sched_barrier(0)
    Unit cur, nxt; int ui = 0;
    if (!S.next(0, cur)) return;
    f32x4 acc[2][2][4][2];
#pragma unroll
    for (int a = 0; a < 2; ++a)
#pragma unroll
        for (int b = 0; b < 2; ++b)
#pragma unroll
            for (int m = 0; m < 4; ++m)
#pragma unroll
                for (int n = 0; n < 2; ++n) acc[a][b][m][n] = (f32x4){0.f, 0.f, 0.f, 0.f};
    bf16x8 At[4][2], B0[2][2], B1[2][2];
    const char* cA = (const char*)g.A + (size_t)cur.pm * tstep; const char* cB = (const char*)g.Bt + (size_t)cur.pn * tstep;
    S.a_ready(cur);
    PG8_STAGE(PG8_SB(0, 0), cB, voffB); PG8_STAGE(PG8_SA(0, 0), cA, voffA); PG8_STAGE(PG8_SB(0, 1), cB + hstep, voffB); PG8_STAGE(PG8_SA(0, 1), cA + hstep, voffA);
    if (wr == 1) PG8_BAR;
    PG8_WAIT_V(4); PG8_BAR;
    PG8_STAGE(PG8_SB(1, 0), cB + kstep, voffB); PG8_STAGE(PG8_SA(1, 0), cA + kstep, voffA); PG8_STAGE(PG8_SB(1, 1), cB + hstep + kstep, voffB);
    PG8_WAIT_V(6); PG8_BAR;
    for (;;) {
        const bool has_next = S.next(ui + 1, nxt);
        const char* nA = has_next ? (const char*)g.A + (size_t)nxt.pm * tstep : cA; const char* nB = has_next ? (const char*)g.Bt + (size_t)nxt.pn * tstep : cB;
        if constexpr (Epi::MID_T > 0) {
        for (int t = 0; t < Epi::MID_T; t += 2) {
            const bool last = (t == nt - 2);
            const char* a1 = cA + (size_t)(t + 1) * kstep;
            const char* a2 = last ? nA : cA + (size_t)(t + 2) * kstep; const char* b2 = last ? nB : cB + (size_t)(t + 2) * kstep;
            const char* a3 = a2 + kstep; const char* b3 = b2 + kstep;
            if (last && has_next) S.a_ready(nxt);
            PG8_LDB(B0, 0, 0); PG8_SCHED; PG8_LDA(At, 0, 0); PG8_STAGE(PG8_SA(1, 1), a1 + hstep, voffA);
            PG8_WAIT_L(8); PG8_BAR; PG8_WAIT_L(0); PG8_MMA(0, 0, At, B0); PG8_BAR; PG8_SCHED;
            PG8_LDB(B1, 0, 1); PG8_STAGE(PG8_SB(0, 0), b2, voffB);
            PG8_BAR; PG8_WAIT_L(0); PG8_MMA(0, 1, At, B1); PG8_BAR;
            PG8_LDA(At, 0, 1); PG8_STAGE(PG8_SA(0, 0), a2, voffA);
            PG8_BAR; PG8_WAIT_L(0); PG8_MMA(1, 0, At, B0); PG8_BAR; PG8_SCHED;
            PG8_STAGE(PG8_SB(0, 1), b2 + hstep, voffB);
            PG8_WAIT_V(6); PG8_BAR; PG8_MMA(1, 1, At, B1); PG8_BAR;
            PG8_LDB(B0, 1, 0); PG8_SCHED; PG8_LDA(At, 1, 0); PG8_STAGE(PG8_SA(0, 1), a2 + hstep, voffA);
            PG8_WAIT_L(8); PG8_BAR; PG8_WAIT_L(0); PG8_MMA(0, 0, At, B0); PG8_BAR; PG8_SCHED;
            PG8_LDB(B1, 1, 1); PG8_STAGE(PG8_SB(1, 0), b3, voffB);
            PG8_BAR; PG8_WAIT_L(0); PG8_MMA(0, 1, At, B1); PG8_BAR;
            PG8_LDA(At, 1, 1); PG8_STAGE(PG8_SA(1, 0), a3, voffA);
            PG8_BAR; PG8_WAIT_L(0); PG8_MMA(1, 0, At, B0); PG8_BAR; PG8_SCHED;
            PG8_STAGE(PG8_SB(1, 1), b3 + hstep, voffB);
            PG8_WAIT_V(6); PG8_BAR; PG8_MMA(1, 1, At, B1); PG8_BAR;
        }
        E.mid(acc, cur, wr, wc, fr, fq);
        for (int t = Epi::MID_T; t < nt; t += 2) {
            const bool last = (t == nt - 2);
            const char* a1 = cA + (size_t)(t + 1) * kstep;
            const char* a2 = last ? nA : cA + (size_t)(t + 2) * kstep; const char* b2 = last ? nB : cB + (size_t)(t + 2) * kstep;
            const char* a3 = a2 + kstep; const char* b3 = b2 + kstep;
            if (last && has_next) S.a_ready(nxt);
            PG8_LDB(B0, 0, 0); PG8_SCHED; PG8_LDA(At, 0, 0); PG8_STAGE(PG8_SA(1, 1), a1 + hstep, voffA);
            PG8_WAIT_L(8); PG8_BAR; PG8_WAIT_L(0); PG8_MMA(0, 0, At, B0); PG8_BAR; PG8_SCHED;
            PG8_LDB(B1, 0, 1); PG8_STAGE(PG8_SB(0, 0), b2, voffB);
            PG8_BAR; PG8_WAIT_L(0); PG8_MMA(0, 1, At, B1); PG8_BAR;
            PG8_LDA(At, 0, 1); PG8_STAGE(PG8_SA(0, 0), a2, voffA);
            PG8_BAR; PG8_WAIT_L(0); PG8_MMA(1, 0, At, B0); PG8_BAR; PG8_SCHED;
            PG8_STAGE(PG8_SB(0, 1), b2 + hstep, voffB);
            PG8_WAIT_V(6); PG8_BAR; PG8_MMA(1, 1, At, B1); PG8_BAR;
            PG8_LDB(B0, 1, 0); PG8_SCHED; PG8_LDA(At, 1, 0); PG8_STAGE(PG8_SA(0, 1), a2 + hstep, voffA);
            PG8_WAIT_L(8); PG8_BAR; PG8_WAIT_L(0); PG8_MMA(0, 0, At, B0); PG8_BAR; PG8_SCHED;
            PG8_LDB(B1, 1, 1); PG8_STAGE(PG8_SB(1, 0), b3, voffB);
            PG8_BAR; PG8_WAIT_L(0); PG8_MMA(0, 1, At, B1); PG8_BAR;
            PG8_LDA(At, 1, 1); PG8_STAGE(PG8_SA(1, 0), a3, voffA);
            PG8_BAR; PG8_WAIT_L(0); PG8_MMA(1, 0, At, B0); PG8_BAR; PG8_SCHED;
            PG8_STAGE(PG8_SB(1, 1), b3 + hstep, voffB);
            PG8_WAIT_V(6); PG8_BAR; PG8_MMA(1, 1, At, B1); PG8_BAR;
        }
        } else {
        for (int t = 0; t < nt; t += 2) {
            const bool last = (t == nt - 2);
            const char* a1 = cA + (size_t)(t + 1) * kstep;
            const char* a2 = last ? nA : cA + (size_t)(t + 2) * kstep; const char* b2 = last ? nB : cB + (size_t)(t + 2) * kstep;
            const char* a3 = a2 + kstep; const char* b3 = b2 + kstep;
            if (last && has_next) S.a_ready(nxt);
            PG8_LDB(B0, 0, 0); PG8_SCHED; PG8_LDA(At, 0, 0); PG8_STAGE(PG8_SA(1, 1), a1 + hstep, voffA);
            PG8_WAIT_L(8); PG8_BAR; PG8_WAIT_L(0); PG8_MMA(0, 0, At, B0); PG8_BAR; PG8_SCHED;
            PG8_LDB(B1, 0, 1); PG8_STAGE(PG8_SB(0, 0), b2, voffB);
            PG8_BAR; PG8_WAIT_L(0); PG8_MMA(0, 1, At, B1); PG8_BAR;
            PG8_LDA(At, 0, 1); PG8_STAGE(PG8_SA(0, 0), a2, voffA);
            PG8_BAR; PG8_WAIT_L(0); PG8_MMA(1, 0, At, B0); PG8_BAR; PG8_SCHED;
            PG8_STAGE(PG8_SB(0, 1), b2 + hstep, voffB);
            PG8_WAIT_V(6); PG8_BAR; PG8_MMA(1, 1, At, B1); PG8_BAR;
            PG8_LDB(B0, 1, 0); PG8_SCHED; PG8_LDA(At, 1, 0); PG8_STAGE(PG8_SA(0, 1), a2 + hstep, voffA);
            PG8_WAIT_L(8); PG8_BAR; PG8_WAIT_L(0); PG8_MMA(0, 0, At, B0); PG8_BAR; PG8_SCHED;
            PG8_LDB(B1, 1, 1); PG8_STAGE(PG8_SB(1, 0), b3, voffB);
            PG8_BAR; PG8_WAIT_L(0); PG8_MMA(0, 1, At, B1); PG8_BAR;
            PG8_LDA(At, 1, 1); PG8_STAGE(PG8_SA(1, 0), a3, voffA);
            PG8_BAR; PG8_WAIT_L(0); PG8_MMA(1, 0, At, B0); PG8_BAR; PG8_SCHED;
            PG8_STAGE(PG8_SB(1, 1), b3 + hstep, voffB);
            PG8_WAIT_V(6); PG8_BAR; PG8_MMA(1, 1, At, B1); PG8_BAR;
        }
        }
            if constexpr (!Epi::AFTER_DRAIN) { E(acc, cur, wr, wc, fr, fq); S.done(cur); }
            if (!has_next) break;
#pragma unroll
        for (int a = 0; a < 2; ++a)
#pragma unroll
            for (int b = 0; b < 2; ++b)
#pragma unroll
                for (int m = 0; m < 4; ++m)
#pragma unroll
                    for (int n = 0; n < 2; ++n) acc[a][b][m][n] = (f32x4){0.f, 0.f, 0.f, 0.f};
        cur = nxt; cA = nA; cB = nB; ++ui;
    }
    PG8_WAIT_V(0);
    if (wr == 0) PG8_BAR;
    PG8_BAR;
    if constexpr (Epi::AFTER_DRAIN) { E.fused(acc, cur, wr, wc, fr, fq, lds, wid, lane); S.done(cur); }
    if (STAMP && wid == 0) { stamps[lane] = lane < nts ? (((unsigned long long)(unsigned)ts_hi << 32) | (unsigned)ts_lo) : 0ull;
        if (lane == 62) stamps[62] = rt_entry; if (lane == 63) stamps[63] = (unsigned long long)wall_clock64(); }
#undef PG8_STAMP
#undef PG8_SA
#undef PG8_SB
#undef PG8_STAGE
#undef PG8_LDA
#undef PG8_LDB
#undef PG8_MMA
#undef PG8_WAIT_V
#undef PG8_WAIT_L
#undef PG8_BAR
#undef PG8_SCHED
}
}

typedef unsigned u32x4_ __attribute__((ext_vector_type(4)));
DEVI bf16x8 mk8(unsigned a, unsigned b, unsigned c, unsigned d) { u32x4_ v = {a, b, c, d}; return __builtin_bit_cast(bf16x8, v); }
DEVI float bflo(unsigned v) { return __uint_as_float(v << 16); }
DEVI float bfhi(unsigned v) { return __uint_as_float(v & 0xffff0000u); }
struct EpiProj {
  static constexpr bool PERM = true, AFTER_DRAIN = false; static constexpr int MID_T = 0;
  us *projA, *projB;
  DEVI void operator()(const f32x4 (&acc)[2][2][4][2], const pg8::Unit& u, int wr, int wc, int fr, int fq) const {
    const int row0 = u.pm * 256 + wr * 64 + fr;
#pragma unroll
    for (int bj = 0; bj < 2; ++bj) {
      const int nb = u.pn * 256 + bj * 128 + wc * 32;
      if (nb >= 5152) continue;
      us* dst; int ld, col, act;
      if (nb < 416) { dst = projA; ld = LDA_; col = nb; act = 0; }
      else if (nb < 928) { dst = projB; ld = LDB_; col = nb - 416; act = 1; }
      else if (nb < 2592) { dst = projA; ld = LDA_; col = nb - 928 + 416; act = 0; }
      else if (nb < 3104) { dst = projB; ld = LDB_; col = nb - 2592 + 512; act = 1; }
      else { dst = projB; ld = LDB_; col = nb - 3104 + 1024; act = 2; }
#pragma unroll
      for (int ai = 0; ai < 2; ++ai)
#pragma unroll
        for (int m = 0; m < 4; ++m) {
          f32x4 v0 = acc[ai][bj][m][0], v1 = acc[ai][bj][m][1];
          if (act == 1) {
#pragma unroll
            for (int r = 0; r < 4; ++r) { v0[r] = siluf_(v0[r]); v1[r] = siluf_(v1[r]); }
          } else if (act == 2) {
#pragma unroll
            for (int r = 0; r < 4; ++r) { v0[r] = sigmoidf_(v0[r]); v1[r] = sigmoidf_(v1[r]); }
          }
          uint4 o; o.x = pack2(v0[0], v0[1]); o.y = pack2(v0[2], v0[3]); o.z = pack2(v1[0], v1[1]); o.w = pack2(v1[2], v1[3]);
          __builtin_nontemporal_store(u32x4_{o.x, o.y, o.z, o.w}, (u32x4_*)(dst + (size_t)(row0 + ai * 128 + m * 16) * ld + col + 8 * fq));
        }
    }
  }
};
__device__ void phase2(const Params& p, unsigned char* smraw) {
  pg8::Gemm g{p.h, p.Wt_in, T_TOK, 5376, 1024};
  pg8::StaticOrder S; S.init(g.M, g.N, (int)gridDim.x, (int)blockIdx.x);
  EpiProj E{p.projA, p.projB};
  pg8::gemm_phase<EpiProj, pg8::StaticOrder, false>((PG8_LAS unsigned char*)smraw, g, S, E, nullptr);
}

#define REG_(i) ((us*)(smraw + (i) * 9216))
DEVI f32x4 mm_tile(const us* A, const us* B, int mt, int nt, int fr, int fq, f32x4 acc) {
#pragma unroll
  for (int ks = 0; ks < 2; ++ks) {
    bf16x8 a = *(const bf16x8*)(A + (mt * 16 + fr) * 72 + ks * 32 + fq * 8);
    bf16x8 b = *(const bf16x8*)(B + (nt * 16 + fr) * 72 + ks * 32 + fq * 8);
    acc = mfma16(a, b, acc);
  }
  return acc;
}
typedef short v4s_ __attribute__((ext_vector_type(4)));
DEVI bf16x8 frag_tr(const us* X, int r0, int ks, int lane) {
  const int grp = lane >> 4, i = lane & 15;
  const us* a0 = X + (ks * 32 + 8 * grp + (i >> 2)) * 72 + r0 + 4 * (i & 3);
  const v4s_ lo = __builtin_amdgcn_ds_read_tr16_b64_v4i16((__attribute__((address_space(3))) v4s_*)a0);
  const v4s_ hi = __builtin_amdgcn_ds_read_tr16_b64_v4i16((__attribute__((address_space(3))) v4s_*)(a0 + 4 * 72));
  return bf16x8{lo[0], lo[1], lo[2], lo[3], hi[0], hi[1], hi[2], hi[3]};
}
template <bool TA, bool TB>
DEVI f32x4 mm_tile_x(const us* A, const us* B, int mt, int nt, int lane, f32x4 acc) {
  const int fr = lane & 15, fq = lane >> 4;
#pragma unroll
  for (int ks = 0; ks < 2; ++ks) {
    const bf16x8 a = TA ? frag_tr(A, mt * 16, ks, lane) : *(const bf16x8*)(A + (mt * 16 + fr) * 72 + ks * 32 + fq * 8);
    const bf16x8 b = TB ? frag_tr(B, nt * 16, ks, lane) : *(const bf16x8*)(B + (nt * 16 + fr) * 72 + ks * 32 + fq * 8);
    acc = mfma16(a, b, acc);
  }
  return acc;
}
DEVI void storeT_nt(us* dst, int ld, int mt, int nt, int fr, int fq, f32x4 v) {
  const uint2 q = pack4(v);
  __builtin_nontemporal_store(u32x2n_{q.x, q.y}, (u32x2n_*)(dst + (nt * 16 + fr) * ld + mt * 16 + fq * 4));
}
DEVI void storeT(us* dst, int ld, int mt, int nt, int fr, int fq, f32x4 v) {
  *(uint2*)(dst + (nt * 16 + fr) * ld + mt * 16 + fq * 4) = pack4(v);
}
DEVI f32x4 maskv(f32x4 v, int mt, int nt, int fr, int fq, int mode) {
  const int n = nt * 16 + fr, m0 = mt * 16 + fq * 4;
#pragma unroll
  for (int r = 0; r < 4; ++r) {
    const int m = m0 + r;
    bool keep = (mode == 0) ? (m < n) : (mode == 1) ? (m <= n) : (n < m);
    if (!keep) v[r] = 0.f;
  }
  return v;
}
struct WkvRaw { bf16x8 cur[5], prv[5]; };
DEVI void wkv_load_raw(const Params& p, int item, WkvRaw& R) {
  const int tid = tidx();
  const int h = item & 7, bc = item >> 3, b = bc >> 6, c = bc & 63;
  const int t = tid >> 3, j0 = (tid & 7) * 8, jc = h * 64 + j0;
  const bool hp = (c * 64 + t) > 0;
  const us* rowp = p.projA + (size_t)(b * SEQ + c * 64 + t) * LDA_ + 416;
  const int offs[5] = {jc, 512 + jc, 1024 + jc, 1536 + j0, 1600 + j0};
#pragma unroll
  for (int q = 0; q < 5; ++q) {
    R.cur[q] = *(const bf16x8*)(rowp + offs[q]);
    R.prv[q] = hp ? *(const bf16x8*)(rowp + offs[q] - LDA_) : R.cur[q];
  }
}
DEVI void shift8(bf16x8 cur, bf16x8 prv, bool hasprev, const float* mu, float (&o)[8]) {
  const float4 m0 = *(const float4*)mu, m1 = *(const float4*)(mu + 4);
  const float mm[8] = {m0.x, m0.y, m0.z, m0.w, m1.x, m1.y, m1.z, m1.w};
#pragma unroll
  for (int e = 0; e < 8; ++e) {
    float cv = bf2f((us)cur[e]);
    float pv = hasprev ? bf2f((us)prv[e]) : 0.f;
    o[e] = cv + (pv - cv) * mm[e];
  }
}
DEVI void ld8f(const float* ptr, float (&o)[8]) {
  const float4 a = *(const float4*)ptr, b = *(const float4*)(ptr + 4);
  o[0] = a.x; o[1] = a.y; o[2] = a.z; o[3] = a.w; o[4] = b.x; o[5] = b.y; o[6] = b.z; o[7] = b.w;
}
DEVI float fast_tanh(float x) { const float e = __builtin_amdgcn_exp2f(2.8853900817779268f * x); return 1.f - 2.f * __builtin_amdgcn_rcpf(e + 1.f); }

__device__ void wkv_prep_item(const Params& p, int item, int next_item, WkvRaw& RW, unsigned char* smraw) {
  const int tid = tidx(), lane = tid & 63, w = tid >> 6, fr = lane & 15, fq = lane >> 4;
  const int h = item & 7, bc = item >> 3, b = bc >> 6, c = bc & 63;
  const int ch = (b * 8 + h) * 64 + c;
  const int tok0 = b * SEQ + c * 64;
  const int t = tid >> 3, j0 = (tid & 7) * 8, jc = h * 64 + j0;
  const f32x4 z4 = {0.f, 0.f, 0.f, 0.f};
  us *At = REG_(0), *Bt = REG_(1), *Kt = REG_(2), *Rt = REG_(3), *BhT = REG_(4), *KhT = REG_(5), *VT = REG_(6);
  us *P0 = REG_(7), *PT0 = REG_(8), *P1 = REG_(9), *PT1 = REG_(10), *Aak = REG_(11), *Arb = REG_(12), *Ark = REG_(13);
  us* UT = REG_(14);
  float* F = (float*)REG_(9);
  float* G = (float*)REG_(14);
  float* segsum = (float*)(smraw + 16 * 9216);

  float rr[8], kk_[8], vv[8], wd[8], ad[8];
  {
    const bool hp = (c * 64 + t) > 0;
    shift8(RW.cur[0], RW.prv[0], hp, p.mu + jc, rr);
    shift8(RW.cur[1], RW.prv[1], hp, p.mu + 512 + jc, kk_);
    shift8(RW.cur[2], RW.prv[2], hp, p.mu + 1024 + jc, vv);
    shift8(RW.cur[3], RW.prv[3], hp, p.mu + 1536 + j0, wd);
    shift8(RW.cur[4], RW.prv[4], hp, p.mu + 1600 + j0, ad);
  }
  {
    uint4 o1, o2;
    o1.x = pack2(fast_tanh(wd[0]), fast_tanh(wd[1])); o1.y = pack2(fast_tanh(wd[2]), fast_tanh(wd[3]));
    o1.z = pack2(fast_tanh(wd[4]), fast_tanh(wd[5])); o1.w = pack2(fast_tanh(wd[6]), fast_tanh(wd[7]));
    o2.x = pack2(ad[0], ad[1]); o2.y = pack2(ad[2], ad[3]); o2.z = pack2(ad[4], ad[5]); o2.w = pack2(ad[6], ad[7]);
    *(uint4*)(P0 + t * 72 + j0) = o1;
    *(uint4*)(PT0 + t * 72 + j0) = o2;
  }
  lds_barrier();
  {
    const int which = w >> 2, tt = w & 3;
    const us* A = which ? PT0 : P0;
    const us* Wt = (which ? p.Wt_icl : p.Wt_dec) + (size_t)h * 64 * 64;
    float* Fw = F + which * 4160;
#pragma unroll
    for (int jt = 0; jt < 4; ++jt) {
      f32x4 acc = z4;
#pragma unroll
      for (int ks = 0; ks < 2; ++ks) {
        bf16x8 a = *(const bf16x8*)(A + (tt * 16 + fr) * 72 + ks * 32 + fq * 8);
        bf16x8 bq = *(const bf16x8*)(Wt + (jt * 16 + fr) * 64 + ks * 32 + fq * 8);
        acc = mfma16(a, bq, acc);
      }
#pragma unroll
      for (int r = 0; r < 4; ++r) Fw[(tt * 16 + fq * 4 + r) * 65 + jt * 16 + fr] = acc[r];
    }
  }
  lds_barrier();
  float lw[8], av[8], kn[8], kp[8];
  {
    float ss = 0.f;
    float pw0[8], pa0[8], pkk[8], pka[8];
    ld8f(p.w0 + jc, pw0); ld8f(p.a0 + jc, pa0); ld8f(p.k_k + jc, pkk); ld8f(p.k_a + jc, pka);
#pragma unroll
    for (int e = 0; e < 8; ++e) {
      float dl = pw0[e] + F[t * 65 + j0 + e];
      float al = pa0[e] + F[4160 + t * 65 + j0 + e];
      float xneg = -dl;
      float sp = fmaxf(xneg, 0.f) + __logf(1.f + __expf(-fabsf(xneg)));
      float wl = -sp - 0.5f;
      lw[e] = -__expf(wl);
      av[e] = sigmoidf_(al);
      float kq = kk_[e] * pkk[e];
      kn[e] = kq;
      ss += kq * kq;
      kp[e] = kk_[e] * (1.f + (av[e] - 1.f) * pka[e]);
    }
    ss += __shfl_xor(ss, 1); ss += __shfl_xor(ss, 2); ss += __shfl_xor(ss, 4);
    const float inv = 1.f / fmaxf(sqrtf(ss), 1e-12f);
    float bon = 0.f;
    float prk[8];
    ld8f(p.r_k + jc, prk);
#pragma unroll
    for (int e = 0; e < 8; ++e) {
      kn[e] *= inv;
      bon += rr[e] * kp[e] * prk[e];
    }
    bon += __shfl_xor(bon, 1); bon += __shfl_xor(bon, 2); bon += __shfl_xor(bon, 4);
    uint4 o;
    o.x = pack2(bon * vv[0], bon * vv[1]); o.y = pack2(bon * vv[2], bon * vv[3]);
    o.z = pack2(bon * vv[4], bon * vv[5]); o.w = pack2(bon * vv[6], bon * vv[7]);
    __builtin_nontemporal_store(u32x4_{o.x, o.y, o.z, o.w}, (u32x4_*)(p.bv + (size_t)(tok0 + t) * 512 + jc));
  }
  lds_barrier();
#pragma unroll
  for (int e = 0; e < 8; ++e) G[t * 65 + j0 + e] = lw[e];
  lds_barrier();
  {
    const int j = tid & 63, seg = tid >> 6;
    float run = 0.f;
#pragma unroll
    for (int i = 0; i < 8; ++i) { run += G[(seg * 8 + i) * 65 + j]; G[(seg * 8 + i) * 65 + j] = run; }
    segsum[seg * 64 + j] = run;
    lds_barrier();
    float off = 0.f;
    for (int s2 = 0; s2 < seg; ++s2) off += segsum[s2 * 64 + j];
#pragma unroll
    for (int i = 0; i < 8; ++i) G[(seg * 8 + i) * 65 + j] += off;
  }
  lds_barrier();
  {
    float ta[8], tb[8], tk[8], tr[8], tbh[8], tkh[8];
#pragma unroll
    for (int e = 0; e < 8; ++e) {
      const float g = G[t * 65 + j0 + e], gC = G[63 * 65 + j0 + e];
      const float eg = __expf(g), eng = __expf(-g), egx = __expf(g - lw[e]), egc = __expf(gC - g);
      ta[e] = -kn[e] * egx;
      tb[e] = kn[e] * av[e] * eng;
      tk[e] = kp[e] * eng;
      tr[e] = rr[e] * eg;
      tbh[e] = kn[e] * av[e] * egc;
      tkh[e] = kp[e] * egc;
      if (t == 0) p.Gc[ch * 64 + j0 + e] = __expf(gC);
    }
    uint4 o;
    o.x = pack2(ta[0], ta[1]); o.y = pack2(ta[2], ta[3]); o.z = pack2(ta[4], ta[5]); o.w = pack2(ta[6], ta[7]);
    *(uint4*)(At + t * 72 + j0) = o;
    o.x = pack2(tb[0], tb[1]); o.y = pack2(tb[2], tb[3]); o.z = pack2(tb[4], tb[5]); o.w = pack2(tb[6], tb[7]);
    *(uint4*)(Bt + t * 72 + j0) = o;
    o.x = pack2(tk[0], tk[1]); o.y = pack2(tk[2], tk[3]); o.z = pack2(tk[4], tk[5]); o.w = pack2(tk[6], tk[7]);
    *(uint4*)(Kt + t * 72 + j0) = o;
    o.x = pack2(tr[0], tr[1]); o.y = pack2(tr[2], tr[3]); o.z = pack2(tr[4], tr[5]); o.w = pack2(tr[6], tr[7]);
    *(uint4*)(Rt + t * 72 + j0) = o;
    o.x = pack2(tbh[0], tbh[1]); o.y = pack2(tbh[2], tbh[3]); o.z = pack2(tbh[4], tbh[5]); o.w = pack2(tbh[6], tbh[7]);
    *(uint4*)(BhT + t * 72 + j0) = o;
    o.x = pack2(tkh[0], tkh[1]); o.y = pack2(tkh[2], tkh[3]); o.z = pack2(tkh[4], tkh[5]); o.w = pack2(tkh[6], tkh[7]);
    *(uint4*)(KhT + t * 72 + j0) = o;
    o.x = pack2(vv[0], vv[1]); o.y = pack2(vv[2], vv[3]); o.z = pack2(vv[4], vv[5]); o.w = pack2(vv[6], vv[7]);
    *(uint4*)(VT + t * 72 + j0) = o;
  }
  lds_barrier();
#pragma unroll
  for (int q = 0; q < 2; ++q) {
    const int id = w * 2 + q, mt = id >> 2, nt = id & 3;
    storeT(P0, 72, mt, nt, fr, fq, maskv(mm_tile(Bt, At, mt, nt, fr, fq, z4), mt, nt, fr, fq, 0));
  }
  lds_barrier();
  us* Tb = PT0;
  us* UTw = UT + w * 16 * 72;
  if (w == 0) {
    const int blk = lane >> 4, cc = lane & 15;
    float Tc[16];
#pragma unroll
    for (int r = 0; r < 16; ++r) Tc[r] = 0.f;
#pragma unroll
    for (int r = 0; r < 16; ++r) {
      float v = (r == cc) ? 1.f : 0.f;
      if (r > 0) {
        const us* arow = P0 + (blk * 16 + r) * 72 + blk * 16;
        const uint4 lo = *(const uint4*)arow;
        const uint4 hi = *(const uint4*)(arow + 8);
        const unsigned wv[8] = {lo.x, lo.y, lo.z, lo.w, hi.x, hi.y, hi.z, hi.w};
#pragma unroll
        for (int s2 = 0; s2 < r; ++s2) v += ((s2 & 1) ? bfhi(wv[s2 >> 1]) : bflo(wv[s2 >> 1])) * Tc[s2];
      }
      Tc[r] = v;
    }
#pragma unroll
    for (int r = 0; r < 16; ++r) Tb[blk * 256 + r * 16 + cc] = f2bf(Tc[r]);
  } else {
    for (int L = w - 1; L < 48; L += 7) {
      const int which = L >> 4, id = L & 15, mt = id >> 2, nt = id & 3;
      if (which == 0) storeT(Aak, 72, mt, nt, fr, fq, maskv(mm_tile(Kt, At, mt, nt, fr, fq, z4), mt, nt, fr, fq, 0));
      else if (which == 1) storeT(Arb, 72, mt, nt, fr, fq, maskv(mm_tile(Bt, Rt, mt, nt, fr, fq, z4), mt, nt, fr, fq, 1));
      else storeT(Ark, 72, mt, nt, fr, fq, maskv(mm_tile(Kt, Rt, mt, nt, fr, fq, z4), mt, nt, fr, fq, 1));
    }
  }
  {
    const uint4 zz = make_uint4(0u, 0u, 0u, 0u);
    *(uint4*)(UTw + (lane >> 2) * 72 + (lane & 3) * 16) = zz;
    *(uint4*)(UTw + (lane >> 2) * 72 + (lane & 3) * 16 + 8) = zz;
  }
  lds_barrier();
  if (next_item < 4096) wkv_load_raw(p, next_item, RW);
  {
    f32x4 zI[4];
    if (w >= 4) {
#pragma unroll
      for (int I = 0; I < 4; ++I) zI[I] = mm_tile_x<false, true>(Aak, VT, I, w - 4, lane, z4);
    } else {
#pragma unroll
      for (int I = 0; I < 4; ++I)
#pragma unroll
        for (int r = 0; r < 4; ++r) zI[I][r] = bf2f(At[(I * 16 + fq * 4 + r) * 72 + w * 16 + fr]);
    }
#pragma unroll
    for (int I = 0; I < 4; ++I) {
      f32x4 rhs = zI[I];
      if (I >= 1) {
#pragma unroll
        for (int ks = 0; ks < (I == 3 ? 2 : 1); ++ks) {
          const bf16x8 a = *(const bf16x8*)(P0 + (I * 16 + fr) * 72 + ks * 32 + fq * 8);
          const bf16x8 b = *(const bf16x8*)(UTw + fr * 72 + ks * 32 + fq * 8);
          rhs = mfma16(a, b, rhs);
        }
      }
      const uint2 tq = *(const uint2*)(Tb + I * 256 + fr * 16 + fq * 4);
      const uint2 rq = pack4(rhs);
      const f32x4 uI = mfma16(mk8(tq.x, tq.y, 0u, 0u), mk8(rq.x, rq.y, 0u, 0u), z4);
      *(uint2*)(UTw + fr * 72 + I * 16 + fq * 4) = pack4(uI);
    }
  }
  lds_barrier();
  {
    const int o = w >> 1;
    const us* U1 = UT;
    const us* U0 = UT + 64 * 72;
    for (int q = 0; q < 8; ++q) {
      const int id = (w & 1) * 8 + q, mt = id >> 2, nt = id & 3;
      if (o == 0) {
        f32x4 cc = mm_tile_x<false, true>(U1, BhT, mt, nt, lane, z4);
        storeT_nt(p.Mp + (size_t)ch * 4096, 64, mt, nt, fr, fq, cc);
      } else if (o == 1) {
        f32x4 cc = mm_tile_x<true, false>(BhT, U0, mt, nt, lane, z4);
        cc = mm_tile_x<true, true>(KhT, VT, mt, nt, lane, cc);
        storeT_nt(p.Nt + (size_t)ch * 4096, 64, mt, nt, fr, fq, cc);
      } else if (o == 2) {
        f32x4 cc = mm_tile(U1, Arb, mt, nt, fr, fq, z4);
#pragma unroll
        for (int r = 0; r < 4; ++r) cc[r] += bf2f(Rt[(nt * 16 + fr) * 72 + mt * 16 + fq * 4 + r]);
        storeT_nt(p.Y1 + (size_t)ch * 4096, 64, mt, nt, fr, fq, cc);
      } else {
        f32x4 cc = mm_tile(U0, Arb, mt, nt, fr, fq, z4);
        cc = mm_tile_x<true, false>(VT, Ark, mt, nt, lane, cc);
        storeT_nt(p.Y0t + (size_t)ch * 4096, 64, mt, nt, fr, fq, cc);
      }
    }
  }
  lds_barrier();
}

#define P3_COMMON \
  us* sm = (us*)smraw; \
  float* rs = (float*)(smraw + 2 * GST * 2); \
  const int tid = tidx(), lane = tid & 63, wid = tid >> 6; \
  const int wx = wid >> 2, wy = wid & 3, fr = lane & 15, fq = lane >> 4;
__device__ void phase3q(const Params& p, unsigned char* smraw) {
  P3_COMMON
  for (int it = blockIdx.x; it < 6 * 128; it += gridDim.x) {
    {
      const int yt = it / 6, xt = it % 6, x0 = xt * 128, y0 = yt * 256;
      f32x4 acc[4][4];
      zero_acc(acc);
      gemm_main<true>(p.Wt_uq + (size_t)x0 * 256, 256, p.projA + (size_t)y0 * LDA_, LDA_, 256, sm, acc, rs, 1.f / 256.f, 1e-6f);
#pragma unroll
      for (int j = 0; j < 4; ++j) {
        const int tl = wy * 64 + j * 16 + fr, tk = y0 + tl;
        const float rstd = rs[tl];
        const int bb = tk >> 12, s = tk & 4095;
#pragma unroll
        for (int i = 0; i < 4; ++i) {
          const int nb = x0 + wx * 64 + i * 16;
          const int hd = nb / 96, dq = nb % 96;
          us* qrow = p.Q + ((size_t)(bb * 8 + hd) * SEQ + s) * 96;
          if (dq < 64) {
            f32x4 v = acc[i][j] * rstd;
            *(uint2*)(qrow + dq + fq * 4) = pack4(v);
          } else if (dq == 64) {
            if (i < 3) {
              f32x4 t1 = acc[i][j] * rstd, t2 = acc[(i + 1) & 3][j] * rstd, o1, o2;
              const float4 cv = *(const float4*)(p.cs + (size_t)tk * 32 + fq * 4);
              const float4 sv = *(const float4*)(p.cs + (size_t)tk * 32 + 16 + fq * 4);
              o1[0] = t1[0] * cv.x - t2[0] * sv.x; o2[0] = t1[0] * sv.x + t2[0] * cv.x;
              o1[1] = t1[1] * cv.y - t2[1] * sv.y; o2[1] = t1[1] * sv.y + t2[1] * cv.y;
              o1[2] = t1[2] * cv.z - t2[2] * sv.z; o2[2] = t1[2] * sv.z + t2[2] * cv.z;
              o1[3] = t1[3] * cv.w - t2[3] * sv.w; o2[3] = t1[3] * sv.w + t2[3] * cv.w;
              *(uint2*)(qrow + 64 + fq * 4) = pack4(o1);
              *(uint2*)(qrow + 80 + fq * 4) = pack4(o2);
            }
          }
        }
      }
      lds_barrier();
    }
  }
}
__device__ void phase3kv(const Params& p, unsigned char* smraw) {
  P3_COMMON
  for (int it = blockIdx.x; it < 8 * 128; it += gridDim.x) {
    {
      const int r = it, yt = r >> 3, xt = r & 7, x0 = xt * 128, y0 = yt * 256;
      f32x4 acc[4][4];
      zero_acc(acc);
      gemm_main<true, true>(p.Wt_ukv + (size_t)x0 * 128, 128, p.projA + (size_t)y0 * LDA_ + 256, LDA_, 128, sm, acc, rs, 1.f / 128.f, 1e-6f);
      const int hd = xt;
      if (wx == 0) {
#pragma unroll
        for (int j = 0; j < 4; ++j) {
          const int tl = wy * 64 + j * 16 + fr, tk = y0 + tl;
          const float rstd = rs[tl];
          const int bb = tk >> 12, s = tk & 4095;
#pragma unroll
          for (int i = 0; i < 4; ++i) {
            f32x4 v = acc[i][j] * rstd;
            *(uint2*)(p.K + ((size_t)(bb * 8 + hd) * SEQ + s) * 96 + i * 16 + fq * 4) = pack4(v);
          }
        }
      } else {
#pragma unroll
        for (int j = 0; j < 4; ++j) {
          const int tl0 = wy * 64 + j * 16 + fq * 4, tk0 = y0 + tl0;
          const f32x4 r4 = *(const f32x4*)(rs + tl0);
          const int bb = tk0 >> 12, s0 = tk0 & 4095;
#pragma unroll
          for (int i = 0; i < 4; ++i) {
            f32x4 v = acc[i][j] * r4;
            *(uint2*)(p.Vt + ((size_t)(bb * 8 + hd) * 64 + i * 16 + fr) * SEQ + s0) = pack4(v);
          }
        }
      }
      lds_barrier();
    }
  }
}
__device__ void phase3w(const Params& p, unsigned char* smraw) {
  const int tid = tidx();
  {
    WkvRaw RW;
    if ((int)blockIdx.x < 4096) wkv_load_raw(p, blockIdx.x, RW);
    for (int it = blockIdx.x; it < 4096; it += gridDim.x) wkv_prep_item(p, it, it + (int)gridDim.x, RW, smraw);
  }
  const int gt = blockIdx.x * NTHR + tid, gs = gridDim.x * NTHR;
  for (int i = gt; i < T_TOK * 16; i += gs) {
    const int tk = i >> 4, pi = i & 15;
    const float k1 = bf2f(p.projA[(size_t)tk * LDA_ + 384 + pi]), k2 = bf2f(p.projA[(size_t)tk * LDA_ + 400 + pi]);
    const float cv = p.cs[tk * 32 + pi], sv = p.cs[tk * 32 + 16 + pi];
    const us o1 = f2bf(k1 * cv - k2 * sv), o2 = f2bf(k1 * sv + k2 * cv);
    const int bb = tk >> 12, s = tk & 4095;
#pragma unroll
    for (int hd = 0; hd < 8; ++hd) {
      us* kr = p.K + ((size_t)(bb * 8 + hd) * SEQ + s) * 96;
      kr[64 + pi] = o1;
      kr[80 + pi] = o2;
    }
  }
}

typedef unsigned u32x2_ __attribute__((ext_vector_type(2)));
struct ScanLd { u32x4_ a[4][2]; f32x4 g[4]; u32x2_ nn[4]; };
DEVI void scan_load(const Params& p, size_t ch, int vs, int fr, int fq, ScanLd& L) {
  const us* mp = p.Mp + ch * 4096;
  const us* nt = p.Nt + ch * 4096 + (vs * 16 + fr) * 64 + fq * 4;
  const float* gc = p.Gc + ch * 64 + fq * 4;
#pragma unroll
  for (int m = 0; m < 4; ++m) {
    L.g[m] = *(const f32x4*)(gc + m * 16);
    L.nn[m] = *(const u32x2_*)(nt + m * 16);
#pragma unroll
    for (int ks = 0; ks < 2; ++ks) {
      const u32x2_ lo = *(const u32x2_*)(mp + (m * 16 + fr) * 64 + ks * 32 + fq * 4);
      const u32x2_ hi = *(const u32x2_*)(mp + (m * 16 + fr) * 64 + ks * 32 + 16 + fq * 4);
      L.a[m][ks] = u32x4_{lo[0], lo[1], hi[0], hi[1]};
    }
  }
}
DEVI void scan_step(f32x4 (&H)[4], const ScanLd& L) {
  bf16x8 bop[2];
#pragma unroll
  for (int ks = 0; ks < 2; ++ks) {
    uint2 lo = pack4(H[2 * ks]), hi = pack4(H[2 * ks + 1]);
    bop[ks] = mk8(lo.x, lo.y, hi.x, hi.y);
  }
#pragma unroll
  for (int m = 0; m < 4; ++m) {
    f32x4 hn;
    hn[0] = L.g[m][0] * H[m][0] + bflo(L.nn[m][0]);
    hn[1] = L.g[m][1] * H[m][1] + bfhi(L.nn[m][0]);
    hn[2] = L.g[m][2] * H[m][2] + bflo(L.nn[m][1]);
    hn[3] = L.g[m][3] * H[m][3] + bfhi(L.nn[m][1]);
#pragma unroll
    for (int ks = 0; ks < 2; ++ks) hn = mfma16(__builtin_bit_cast(bf16x8, L.a[m][ks]), bop[ks], hn);
    H[m] = hn;
  }
}
DEVI void scan_store(const Params& p, size_t ch, int vs, int fr, int fq, const f32x4 (&H)[4]) {
  us* hh = p.Hh + ch * 4096 + (vs * 16 + fr) * 64 + fq * 4;
#pragma unroll
  for (int m = 0; m < 4; ++m) { const uint2 q = pack4(H[m]); __builtin_nontemporal_store(u32x2n_{q.x, q.y}, (u32x2n_*)(hh + m * 16)); }
}
__device__ void wkv_scan_item(const Params& p, int item) {
  const int lane = tidx() & 63, fr = lane & 15, fq = lane >> 4;
  const int bh = item >> 2, vs = item & 3;
  const size_t ch0 = (size_t)bh * 64;
  f32x4 H[4];
#pragma unroll
  for (int m = 0; m < 4; ++m) H[m] = f32x4{0.f, 0.f, 0.f, 0.f};
  ScanLd L0, L1, L2;
  scan_load(p, ch0, vs, fr, fq, L0);
  scan_load(p, ch0 + 1, vs, fr, fq, L1);
  scan_load(p, ch0 + 2, vs, fr, fq, L2);
  for (int c = 0; c < 63; c += 3) {
    scan_store(p, ch0 + c, vs, fr, fq, H); scan_step(H, L0); scan_load(p, ch0 + min(c + 3, 62), vs, fr, fq, L0);
    scan_store(p, ch0 + c + 1, vs, fr, fq, H); scan_step(H, L1); scan_load(p, ch0 + min(c + 4, 62), vs, fr, fq, L1);
    scan_store(p, ch0 + c + 2, vs, fr, fq, H); scan_step(H, L2); scan_load(p, ch0 + min(c + 5, 62), vs, fr, fq, L2);
  }
  scan_store(p, ch0 + 63, vs, fr, fq, H);
}

constexpr int SC_G = 6, SC_NT = 64 * 144, SC_GC = SC_NT + 16 * 144, SC_SLOT = SC_GC + 256, SC_NGRP = 11;
__device__ void wkv_scan_block(const Params& p, int item, unsigned char* smraw) {
  const int tid = tidx(), lane = tid & 63, w = tid >> 6, fr = lane & 15, fq = lane >> 4;
  const int bh = item >> 2, vs = item & 3;
  const size_t ch0 = (size_t)bh * 64;
  bf16x8 gm[SC_G], gn[2];
  f32x4 gg;
  const int mrow = tid >> 3, mcol = (tid & 7) * 8;
  int nslot[2], nrow[2], ncol[2];
#pragma unroll
  for (int q = 0; q < 2; ++q) { const int id = tid + 512 * q; nslot[q] = id >> 7; nrow[q] = (id & 127) >> 3; ncol[q] = (id & 7) * 8; }
  const int gslot = tid >> 4, gcol = (tid & 15) * 4;
#define SC_LOAD(g0) { \
    _Pragma("unroll") for (int q = 0; q < SC_G; ++q) gm[q] = *(const bf16x8*)(p.Mp + (ch0 + min((g0) + q, 62)) * 4096 + mrow * 64 + mcol); \
    _Pragma("unroll") for (int q = 0; q < 2; ++q) if (tid + 512 * q < SC_G * 128) \
      gn[q] = *(const bf16x8*)(p.Nt + (ch0 + min((g0) + nslot[q], 62)) * 4096 + (vs * 16 + nrow[q]) * 64 + ncol[q]); \
    if (tid < SC_G * 16) gg = *(const f32x4*)(p.Gc + (ch0 + min((g0) + gslot, 62)) * 64 + gcol); }
#define SC_WRITE(buf) { unsigned char* bb = smraw + (buf) * (SC_G * SC_SLOT); \
    _Pragma("unroll") for (int q = 0; q < SC_G; ++q) *(bf16x8*)(bb + q * SC_SLOT + mrow * 144 + mcol * 2) = gm[q]; \
    _Pragma("unroll") for (int q = 0; q < 2; ++q) if (tid + 512 * q < SC_G * 128) \
      *(bf16x8*)(bb + nslot[q] * SC_SLOT + SC_NT + nrow[q] * 144 + ncol[q] * 2) = gn[q]; \
    if (tid < SC_G * 16) *(f32x4*)(bb + gslot * SC_SLOT + SC_GC + gcol * 4) = gg; }
  f32x4 H[4];
#pragma unroll
  for (int m = 0; m < 4; ++m) H[m] = f32x4{0.f, 0.f, 0.f, 0.f};
  SC_LOAD(0)
  SC_WRITE(0)
  lds_barrier();
  for (int g = 0; g < SC_NGRP; ++g) {
    if (g + 1 < SC_NGRP) SC_LOAD((g + 1) * SC_G)
    if (w == 0) {
      const unsigned char* bb = smraw + (g & 1) * (SC_G * SC_SLOT);
#pragma unroll
      for (int q = 0; q < SC_G; ++q) {
        const int c = g * SC_G + q;
        if (c < 63) {
          scan_store(p, ch0 + c, vs, fr, fq, H);
          const unsigned char* sl = bb + q * SC_SLOT;
          bf16x8 bop[2];
#pragma unroll
          for (int ks = 0; ks < 2; ++ks) {
            const uint2 lo = pack4(H[2 * ks]), hi = pack4(H[2 * ks + 1]);
            bop[ks] = mk8(lo.x, lo.y, hi.x, hi.y);
          }
#pragma unroll
          for (int m = 0; m < 4; ++m) {
            const f32x4 gv = *(const f32x4*)(sl + SC_GC + (m * 16 + fq * 4) * 4);
            const uint2 nn = *(const uint2*)(sl + SC_NT + fr * 144 + (m * 16 + fq * 4) * 2);
            f32x4 hn;
            hn[0] = gv[0] * H[m][0] + bflo(nn.x); hn[1] = gv[1] * H[m][1] + bfhi(nn.x);
            hn[2] = gv[2] * H[m][2] + bflo(nn.y); hn[3] = gv[3] * H[m][3] + bfhi(nn.y);
#pragma unroll
            for (int ks = 0; ks < 2; ++ks) {
              const uint2 lo = *(const uint2*)(sl + (m * 16 + fr) * 144 + (ks * 32 + fq * 4) * 2);
              const uint2 hi = *(const uint2*)(sl + (m * 16 + fr) * 144 + (ks * 32 + 16 + fq * 4) * 2);
              hn = mfma16(mk8(lo.x, lo.y, hi.x, hi.y), bop[ks], hn);
            }
            H[m] = hn;
          }
        }
      }
    }
    if (g + 1 < SC_NGRP) SC_WRITE((g + 1) & 1)
    lds_barrier();
  }
  if (w == 0) scan_store(p, ch0 + 63, vs, fr, fq, H);
#undef SC_LOAD
#undef SC_WRITE
}

constexpr int AKS = 104, AVS = 68, ASTG = 64 * AKS + 64 * AVS;
__device__ void attn_item(const Params& p, int bh, int qt, unsigned char* smraw) {
  us* sm = (us*)smraw;
  const int tid = tidx(), lane = tid & 63, w = tid >> 6, c = lane & 31, hh = lane >> 5;
  const int pr = w >> 1, sub = w & 1;
  const int q0 = qt * 256;
  const us* Kg = p.K + (size_t)bh * SEQ * 96;
  const us* Vg = p.Vt + (size_t)bh * 64 * SEQ;
  bf16x8 qf[2][6];
#pragma unroll
  for (int qs = 0; qs < 2; ++qs) {
    const us* qb = p.Q + ((size_t)bh * SEQ + q0 + pr * 64 + qs * 32 + c) * 96 + 8 * hh;
#pragma unroll
    for (int s = 0; s < 6; ++s) qf[qs][s] = *(const bf16x8*)(qb + 16 * s);
  }
  const int nkt = q0 / 64 + 4, mylim = q0 / 64 + pr;
  f32x16 ot[2][2];
#pragma unroll
  for (int a = 0; a < 2; ++a)
#pragma unroll
    for (int b = 0; b < 2; ++b)
#pragma unroll
      for (int r = 0; r < 16; ++r) ot[a][b][r] = 0.f;
  float mrun[2] = {-1e30f, -1e30f}, lrun[2] = {0.f, 0.f};
  const int kr0 = tid / 12, kc0 = (tid % 12) * 8;
  const int kr1 = (tid + 512) / 12, kc1 = ((tid + 512) % 12) * 8;
  const int vr = tid >> 3, vc = (tid & 7) * 8;
  bf16x8 gk0, gk1, gv;
  gk0 = *(const bf16x8*)(Kg + (size_t)kr0 * 96 + kc0);
  if (tid < 256) gk1 = *(const bf16x8*)(Kg + (size_t)kr1 * 96 + kc1);
  gv = *(const bf16x8*)(Vg + (size_t)vr * SEQ + vc);
  {
    us* ks = sm; us* vsm = sm + 64 * AKS;
    *(bf16x8*)(ks + kr0 * AKS + kc0) = gk0;
    if (tid < 256) *(bf16x8*)(ks + kr1 * AKS + kc1) = gk1;
    const u32x4_ q4 = __builtin_bit_cast(u32x4_, gv);
    *(uint2*)(vsm + vr * AVS + vc) = make_uint2(q4.x, q4.y);
    *(uint2*)(vsm + vr * AVS + vc + 4) = make_uint2(q4.z, q4.w);
  }
  lds_barrier();
  for (int kt = 0; kt < nkt; ++kt) {
    const int cur = kt & 1;
    if (kt + 1 < nkt) {
      const size_t kb = (size_t)(kt + 1) * 64;
      gk0 = *(const bf16x8*)(Kg + (kb + kr0) * 96 + kc0);
      if (tid < 256) gk1 = *(const bf16x8*)(Kg + (kb + kr1) * 96 + kc1);
      gv = *(const bf16x8*)(Vg + (size_t)vr * SEQ + kb + vc);
    }
    if (kt <= mylim) {
      const us* ks = sm + cur * ASTG + (32 * sub + c) * AKS + 8 * hh;
      const us* vsm = sm + cur * ASTG + 64 * AKS + 32 * sub + 4 * hh;
      f32x16 sc[2];
#pragma unroll
      for (int a = 0; a < 2; ++a)
#pragma unroll
        for (int r = 0; r < 16; ++r) sc[a][r] = 0.f;
#pragma unroll
      for (int s = 0; s < 6; ++s) {
        const bf16x8 a0 = *(const bf16x8*)(ks + 16 * s);
        sc[0] = mfma32(a0, qf[0][s], sc[0]);
        sc[1] = mfma32(a0, qf[1][s], sc[1]);
      }
#pragma unroll
      for (int qs = 0; qs < 2; ++qs) {
        float mx = fmaxf(fmaxf(sc[qs][0], sc[qs][1]), sc[qs][2]);
#pragma unroll
        for (int r = 3; r < 15; r += 2) mx = fmaxf(fmaxf(mx, sc[qs][r]), sc[qs][r + 1]);
        mx = fmaxf(mx, sc[qs][15]);
        mx = fmaxf(mx, __shfl_xor(mx, 32));
        if (__builtin_amdgcn_ballot_w64(mx > mrun[qs] + 8.f) != 0ull) {
          const float mnew = fmaxf(mrun[qs], mx);
          const float alpha = __builtin_amdgcn_exp2f(mrun[qs] - mnew);
          mrun[qs] = mnew;
          lrun[qs] *= alpha;
#pragma unroll
          for (int r = 0; r < 16; ++r) { ot[qs][0][r] *= alpha; ot[qs][1][r] *= alpha; }
        }
        const float mref = mrun[qs];
        sc[qs] = sc[qs] - mref;
#pragma unroll
        for (int r = 0; r < 16; ++r) sc[qs][r] = __builtin_amdgcn_exp2f(sc[qs][r]);
        typedef float f32x8_ __attribute__((ext_vector_type(8)));
        typedef float f32x2s_ __attribute__((ext_vector_type(2)));
        const f32x8_ h8 = __builtin_shufflevector(sc[qs], sc[qs], 0, 1, 2, 3, 4, 5, 6, 7) + __builtin_shufflevector(sc[qs], sc[qs], 8, 9, 10, 11, 12, 13, 14, 15);
        const f32x4 h4 = __builtin_shufflevector(h8, h8, 0, 1, 2, 3) + __builtin_shufflevector(h8, h8, 4, 5, 6, 7);
        const f32x2s_ h2 = __builtin_shufflevector(h4, h4, 0, 1) + __builtin_shufflevector(h4, h4, 2, 3);
        float rsum = h2[0] + h2[1];
        rsum += __shfl_xor(rsum, 32);
        lrun[qs] += rsum;
      }
#pragma unroll
      for (int s = 0; s < 2; ++s) {
        bf16x8 pb[2];
#pragma unroll
        for (int qs = 0; qs < 2; ++qs)
          pb[qs] = mk8(pack2(sc[qs][8 * s + 0], sc[qs][8 * s + 1]), pack2(sc[qs][8 * s + 2], sc[qs][8 * s + 3]),
                       pack2(sc[qs][8 * s + 4], sc[qs][8 * s + 5]), pack2(sc[qs][8 * s + 6], sc[qs][8 * s + 7]));
#pragma unroll
        for (int dt = 0; dt < 2; ++dt) {
          const uint2 lo = *(const uint2*)(vsm + (32 * dt + c) * AVS + 16 * s);
          const uint2 hi = *(const uint2*)(vsm + (32 * dt + c) * AVS + 16 * s + 8);
          const bf16x8 va = mk8(lo.x, lo.y, hi.x, hi.y);
          ot[0][dt] = mfma32(va, pb[0], ot[0][dt]);
          ot[1][dt] = mfma32(va, pb[1], ot[1][dt]);
        }
      }
    }
    if (kt + 1 < nkt) {
      us* ksn = sm + (cur ^ 1) * ASTG; us* vsn = ksn + 64 * AKS;
      *(bf16x8*)(ksn + kr0 * AKS + kc0) = gk0;
      if (tid < 256) *(bf16x8*)(ksn + kr1 * AKS + kc1) = gk1;
      const u32x4_ q4 = __builtin_bit_cast(u32x4_, gv);
      *(uint2*)(vsn + vr * AVS + vc) = make_uint2(q4.x, q4.y);
      *(uint2*)(vsn + vr * AVS + vc + 4) = make_uint2(q4.z, q4.w);
    }
    lds_barrier();
  }
  float* xo = (float*)smraw + pr * 4096;
  float* xml = (float*)smraw + 16384 + pr * 256;
  if (sub == 1) {
#pragma unroll
    for (int qs = 0; qs < 2; ++qs) {
#pragma unroll
      for (int dt = 0; dt < 2; ++dt)
#pragma unroll
        for (int r = 0; r < 16; ++r) xo[((qs * 2 + dt) * 16 + r) * 64 + lane] = ot[qs][dt][r];
      xml[(qs * 2 + 0) * 64 + lane] = mrun[qs];
      xml[(qs * 2 + 1) * 64 + lane] = lrun[qs];
    }
  }
  lds_barrier();
  if (sub == 0) {
    const int b = bh >> 3, hd = bh & 7;
#pragma unroll
    for (int qs = 0; qs < 2; ++qs) {
      const float m2 = xml[(qs * 2 + 0) * 64 + lane], l2 = xml[(qs * 2 + 1) * 64 + lane];
      const float M = fmaxf(mrun[qs], m2);
      const float e1 = __builtin_amdgcn_exp2f(mrun[qs] - M), e2 = __builtin_amdgcn_exp2f(m2 - M);
      const float inv = 1.f / (lrun[qs] * e1 + l2 * e2);
      const float f1 = e1 * inv, f2 = e2 * inv;
      const size_t tk = (size_t)b * SEQ + q0 + pr * 64 + qs * 32 + c;
      const us* ga = p.projB + tk * LDB_ + hd * 64;
      us* zo = p.za + tk * 1024 + hd * 64;
#pragma unroll
      for (int dt = 0; dt < 2; ++dt) {
#pragma unroll
        for (int g = 0; g < 4; ++g) {
          const int d0 = 32 * dt + 8 * g + 4 * hh;
          const uint2 gg = *(const uint2*)(ga + d0);
          f32x4 v;
#pragma unroll
          for (int r = 0; r < 4; ++r) v[r] = ot[qs][dt][4 * g + r] * f1 + xo[((qs * 2 + dt) * 16 + 4 * g + r) * 64 + lane] * f2;
          v[0] *= bflo(gg.x); v[1] *= bfhi(gg.x); v[2] *= bflo(gg.y); v[3] *= bfhi(gg.y);
          *(uint2*)(zo + d0) = pack4(v);
        }
      }
    }
  }
  lds_barrier();
}

__device__ void phase4(const Params& p, unsigned char* smraw) {
  const int wid = tidx() >> 6;
#pragma nounroll
  for (int it = blockIdx.x; it < 256; it += gridDim.x) wkv_scan_block(p, it, smraw);
  const int G = gridDim.x;
#pragma nounroll
  for (int r = 0;; ++r) {
    const int pos = (r & 1) ? (G - 1 - (int)blockIdx.x) : (int)blockIdx.x;
    const int k = r * G + pos;
    if (r * G >= 1024) break;
    if (k < 1024) attn_item(p, k & 63, 15 - (k >> 6), smraw);
  }
}

__device__ void phase5(const Params& p) {
  const int lane = tidx() & 63, wid = tidx() >> 6, fr = lane & 15, fq = lane >> 4;
  for (int it = blockIdx.x * 8 + wid; it < 4096 * 4; it += gridDim.x * 8) {
    const int ch = it >> 2, tt = it & 3;
    const int bh = ch >> 6, cc = ch & 63, b = bh >> 3, hd = bh & 7;
    const us* y1 = p.Y1 + (size_t)ch * 4096;
    const us* hh = p.Hh + (size_t)ch * 4096;
    const us* y0 = p.Y0t + (size_t)ch * 4096;
    const size_t tk = (size_t)b * SEQ + cc * 64 + tt * 16 + fr;
    const int ci0 = hd * 64 + fq * 4;
    bf16x8 bq[2];
#pragma unroll
    for (int ks = 0; ks < 2; ++ks) bq[ks] = *(const bf16x8*)(y1 + (tt * 16 + fr) * 64 + ks * 32 + fq * 8);
    uint2 bvv[4], gbv[4];
    f32x4 y[4];
#pragma unroll
    for (int mt = 0; mt < 4; ++mt) {
      const uint2 yy = *(const uint2*)(y0 + (tt * 16 + fr) * 64 + mt * 16 + fq * 4);
      bvv[mt] = *(const uint2*)(p.bv + tk * 512 + ci0 + mt * 16);
      gbv[mt] = *(const uint2*)(p.projB + tk * LDB_ + 512 + ci0 + mt * 16);
      y[mt][0] = bflo(yy.x); y[mt][1] = bfhi(yy.x); y[mt][2] = bflo(yy.y); y[mt][3] = bfhi(yy.y);
#pragma unroll
      for (int ks = 0; ks < 2; ++ks) {
        const bf16x8 a = *(const bf16x8*)(hh + (mt * 16 + fr) * 64 + ks * 32 + fq * 8);
        y[mt] = mfma16(a, bq[ks], y[mt]);
      }
    }
    float s1 = 0.f;
#pragma unroll
    for (int mt = 0; mt < 4; ++mt) s1 += y[mt][0] + y[mt][1] + y[mt][2] + y[mt][3];
    s1 += __shfl_xor(s1, 16); s1 += __shfl_xor(s1, 32);
    const float mean = s1 * (1.f / 64.f);
    float s2 = 0.f;
#pragma unroll
    for (int mt = 0; mt < 4; ++mt)
#pragma unroll
      for (int r = 0; r < 4; ++r) { y[mt][r] -= mean; s2 += y[mt][r] * y[mt][r]; }
    s2 += __shfl_xor(s2, 16); s2 += __shfl_xor(s2, 32);
    const float rstd = rsqrtf(s2 * (1.f / 64.f) + 64e-5f);
#pragma unroll
    for (int mt = 0; mt < 4; ++mt) {
      const float4 gg = *(const float4*)(p.gn_g + ci0 + mt * 16), gb = *(const float4*)(p.gn_b + ci0 + mt * 16);
      f32x4 v;
      v[0] = (y[mt][0] * rstd * gg.x + gb.x + bflo(bvv[mt].x)) * bflo(gbv[mt].x);
      v[1] = (y[mt][1] * rstd * gg.y + gb.y + bfhi(bvv[mt].x)) * bfhi(gbv[mt].x);
      v[2] = (y[mt][2] * rstd * gg.z + gb.z + bflo(bvv[mt].y)) * bflo(gbv[mt].y);
      v[3] = (y[mt][3] * rstd * gg.w + gb.w + bfhi(bvv[mt].y)) * bfhi(gbv[mt].y);
      *(uint2*)(p.za + tk * 1024 + 512 + ci0 + mt * 16) = pack4(v);
    }
  }
}

DEVI void unpack8(uint4 g, float (&o)[8]) {
  o[0] = bflo(g.x); o[1] = bfhi(g.x); o[2] = bflo(g.y); o[3] = bfhi(g.y);
  o[4] = bflo(g.z); o[5] = bfhi(g.z); o[6] = bflo(g.w); o[7] = bfhi(g.w);
}
struct EpiMerge {
  static constexpr bool PERM = true, AFTER_DRAIN = false; static constexpr int MID_T = 8;
  const us* projB; us* merged;
  DEVI void mid(f32x4 (&acc)[2][2][4][2], const pg8::Unit& u, int wr, int wc, int fr, int fq) const {
    const int row0 = u.pm * 256 + wr * 64 + fr, col0 = u.pn * 256 + wc * 32 + 8 * fq;
    const us* gbase = projB + (size_t)row0 * LDB_ + 1024 + col0;
#pragma unroll
    for (int ai = 0; ai < 2; ++ai) {
#pragma unroll
      for (int m = 0; m < 4; ++m) {
#pragma unroll
        for (int bj = 0; bj < 2; ++bj) {
          const us* gp = gbase + (size_t)(ai * 128 + m * 16) * LDB_ + bj * 128;
          float ga[8], gb[8];
          unpack8(*(const uint4*)gp, ga);
          unpack8(*(const uint4*)(gp + 1024), gb);
#pragma unroll
          for (int e = 0; e < 4; ++e) {
            acc[ai][bj][m][0][e] *= ga[e] * __builtin_amdgcn_rcpf(gb[e]);
            acc[ai][bj][m][1][e] *= ga[4 + e] * __builtin_amdgcn_rcpf(gb[4 + e]);
          }
        }
      }
    }
  }
  DEVI void operator()(const f32x4 (&acc)[2][2][4][2], const pg8::Unit& u, int wr, int wc, int fr, int fq) const {
    const int row0 = u.pm * 256 + wr * 64 + fr, col0 = u.pn * 256 + wc * 32 + 8 * fq;
#pragma unroll
    for (int ai = 0; ai < 2; ++ai)
#pragma unroll
      for (int m = 0; m < 4; ++m) {
        const size_t row = row0 + ai * 128 + m * 16;
#pragma unroll
        for (int bj = 0; bj < 2; ++bj) {
          const int c = col0 + bj * 128;
          float gb[8];
          unpack8(*(const uint4*)(projB + row * LDB_ + 2048 + c), gb);
          const f32x4 v0 = acc[ai][bj][m][0], v1 = acc[ai][bj][m][1];
          uint4 q;
          q.x = pack2(v0[0] * gb[0], v0[1] * gb[1]); q.y = pack2(v0[2] * gb[2], v0[3] * gb[3]);
          q.z = pack2(v1[0] * gb[4], v1[1] * gb[5]); q.w = pack2(v1[2] * gb[6], v1[3] * gb[7]);
          *(uint4*)(merged + row * 1024 + c) = q;
        }
      }
  }
};
__device__ void phase6(const Params& p, unsigned char* smraw) {
  pg8::Gemm g{p.za, p.Wt_pa, T_TOK, 1024, 1024};
  pg8::StaticOrder S; S.init(g.M, g.N, (int)gridDim.x, (int)blockIdx.x);
  EpiMerge E{p.projB, p.merged};
  pg8::gemm_phase<EpiMerge, pg8::StaticOrder, false>((PG8_LAS unsigned char*)smraw, g, S, E, nullptr);
}

struct EpiSub {
  static constexpr bool PERM = true, AFTER_DRAIN = false; static constexpr int MID_T = 0;
  us* sub;
  DEVI void operator()(const f32x4 (&acc)[2][2][4][2], const pg8::Unit& u, int wr, int wc, int fr, int fq) const {
    const int row0 = u.pm * 256 + wr * 64 + fr, col0 = u.pn * 256 + wc * 32 + 8 * fq;
#pragma unroll
    for (int ai = 0; ai < 2; ++ai)
#pragma unroll
      for (int m = 0; m < 4; ++m) {
        const size_t row = row0 + ai * 128 + m * 16;
#pragma unroll
        for (int bj = 0; bj < 2; ++bj) {
          const f32x4 v0 = acc[ai][bj][m][0], v1 = acc[ai][bj][m][1];
          uint4 q; q.x = pack2(v0[0], v0[1]); q.y = pack2(v0[2], v0[3]); q.z = pack2(v1[0], v1[1]); q.w = pack2(v1[2], v1[3]);
          *(uint4*)(sub + row * 1024 + col0 + bj * 128) = q;
        }
      }
  }
};
__device__ void phase7(const Params& p, unsigned char* smraw) {
  pg8::Gemm g{p.merged, p.Wt_out, T_TOK, 1024, 1024};
  pg8::StaticOrder S; S.init(g.M, g.N, (int)gridDim.x, (int)blockIdx.x);
  EpiSub E{p.sub};
  pg8::gemm_phase<EpiSub, pg8::StaticOrder, false>((PG8_LAS unsigned char*)smraw, g, S, E, nullptr);
}

__device__ void phase8(const Params& p) {
  const int lane = tidx() & 63, wid = tidx() >> 6;
  for (int row0 = (blockIdx.x * 8 + wid) * 2; row0 < T_TOK; row0 += gridDim.x * 16) {
    const float* gate = p.mod + (row0 >> 12) * 3072 + 2048;
    float4 z[2][4];
#pragma unroll
    for (int r = 0; r < 2; ++r) {
      const float4* xr = (const float4*)(p.x + (size_t)(row0 + r) * DM);
      const uint2* sr = (const uint2*)(p.sub + (size_t)(row0 + r) * DM);
#pragma unroll
      for (int i = 0; i < 4; ++i) {
        const int c4 = i * 64 + lane;
        const float4 xv = xr[c4];
        const uint2 sv = sr[c4];
        const float4 g = ((const float4*)gate)[c4];
        z[r][i].x = ALPHA_ * xv.x + (1.f + g.x) * bflo(sv.x);
        z[r][i].y = ALPHA_ * xv.y + (1.f + g.y) * bfhi(sv.x);
        z[r][i].z = ALPHA_ * xv.z + (1.f + g.z) * bflo(sv.y);
        z[r][i].w = ALPHA_ * xv.w + (1.f + g.w) * bfhi(sv.y);
      }
    }
#pragma unroll
    for (int r = 0; r < 2; ++r) {
      float s = 0.f;
#pragma unroll
      for (int i = 0; i < 4; ++i) s += z[r][i].x + z[r][i].y + z[r][i].z + z[r][i].w;
#pragma unroll
      for (int o = 32; o; o >>= 1) s += __shfl_xor(s, o);
      const float mean = s * (1.f / 1024.f);
      float q = 0.f;
#pragma unroll
      for (int i = 0; i < 4; ++i) {
        z[r][i].x -= mean; z[r][i].y -= mean; z[r][i].z -= mean; z[r][i].w -= mean;
        q += z[r][i].x * z[r][i].x + z[r][i].y * z[r][i].y + z[r][i].z * z[r][i].z + z[r][i].w * z[r][i].w;
      }
#pragma unroll
      for (int o = 32; o; o >>= 1) q += __shfl_xor(q, o);
      const float rstd = rsqrtf(q * (1.f / 1024.f) + 1e-5f);
      float4* orow = (float4*)(p.out + (size_t)(row0 + r) * DM);
#pragma unroll
      for (int i = 0; i < 4; ++i) {
        const int c4 = i * 64 + lane;
        const float4 g = ((const float4*)p.post_g)[c4], bb = ((const float4*)p.post_b)[c4];
        float4 v;
        v.x = z[r][i].x * rstd * g.x + bb.x; v.y = z[r][i].y * rstd * g.y + bb.y;
        v.z = z[r][i].z * rstd * g.z + bb.z; v.w = z[r][i].w * rstd * g.w + bb.w;
        orow[c4] = v;
      }
    }
  }
}

#define XB_TMO      128
#define XB_XCNT(j)  (256  + 64 * (j))
#define XB_XSUB(j)  (1280 + 64 * (j))
#define XB_XGEN(j)  (2304 + 64 * (j))
#define XB_TOP      3328
#define XB_TOPGEN   3392
#define XCD_BAR_WORDS 3456
#define XB_SPIN_CAP (1u << 18)
#define LAS __attribute__((address_space(3)))

__device__ __forceinline__ unsigned xb_ld(unsigned* p)              { return __hip_atomic_load(p, __ATOMIC_RELAXED, __HIP_MEMORY_SCOPE_AGENT); }
__device__ __forceinline__ unsigned xb_add(unsigned* p, unsigned v) { return __hip_atomic_fetch_add(p, v, __ATOMIC_RELAXED, __HIP_MEMORY_SCOPE_AGENT); }
__device__ __forceinline__ unsigned xb_xcc_id() { return (unsigned)__builtin_amdgcn_s_getreg((3 << 11) | 20) & 0xFu; }
#define XB_SPIN(cond, bar) do { unsigned _sp = 0; while (cond) { __builtin_amdgcn_s_sleep(1); \
    if ((++_sp & 255u) == 0u) { if (xb_ld(&(bar)[XB_TMO])) break; if (_sp > XB_SPIN_CAP) { atomicAdd(&(bar)[XB_TMO], 1u); break; } } } } while (0)

struct XcdBarrier {
    unsigned* bar; unsigned x;
    volatile LAS unsigned* st;
};

__device__ __forceinline__ XcdBarrier xcd_barrier_post(unsigned* bar, volatile LAS unsigned* st) {
    XcdBarrier b; b.bar = bar; b.x = xb_xcc_id(); b.st = st;
    if (threadIdx.x == 0) (void)xb_add(&bar[XB_XCNT(b.x)], 1u);
    return b;
}
__device__ __forceinline__ void xcd_barrier_complete(unsigned* bar, unsigned x, unsigned& nloc, unsigned& nx) {
    const unsigned G = gridDim.x * gridDim.y * gridDim.z;
    unsigned sum, cnt, mine, sp = 0u;
    for (;;) {
        sum = 0u; cnt = 0u; mine = 0u;
#pragma unroll
        for (unsigned j = 0; j < 16; ++j) { const unsigned c = xb_ld(&bar[XB_XCNT(j)]); sum += c; cnt += (c > 0u) ? 1u : 0u; mine = (j == x) ? c : mine; }
        if (sum == G) break;
        __builtin_amdgcn_s_sleep(1);
        if ((++sp & 255u) == 0u) { if (xb_ld(&bar[XB_TMO])) break; if (sp > XB_SPIN_CAP) { atomicAdd(&bar[XB_TMO], 1u); break; } }
    }
    nloc = mine > 0u ? mine : 1u; nx = cnt > 0u ? cnt : 1u;
}

__device__ __forceinline__ void xcd_barrier(const XcdBarrier& b) {
    asm volatile("s_waitcnt vmcnt(0)" ::: "memory");
    __syncthreads();
    if (threadIdx.x == 0) {
        unsigned* bar = b.bar;
        __builtin_amdgcn_s_waitcnt(0);
        unsigned nloc = b.st[0], nx = b.st[1];
        if (nloc == 0u) { xcd_barrier_complete(bar, b.x, nloc, nx); b.st[0] = nloc; b.st[1] = nx; }
        const unsigned old = xb_add(&bar[XB_XSUB(b.x)], 1u);
        const unsigned gen = old / nloc;
        if (old + 1u == (gen + 1u) * nloc) {
            __builtin_amdgcn_fence(__ATOMIC_RELEASE, "agent");
            asm volatile("s_waitcnt vmcnt(0)" ::: "memory");
            const unsigned og = xb_add(&bar[XB_TOP], 1u);
            const unsigned tg = og / nx;
            if (og + 1u == (tg + 1u) * nx) xb_add(&bar[XB_TOPGEN], 1u);
            else XB_SPIN(xb_ld(&bar[XB_TOPGEN]) == tg, bar);
            __builtin_amdgcn_fence(__ATOMIC_ACQUIRE, "agent");
            xb_add(&bar[XB_XGEN(b.x)], 1u);
            asm volatile("s_waitcnt vmcnt(0)" ::: "memory");
        } else {
            XB_SPIN(xb_ld(&bar[XB_XGEN(b.x)]) == gen, bar);
            __builtin_amdgcn_fence(__ATOMIC_ACQUIRE, "agent");
            asm volatile("s_waitcnt vmcnt(0)" ::: "memory");
        }
    }
    __syncthreads();
}


#ifdef ONE_LAUNCH
__global__ void __launch_bounds__(NTHR) fwd_kernel(Params p) {
  extern __shared__ __attribute__((aligned(16))) unsigned char smraw[];
  cg::grid_group grid = cg::this_grid();
  volatile LAS unsigned* xst = (volatile LAS unsigned*)(smraw + LDSB0);
  if (threadIdx.x == 0) { xst[0] = 0u; xst[1] = 0u; }
  __syncthreads();
  const XcdBarrier xb = xcd_barrier_post(p.bar, xst);
  if (p.bar == nullptr) grid.sync();
  phase0(p, smraw); xcd_barrier(xb);
  phase1(p); xcd_barrier(xb);
  phase2(p, smraw); xcd_barrier(xb);
  phase3q(p, smraw); phase3kv(p, smraw); phase3w(p, smraw); xcd_barrier(xb);
  phase4(p, smraw); xcd_barrier(xb);
  phase5(p); xcd_barrier(xb);
  phase6(p, smraw); xcd_barrier(xb);
  phase7(p, smraw); xcd_barrier(xb);
  phase8(p);
}
#else
#define PK(name, call) __global__ void __launch_bounds__(NTHR) name(Params p) { \
  extern __shared__ __attribute__((aligned(16))) unsigned char smraw[]; call; }
PK(k_p0, phase0(p, smraw)) PK(k_p1, phase1(p)) PK(k_p2, phase2(p, smraw)) PK(k_p3q, phase3q(p, smraw))
PK(k_p3kv, phase3kv(p, smraw)) PK(k_p3w, phase3w(p, smraw)) PK(k_p4, phase4(p, smraw)) PK(k_p5, phase5(p))
PK(k_p6, phase6(p, smraw)) PK(k_p7, phase7(p, smraw)) PK(k_p8, phase8(p))
#endif

extern "C" void kernel_launch(void* const* d_in, const int* in_sizes, int n_in, void* d_out, int out_size,
                              void* d_ws, size_t ws_size, hipStream_t stream) {
  static int grid_blocks = 0;
#ifdef ONE_LAUNCH
  if (!grid_blocks) {
    int dev = 0, cus = 0, per_cu = 0;
    (void)hipGetDevice(&dev);
    (void)hipDeviceGetAttribute(&cus, hipDeviceAttributeMultiprocessorCount, dev);
    (void)hipFuncSetAttribute((const void*)fwd_kernel, hipFuncAttributeMaxDynamicSharedMemorySize, LDSB);
    (void)hipOccupancyMaxActiveBlocksPerMultiprocessor(&per_cu, fwd_kernel, NTHR, LDSB);
    if (per_cu < 1) per_cu = 1;
    grid_blocks = cus * per_cu;
  }
#else
  if (!grid_blocks) {
    const void* ks[] = {(const void*)k_p0, (const void*)k_p1, (const void*)k_p2, (const void*)k_p3q, (const void*)k_p3kv,
                        (const void*)k_p3w, (const void*)k_p4, (const void*)k_p5, (const void*)k_p6, (const void*)k_p7,
                        (const void*)k_p8};
    for (int i = 0; i < 11; ++i) (void)hipFuncSetAttribute(ks[i], hipFuncAttributeMaxDynamicSharedMemorySize, LDSB);
    grid_blocks = 256;
  }
#endif
  Params p{};
  p.x = (const float*)d_in[0]; p.c = (const float*)d_in[1]; p.pos = (const int*)d_in[2];
  p.w_ada = (const float*)d_in[3]; p.b_ada = (const float*)d_in[4]; p.w_in = (const float*)d_in[5];
  p.q_norm_g = (const float*)d_in[6]; p.w_uq = (const float*)d_in[7]; p.kv_norm_g = (const float*)d_in[8];
  p.w_ukv = (const float*)d_in[9]; p.mu = (const float*)d_in[10]; p.w0 = (const float*)d_in[11];
  p.w_dec = (const float*)d_in[12]; p.a0 = (const float*)d_in[13]; p.w_icl = (const float*)d_in[14];
  p.k_k = (const float*)d_in[15]; p.k_a = (const float*)d_in[16]; p.r_k = (const float*)d_in[17];
  p.gn_g = (const float*)d_in[18]; p.gn_b = (const float*)d_in[19]; p.w_pa = (const float*)d_in[20];
  p.w_pb = (const float*)d_in[21]; p.w_out = (const float*)d_in[22]; p.post_g = (const float*)d_in[23];
  p.post_b = (const float*)d_in[24];
  p.out = (float*)d_out;
  unsigned char* ws = (unsigned char*)d_ws;
  size_t off = 0;
  auto take = [&](size_t bytes) { unsigned char* r = ws + off; off += (bytes + 255) & ~(size_t)255; return r; };
  const size_t MiB = 1u << 20;
  p.bar = (unsigned*)take(XCD_BAR_WORDS * 4);
  p.mod = (float*)take(8 * 3072 * 4);
  p.cs = (float*)take((size_t)T_TOK * 32 * 4);
  p.stats = (float*)take((size_t)T_TOK * 2 * 4);
  p.Gc = (float*)take(4096 * 64 * 4);
  p.Wt_in = (us*)take((size_t)5376 * 1024 * 2);
  p.Wt_uq = (us*)take(768 * 256 * 2);
  p.Wt_ukv = (us*)take(1024 * 128 * 2);
  p.Wt_dec = (us*)take(512 * 64 * 2);
  p.Wt_icl = (us*)take(512 * 64 * 2);
  p.Wt_pa = (us*)take(1024 * 1024 * 2);
  p.Wt_pb = p.Wt_pa;
  p.Wt_out = (us*)take(1024 * 1024 * 2);
  unsigned char* r1 = take(64 * MiB);
  unsigned char* r2 = take((size_t)T_TOK * LDA_ * 2);
  p.projB = (us*)take((size_t)T_TOK * LDB_ * 2);
  p.Y1 = (us*)take(32 * MiB);
  p.Y0t = (us*)take(32 * MiB);
  p.bv = (us*)take(32 * MiB);
  p.h = (us*)r1; p.Mp = (us*)r1; p.Nt = (us*)(r1 + 32 * MiB); p.merged = (us*)r1;
  p.projA = (us*)r2; p.sub = (us*)r2; p.Hh = (us*)r2; p.za = (us*)(r2 + 32 * MiB); p.zb = p.za;
  unsigned char* ob = (unsigned char*)d_out;
  p.Q = (us*)ob; p.K = (us*)(ob + 48 * MiB); p.Vt = (us*)(ob + 96 * MiB);
  if (off > ws_size) { fprintf(stderr, "workspace too small: need %zu have %zu\n", off, ws_size); return; }
#ifndef ONE_LAUNCH
  const dim3 g(grid_blocks), bdim(NTHR);
  k_p0<<<g, bdim, LDSB, stream>>>(p);
  k_p1<<<g, bdim, LDSB, stream>>>(p);
  k_p2<<<g, bdim, LDSB, stream>>>(p);
  k_p3q<<<g, bdim, LDSB, stream>>>(p);
  k_p3kv<<<g, bdim, LDSB, stream>>>(p);
  k_p3w<<<g, bdim, LDSB, stream>>>(p);
  k_p4<<<g, bdim, LDSB, stream>>>(p);
  k_p5<<<g, bdim, LDSB, stream>>>(p);
  k_p6<<<g, bdim, LDSB, stream>>>(p);
  k_p7<<<g, bdim, LDSB, stream>>>(p);
  k_p8<<<g, bdim, LDSB, stream>>>(p);
#else
  (void)hipMemsetAsync(p.bar, 0, XCD_BAR_WORDS * 4, stream);
  void* args[] = {&p};
  hipError_t e = hipLaunchCooperativeKernel((void*)fwd_kernel, dim3(grid_blocks), dim3(NTHR), args, LDSB, stream);
  if (e != hipSuccess) fprintf(stderr, "cooperative launch failed: %s (grid %d)\n", hipGetErrorString(e), grid_blocks);
#endif
}
```
